# Optimizing an MI355X kernel written in HIP

```python
import math
import jax, jax.numpy as jnp
from jax import lax
import numpy as np

D_MODEL = 1024
BATCH = 16
SEQ = 2048
DEPTH = 2

F_GROUPS = 4
F_GROUP_DIM = 64
F_WIDTH = F_GROUPS * F_GROUP_DIM
N_HEADS = 6
Q_LORA = 256
KV_LORA = 256
QK_NOPE = 128
QK_ROPE = 64
V_DIM = 128
QK_DIM = QK_NOPE + QK_ROPE
A_WIDTH = N_HEADS * V_DIM
MIX_WIDTH = F_WIDTH + A_WIDTH
IN_WIDTH = F_WIDTH + Q_LORA + KV_LORA + QK_ROPE
ROPE_BASE = 10000.0
Q_BLOCK = 128
MAX_POS_OFFSET = 1024
D_FF = 4 * D_MODEL
EPS = 1e-6

kernel_name = "hybrid_fnet_mla_encoder"


def rms_norm(x, g):
    xf = x.astype(jnp.float32)
    y = xf * lax.rsqrt(jnp.mean(xf * xf, axis=-1, keepdims=True) + EPS)
    return (y * g.astype(jnp.float32)).astype(x.dtype)


def rotary_tables(positions):
    half = QK_ROPE // 2
    inv_freq = ROPE_BASE ** (-jnp.arange(half, dtype=jnp.float32) / half)
    ang = positions.astype(jnp.float32)[..., None] * inv_freq
    return jnp.cos(ang)[:, :, None, :], jnp.sin(ang)[:, :, None, :]


def apply_rotary(x, cos, sin):
    xf = x.astype(jnp.float32)
    x1, x2 = jnp.split(xf, 2, axis=-1)
    out = jnp.concatenate([x1 * cos - x2 * sin, x2 * cos + x1 * sin], axis=-1)
    return out.astype(x.dtype)


def fourier_mixer(u, w_fourier):
    b, s, _ = u.shape
    ug = u.reshape(b, s, F_GROUPS, F_GROUP_DIM).astype(jnp.float32)
    fr = jnp.real(jnp.fft.fft2(ug, axes=(1, 3), norm='ortho'))
    y = jnp.einsum('bsgc,gcd->bsgd', fr, w_fourier.astype(jnp.float32))
    return y.reshape(b, s, F_WIDTH).astype(u.dtype)


def dense_attention(q, k, v):
    b, s, h, dk = q.shape
    dv = v.shape[-1]
    nblk = s // Q_BLOCK
    scale = 1.0 / math.sqrt(dk)
    kf = jnp.transpose(k, (0, 2, 1, 3)).astype(jnp.float32)
    vf = jnp.transpose(v, (0, 2, 1, 3)).astype(jnp.float32)
    qb = jnp.transpose(q, (0, 2, 1, 3)).reshape(b, h, nblk, Q_BLOCK, dk)
    qb = jnp.transpose(qb, (2, 0, 1, 3, 4))

    def one_block(qblk):
        scores = jnp.einsum('bhqd,bhkd->bhqk', qblk.astype(jnp.float32), kf) * scale
        probs = jax.nn.softmax(scores, axis=-1)
        return jnp.einsum('bhqk,bhkd->bhqd', probs, vf)

    o = lax.map(one_block, qb)
    o = jnp.transpose(o, (1, 0, 3, 2, 4)).reshape(b, s, h, dv)
    return o.astype(q.dtype)


def mla_mixer(c_q, c_kv, k_pe, cos, sin, q_a_g, w_q_up, kv_a_g, w_kv_up, q_norm_g, k_norm_g):
    b, s, _ = c_q.shape
    q = (rms_norm(c_q, q_a_g) @ w_q_up).reshape(b, s, N_HEADS, QK_DIM)
    kv = (rms_norm(c_kv, kv_a_g) @ w_kv_up).reshape(b, s, N_HEADS, QK_NOPE + V_DIM)
    k_nope, v = kv[..., :QK_NOPE], kv[..., QK_NOPE:]
    k_pe_h = jnp.broadcast_to(k_pe[:, :, None, :], (b, s, N_HEADS, QK_ROPE))
    k = jnp.concatenate([k_nope, k_pe_h], axis=-1)
    q = rms_norm(q, q_norm_g)
    k = rms_norm(k, k_norm_g)
    q = jnp.concatenate([q[..., :QK_NOPE], apply_rotary(q[..., QK_NOPE:], cos, sin)], axis=-1)
    k = jnp.concatenate([k[..., :QK_NOPE], apply_rotary(k[..., QK_NOPE:], cos, sin)], axis=-1)
    o = dense_attention(q, k, v)
    return o.reshape(b, s, A_WIDTH)


def setup_inputs(seed: int = 0) -> dict:
    key = jax.random.key(seed)
    ks = jax.random.split(key, 18)
    f32 = jnp.float32

    def w(k, shape, fan_in):
        return jax.random.normal(k, shape, f32) * (fan_in ** -0.5)

    def gain(k, shape):
        return 1.0 + 0.05 * jax.random.normal(k, shape, f32)

    x = jax.random.normal(ks[0], (BATCH, SEQ, D_MODEL), f32)
    offsets = jax.random.randint(ks[1], (BATCH, 1), 0, MAX_POS_OFFSET, dtype=jnp.int32)
    positions = (jnp.arange(SEQ, dtype=jnp.int32)[None, :] + offsets).astype(jnp.int32)
    return {
        'x': x,
        'positions': positions,
        'attn_norm_g': gain(ks[2], (DEPTH, D_MODEL)),
        'w_in': w(ks[3], (DEPTH, D_MODEL, IN_WIDTH), D_MODEL),
        'w_fourier': w(ks[4], (DEPTH, F_GROUPS, F_GROUP_DIM, F_GROUP_DIM), F_GROUP_DIM),
        'q_a_g': gain(ks[5], (DEPTH, Q_LORA)),
        'w_q_up': w(ks[6], (DEPTH, Q_LORA, N_HEADS * QK_DIM), Q_LORA),
        'kv_a_g': gain(ks[7], (DEPTH, KV_LORA)),
        'w_kv_up': w(ks[8], (DEPTH, KV_LORA, N_HEADS * (QK_NOPE + V_DIM)), KV_LORA),
        'q_norm_g': gain(ks[9], (DEPTH, QK_DIM)),
        'k_norm_g': gain(ks[10], (DEPTH, QK_DIM)),
        'fourier_out_g': gain(ks[11], (DEPTH, F_WIDTH)),
        'attn_out_g': gain(ks[12], (DEPTH, A_WIDTH)),
        'w_out': w(ks[13], (DEPTH, MIX_WIDTH, D_MODEL), MIX_WIDTH),
        'mlp_norm_g': gain(ks[14], (DEPTH, D_MODEL)),
        'w_mlp_in': w(ks[15], (DEPTH, D_MODEL, D_FF), D_MODEL),
        'w_mlp_out': w(ks[16], (DEPTH, D_FF, D_MODEL), D_FF),
    }


def reference(x, positions, attn_norm_g, w_in, w_fourier, q_a_g, w_q_up, kv_a_g, w_kv_up,
              q_norm_g, k_norm_g, fourier_out_g, attn_out_g, w_out, mlp_norm_g,
              w_mlp_in, w_mlp_out):
    cos, sin = rotary_tables(positions)
    splits = [F_WIDTH, F_WIDTH + Q_LORA, F_WIDTH + Q_LORA + KV_LORA]
    for l in range(DEPTH):
        h = rms_norm(x, attn_norm_g[l])
        z = h @ w_in[l]
        z_f, c_q, c_kv, k_pe = jnp.split(z, splits, axis=-1)
        y_f = rms_norm(fourier_mixer(z_f, w_fourier[l]), fourier_out_g[l])
        y_a = rms_norm(mla_mixer(c_q, c_kv, k_pe, cos, sin, q_a_g[l], w_q_up[l], kv_a_g[l],
                                 w_kv_up[l], q_norm_g[l], k_norm_g[l]), attn_out_g[l])
        x = x + jnp.concatenate([y_f, y_a], axis=-1) @ w_out[l]
        hm = rms_norm(x, mlp_norm_g[l]) @ w_mlp_in[l]
        x = x + jnp.square(jax.nn.relu(hm)) @ w_mlp_out[l]
    return x
```

```cpp
#include <hip/hip_runtime.h>
#include <cstdio>
#include <cstdint>

typedef unsigned short bf16_t;
typedef short bf16x8 __attribute__((ext_vector_type(8)));
typedef float f32x4 __attribute__((ext_vector_type(4)));
typedef unsigned u32x4 __attribute__((ext_vector_type(4)));
typedef unsigned u32x2 __attribute__((ext_vector_type(2)));
#define LAS __attribute__((address_space(3)))

constexpr int BATCH = 16, SEQ = 2048, DM = 1024, T = BATCH * SEQ, DEPTH = 2;
constexpr int FW = 256, QL = 256, KVL = 256, ROPE_D = 64, NOPE = 128, VD = 128, NH = 6, QKD = 192;
constexpr int INW = 832, INWP = 1024, QUPW = NH * QKD  , QUPWP = 1280, KVUPW = NH * 256  , AW = NH * VD  , FF = 4096;
constexpr float EPS = 1e-6f;
constexpr float QSCALE = 0.07216878364870322f * 1.4426950408889634f;
constexpr float DFT_NRM = 0.0027621358640099515f;

constexpr size_t MiB = 1u << 20;
constexpr size_t WS_CTL = 0;
constexpr size_t WS_W = 1 * MiB, LW = 22 * MiB;
constexpr size_t OW_IN = 0, OW_QUP = 2 * MiB, OW_KVUP = OW_QUP + 640 * 1024, OW_OUT = OW_KVUP + 768 * 1024, OW_MI = OW_OUT + 2 * MiB, OW_MO = OW_MI + 8 * MiB, OW_Y = OW_MO + 8 * MiB;
static_assert(OW_Y + 256 * 1024 <= LW, "layer weight block");
constexpr size_t WS_F = 45 * MiB;
constexpr size_t WS_SSQX = 61 * MiB;
constexpr size_t WS_SSQCQ = 63 * MiB, WS_SSQCKV = WS_SSQCQ + 512 * 1024;
constexpr size_t WS_XB = 64 * MiB;
constexpr size_t WS_MIX = 128 * MiB;
constexpr size_t WS_Q = 192 * MiB;
constexpr size_t WS_K = 264 * MiB;
constexpr size_t WS_V = 336 * MiB;
constexpr size_t WS_PQ = 384 * MiB;
constexpr size_t WS_UT = 416 * MiB;
constexpr size_t WS_H = 192 * MiB;
constexpr size_t WS_CQ = 448 * MiB, WS_CKV = 464 * MiB;
constexpr size_t WS_KPE = 480 * MiB;
constexpr size_t WS_ROPE = 484 * MiB;
constexpr size_t WS_SSQPE = 492 * MiB;
constexpr size_t WS_SSQA = WS_SSQPE + 256 * 1024;
constexpr size_t WS_RSTD = 494 * MiB;
constexpr size_t WS_END = 495 * MiB;
constexpr size_t WS_KRAW = 384 * MiB;
constexpr size_t WS_S = 384 * MiB;

__device__ __forceinline__ unsigned f2bf(float f) { unsigned u = __builtin_bit_cast(unsigned, f); return (u + 0x7fffu + ((u >> 16) & 1u)) >> 16; }
__device__ __forceinline__ unsigned pk2(float lo, float hi) { return f2bf(lo) | (f2bf(hi) << 16); }
__device__ __forceinline__ float bf2f(bf16_t h) { return __builtin_bit_cast(float, (unsigned)h << 16); }
__device__ __forceinline__ float wave_sum(float v) {
#pragma unroll
    for (int o = 1; o < 64; o <<= 1) v += __shfl_xor(v, o);
    return v;
}

struct Params {
    const float* x; const int* pos; const float* in[15];
    float* out; unsigned char* ws; int ph_lo, ph_hi;
};
enum { I_ANG = 0, I_WIN, I_WF, I_QAG, I_WQUP, I_KVAG, I_WKVUP, I_QNG, I_KNG, I_FOG, I_AOG, I_WOUT, I_MNG, I_WMI, I_WMO };

constexpr int NWAVES = 8, MK_THREADS = NWAVES * 64;
constexpr int MK_LDS = 147456;

__device__ __forceinline__ void tr_item(const float* W, int K, int N, int koff, const float* g1, const float* g2, int ksplit, bf16_t* WT, LAS float* scr, int item, int lane) {
    const int nblk = N / 32, kb = item / nblk, nb = item % nblk, k0 = 64 * kb, n0 = 32 * nb;
#pragma unroll 8
    for (int i = 0; i < 32; ++i) {
        const int kk = 2 * i + (lane >> 5), kp = k0 + kk, ks = (kp + koff) & (K - 1);
        const float g = g1 ? (kp < ksplit ? g1[kp] : g2[kp - ksplit]) : 1.f;
        scr[kk * 33 + (lane & 31)] = W[(size_t)ks * N + n0 + (lane & 31)] * g;
    }
    asm volatile("s_waitcnt lgkmcnt(0)" ::: "memory");
    const int c = lane & 7;
#pragma unroll
    for (int j = 0; j < 4; ++j) {
        const int n = (lane >> 3) + 8 * j; const LAS float* s = scr + (8 * c) * 33 + n;
        u32x4 o; o.x = pk2(s[0 * 33], s[1 * 33]); o.y = pk2(s[2 * 33], s[3 * 33]); o.z = pk2(s[4 * 33], s[5 * 33]); o.w = pk2(s[6 * 33], s[7 * 33]);
        *(u32x4*)(WT + (size_t)(n0 + n) * K + k0 + 8 * c) = o;
    }
    asm volatile("s_waitcnt lgkmcnt(0)" ::: "memory");
}

__device__ __forceinline__ void phase_prologue(const Params& p, LAS unsigned char* lds) {
    const int tid = threadIdx.x, lane = tid & 63, wave = tid >> 6;
    const int G = gridDim.x, gw = blockIdx.x * NWAVES + wave, NGW = G * NWAVES;
    const int gt = blockIdx.x * MK_THREADS + tid, NGT = G * MK_THREADS;
    LAS float* tab = (LAS float*)lds;
    LAS float* scr = (LAS float*)(lds + 8192 + wave * 8704);
    for (int j = tid; j < 2048; j += MK_THREADS) tab[j] = cospif((float)j * (1.0f / 1024.0f));
    __syncthreads();
    unsigned char* ws = p.ws;
    {
        constexpr int I_IN = 16 * 26, I_QU = 4 * 36, I_KV = 4 * 48, I_OUT = 16 * 32, I_MI = 16 * 128, I_MO = 64 * 32, I_L = I_IN + I_QU + I_KV + I_OUT + I_MI + I_MO;
        for (int it = gw; it < DEPTH * I_L; it += NGW) {
            const int l = it / I_L; int r = it % I_L; unsigned char* wl = ws + WS_W + (size_t)l * LW;
            if (r < I_IN) { tr_item(p.in[I_WIN] + (size_t)l * DM * INW, DM, INW, 0, p.in[I_ANG] + l * DM, nullptr, DM, (bf16_t*)(wl + OW_IN), scr, r, lane); continue; } r -= I_IN;
            if (r < I_QU) { tr_item(p.in[I_WQUP] + (size_t)l * QL * QUPW, QL, QUPW, 0, p.in[I_QAG] + l * QL, nullptr, QL, (bf16_t*)(wl + OW_QUP), scr, r, lane); continue; } r -= I_QU;
            if (r < I_KV) { tr_item(p.in[I_WKVUP] + (size_t)l * KVL * KVUPW, KVL, KVUPW, 0, p.in[I_KVAG] + l * KVL, nullptr, KVL, (bf16_t*)(wl + OW_KVUP), scr, r, lane); continue; } r -= I_KV;
            if (r < I_OUT) { tr_item(p.in[I_WOUT] + (size_t)l * DM * DM, DM, DM, FW, p.in[I_AOG] + l * AW, p.in[I_FOG] + l * FW, AW, (bf16_t*)(wl + OW_OUT), scr, r, lane); continue; } r -= I_OUT;
            if (r < I_MI) { tr_item(p.in[I_WMI] + (size_t)l * DM * FF, DM, FF, 0, p.in[I_MNG] + l * DM, nullptr, DM, (bf16_t*)(wl + OW_MI), scr, r, lane); continue; } r -= I_MI;
            tr_item(p.in[I_WMO] + (size_t)l * FF * DM, FF, DM, 0, nullptr, nullptr, FF, (bf16_t*)(wl + OW_MO), scr, r, lane);
        }
    }
    {
        constexpr int C_IN = (INWP - INW) * DM / 8, C_QU = (QUPWP - QUPW) * QL / 8, C_L = C_IN + C_QU;
        for (int i = gt; i < DEPTH * C_L; i += NGT) {
            const int l = i / C_L, r = i % C_L; unsigned char* wl = ws + WS_W + (size_t)l * LW;
            u32x4* dst = (r < C_IN) ? (u32x4*)(wl + OW_IN + (size_t)INW * DM * 2) + r : (u32x4*)(wl + OW_QUP + (size_t)QUPW * QL * 2) + (r - C_IN);
            *dst = (u32x4){0u, 0u, 0u, 0u};
        }
    }
    {
        bf16_t* F = (bf16_t*)(ws + WS_F);
        for (int ci = gt; ci < 4096 * 256; ci += NGT) {
            const int r = ci >> 8, s0 = (ci & 255) * 8, pq = r >> 11, sp = r & 2047, sh = pq ? 1536 : 0;
            float v[8];
#pragma unroll
            for (int e = 0; e < 8; ++e) v[e] = tab[(sp * (s0 + e) + sh) & 2047];
            u32x4 o; o.x = pk2(v[0], v[1]); o.y = pk2(v[2], v[3]); o.z = pk2(v[4], v[5]); o.w = pk2(v[6], v[7]);
            *(u32x4*)(F + (size_t)r * 2048 + s0) = o;
        }
    }
    {
        for (int i = gt; i < DEPTH * 256 * 512; i += NGT) {
            const int l = i / (256 * 512), r = i % (256 * 512), n = r >> 9, k = r & 511, g = n >> 6, d = n & 63, pq = k >> 8, g2 = (k >> 6) & 3, c = k & 63;
            float acc = 0.f;
            if (g2 == g) {
                const float* wf = p.in[I_WF] + ((size_t)(l * 4 + g) * 64) * 64 + d;
                const int sh = pq ? 1536 : 0;
                for (int c2 = 0; c2 < 64; ++c2) acc += tab[((((c * c2) & 63) * 32) + sh) & 2047] * wf[(size_t)c2 * 64];
                acc *= pq ? -DFT_NRM : DFT_NRM;
            }
            ((bf16_t*)(ws + WS_W + (size_t)l * LW + OW_Y))[r] = (bf16_t)f2bf(acc);
        }
    }
    {
        bf16_t* XB = (bf16_t*)(ws + WS_XB); float* SSQ = (float*)(ws + WS_SSQX);
        for (int m = gw; m < T; m += NGW) {
            const f32x4* xr = (const f32x4*)(p.x + (size_t)m * DM) + lane; f32x4 v[4]; float s = 0.f;
#pragma unroll
            for (int j = 0; j < 4; ++j) { v[j] = xr[64 * j]; s += (v[j].x * v[j].x + v[j].y * v[j].y) + (v[j].z * v[j].z + v[j].w * v[j].w); }
            s = wave_sum(s);
            u32x2* o8 = (u32x2*)(XB + (size_t)m * DM) + lane;
#pragma unroll
            for (int j = 0; j < 4; ++j) o8[64 * j] = (u32x2){pk2(v[j].x, v[j].y), pk2(v[j].z, v[j].w)};
            if (lane < 16) SSQ[(size_t)m * 16 + lane] = lane == 0 ? s : 0.f;
        }
    }
    {
        float* R = (float*)(ws + WS_ROPE);
        for (int i = gt; i < T * 32; i += NGT) {
            const int row = i >> 5, j = i & 31;
            const float inv = powf(10000.0f, -(float)j * (1.0f / 32.0f));
            const float ang = (float)p.pos[row] * inv;
            R[(size_t)row * 64 + j] = cosf(ang); R[(size_t)row * 64 + 32 + j] = sinf(ang);
        }
    }
}

__global__ void __launch_bounds__(MK_THREADS, 2) mk(Params p) {
    extern __shared__ __attribute__((aligned(16))) unsigned char lds_raw[];
    LAS unsigned char* lds = (LAS unsigned char*)lds_raw;
    if (p.ph_lo <= 0 && 0 < p.ph_hi) phase_prologue(p, lds);
}

template <class Epi, bool BKN>
__global__ void __launch_bounds__(256) sg_gemm(const bf16_t* A, long lda, long strideA, const bf16_t* B, long ldb, long strideB, int K, Epi epi, int kscale_at, const float* rowscale) {
    const int z = blockIdx.z; A += (long)z * strideA; B += (long)z * strideB;
    const int lane = threadIdx.x & 63, w = threadIdx.x >> 6, fr = lane & 15, fq = lane >> 4;
    const int m0 = blockIdx.y * 64 + (w >> 1) * 32, n0 = blockIdx.x * 64 + (w & 1) * 32;
    f32x4 acc[2][2];
#pragma unroll
    for (int i = 0; i < 2; ++i)
#pragma unroll
        for (int j = 0; j < 2; ++j) acc[i][j] = (f32x4){0.f, 0.f, 0.f, 0.f};
    for (int k0 = 0; k0 < K; k0 += 32) {
        if (k0 == kscale_at) {
#pragma unroll
            for (int i = 0; i < 2; ++i)
#pragma unroll
                for (int r = 0; r < 4; ++r) { const float s = rowscale[m0 + i * 16 + fq * 4 + r]; acc[i][0][r] *= s; acc[i][1][r] *= s; }
        }
        bf16x8 a[2], b[2];
#pragma unroll
        for (int i = 0; i < 2; ++i) a[i] = *(const bf16x8*)(A + (long)(m0 + i * 16 + fr) * lda + k0 + fq * 8);
#pragma unroll
        for (int j = 0; j < 2; ++j) {
            if (!BKN) b[j] = *(const bf16x8*)(B + (long)(n0 + j * 16 + fr) * ldb + k0 + fq * 8);
            else {
#pragma unroll
                for (int jj = 0; jj < 8; ++jj) b[j][jj] = (short)B[(long)(k0 + fq * 8 + jj) * ldb + n0 + j * 16 + fr];
            }
        }
#pragma unroll
        for (int i = 0; i < 2; ++i)
#pragma unroll
            for (int j = 0; j < 2; ++j) acc[i][j] = __builtin_amdgcn_mfma_f32_16x16x32_bf16(a[i], b[j], acc[i][j], 0, 0, 0);
    }
#pragma unroll
    for (int i = 0; i < 2; ++i)
#pragma unroll
        for (int j = 0; j < 2; ++j)
#pragma unroll
            for (int r = 0; r < 4; ++r) epi(z, m0 + i * 16 + fq * 4 + r, n0 + j * 16 + fr, acc[i][j][r]);
}

struct EpiIn { const float* rstd; bf16_t *UT, *CQ, *CKV, *KPE;
    __device__ void operator()(int, int row, int col, float v) const {
        v *= rstd[row];
        if (col < 256) { const int b = row >> 11, s = row & 2047; UT[((size_t)(b * 256 + col)) * 2048 + s] = (bf16_t)f2bf(v); }
        else if (col < 512) CQ[(size_t)row * 256 + col - 256] = (bf16_t)f2bf(v);
        else if (col < 768) CKV[(size_t)row * 256 + col - 512] = (bf16_t)f2bf(v);
        else KPE[(size_t)row * 64 + col - 768] = (bf16_t)f2bf(v);
    } };
struct EpiDft { bf16_t* PQ;
    __device__ void operator()(int, int row, int col, float v) const {
        const int pq = row >> 11, sp = row & 2047, b = col >> 8, c = col & 255;
        PQ[((size_t)(b * 2048 + sp)) * 512 + pq * 256 + c] = (bf16_t)f2bf(v);
    } };
struct EpiY { bf16_t* MIX;
    __device__ void operator()(int, int row, int col, float v) const { MIX[(size_t)row * 1024 + 768 + col] = (bf16_t)f2bf(v); } };
struct EpiQ { const float* rstd; bf16_t* Q;
    __device__ void operator()(int, int row, int col, float v) const { Q[(size_t)row * QUPW + col] = (bf16_t)f2bf(v * rstd[row]); } };
struct EpiKV { const float* rstd; bf16_t *KRAW, *V;
    __device__ void operator()(int, int row, int col, float v) const {
        v *= rstd[row]; const int h = col >> 8, j = col & 255;
        if (j < 128) KRAW[(size_t)row * 768 + h * 128 + j] = (bf16_t)f2bf(v); else V[(size_t)row * 768 + h * 128 + j - 128] = (bf16_t)f2bf(v);
    } };
struct EpiS { float* S;
    __device__ void operator()(int z, int row, int col, float v) const { S[((size_t)z * 2048 + row) * 2048 + col] = v; } };
struct EpiO { bf16_t* MIX; int b, h0;
    __device__ void operator()(int z, int row, int col, float v) const { MIX[((size_t)(b * 2048 + row)) * 1024 + (h0 + z) * 128 + col] = (bf16_t)f2bf(v); } };
struct EpiRes { const float* xold; float* xnew; bf16_t* XB;
    __device__ void operator()(int, int row, int col, float v) const { const size_t o = (size_t)row * 1024 + col; const float y = xold[o] + v; xnew[o] = y; XB[o] = (bf16_t)f2bf(y); } };
struct EpiH { const float* rstd; bf16_t* H;
    __device__ void operator()(int, int row, int col, float v) const { v *= rstd[row]; v = v > 0.f ? v * v : 0.f; H[(size_t)row * FF + col] = (bf16_t)f2bf(v); } };

__global__ void __launch_bounds__(256) k_rowssq(const bf16_t* src, int ld, int ncols, int nparts, float* dst, int dstride) {
    const int row = (blockIdx.x * 256 + threadIdx.x) >> 6, lane = threadIdx.x & 63; if (row >= T) return;
    const int chunk = ncols / nparts;
    for (int pp = 0; pp < dstride; ++pp) {
        float s = 0.f;
        if (pp < nparts) for (int e = lane; e < chunk; e += 64) { const float v = bf2f(src[(size_t)row * ld + pp * chunk + e]); s += v * v; }
        s = wave_sum(s);
        if (lane == 0) dst[(size_t)row * dstride + pp] = s;
    }
}
__global__ void __launch_bounds__(256) k_rstd(const float* part, int stride, int np, float n, float* rstd) {
    const int row = blockIdx.x * 256 + threadIdx.x; if (row >= T) return;
    float s = 0.f; for (int i = 0; i < np; ++i) s += part[(size_t)row * stride + i];
    rstd[row] = rsqrtf(s / n + EPS);
}
__global__ void __launch_bounds__(256) k_ynorm(bf16_t* MIX) {
    const int row = (blockIdx.x * 256 + threadIdx.x) >> 6, lane = threadIdx.x & 63; if (row >= T) return;
    bf16_t* p = MIX + (size_t)row * 1024 + 768 + lane * 4; float v[4], s = 0.f;
#pragma unroll
    for (int i = 0; i < 4; ++i) { v[i] = bf2f(p[i]); s += v[i] * v[i]; }
    s = wave_sum(s); const float r = rsqrtf(s * (1.f / 256.f) + EPS);
#pragma unroll
    for (int i = 0; i < 4; ++i) p[i] = (bf16_t)f2bf(v[i] * r);
}
__global__ void __launch_bounds__(256) k_qkfin(const bf16_t* src_n, int ld_n, int hs_n, const bf16_t* src_p, int ld_p, int hs_p, const float* gain, const float* rope, float scale, bf16_t* dst) {
    const int gwv = (blockIdx.x * 256 + threadIdx.x) >> 6, lane = threadIdx.x & 63; if (gwv >= T * NH) return;
    const int row = gwv / NH, h = gwv % NH;
    const float n0 = bf2f(src_n[(size_t)row * ld_n + h * hs_n + 2 * lane]), n1 = bf2f(src_n[(size_t)row * ld_n + h * hs_n + 2 * lane + 1]);
    const float pe = bf2f(src_p[(size_t)row * ld_p + h * hs_p + lane]);
    const float ss = wave_sum(n0 * n0 + n1 * n1 + pe * pe), r = rsqrtf(ss * (1.f / 192.f) + EPS);
    const float x = pe * r * gain[128 + lane], y = __shfl_xor(x, 32);
    const int i = lane & 31; const float c = rope[(size_t)row * 64 + i], s = rope[(size_t)row * 64 + 32 + i];
    const float o = lane < 32 ? x * c - y * s : x * c + y * s;
    bf16_t* d = dst + (size_t)row * QUPW + h * 192;
    d[2 * lane] = (bf16_t)f2bf(n0 * r * gain[2 * lane] * scale); d[2 * lane + 1] = (bf16_t)f2bf(n1 * r * gain[2 * lane + 1] * scale);
    d[128 + lane] = (bf16_t)f2bf(o * scale);
}
__global__ void __launch_bounds__(256) k_softmax(float* S) {
    __shared__ float red[8];
    float* row = S + (size_t)blockIdx.x * 2048; const int t = threadIdx.x, lane = t & 63, w = t >> 6;
    f32x4 a = *(const f32x4*)(row + t * 4), b = *(const f32x4*)(row + 1024 + t * 4);
    float m = fmaxf(fmaxf(fmaxf(a.x, a.y), fmaxf(a.z, a.w)), fmaxf(fmaxf(b.x, b.y), fmaxf(b.z, b.w)));
#pragma unroll
    for (int o = 1; o < 64; o <<= 1) m = fmaxf(m, __shfl_xor(m, o));
    if (lane == 0) red[w] = m; __syncthreads();
    m = fmaxf(fmaxf(red[0], red[1]), fmaxf(red[2], red[3]));
    a.x = exp2f(a.x - m); a.y = exp2f(a.y - m); a.z = exp2f(a.z - m); a.w = exp2f(a.w - m);
    b.x = exp2f(b.x - m); b.y = exp2f(b.y - m); b.z = exp2f(b.z - m); b.w = exp2f(b.w - m);
    float s = wave_sum((a.x + a.y) + (a.z + a.w) + (b.x + b.y) + (b.z + b.w));
    if (lane == 0) red[4 + w] = s; __syncthreads();
    s = 1.f / ((red[4] + red[5]) + (red[6] + red[7]));
    bf16_t* pr = (bf16_t*)row;
    *(u32x2*)(pr + t * 4) = (u32x2){pk2(a.x * s, a.y * s), pk2(a.z * s, a.w * s)};
    *(u32x2*)(pr + 1024 + t * 4) = (u32x2){pk2(b.x * s, b.y * s), pk2(b.z * s, b.w * s)};
}

template <class Epi, bool BKN = false>
static void gemm(hipStream_t st, int M, int N, int K, int Z, const bf16_t* A, long lda, long sA, const bf16_t* B, long ldb, long sB, Epi epi, int kscale_at = -1, const float* rowscale = nullptr) {
    hipLaunchKernelGGL((sg_gemm<Epi, BKN>), dim3(N / 64, M / 64, Z), dim3(256), 0, st, A, lda, sA, B, ldb, sB, K, epi, kscale_at, rowscale);
}

extern "C" void kernel_launch(void* const* d_in, const int* in_sizes, int n_in, void* d_out, int out_size, void* d_ws, size_t ws_size, hipStream_t stream) {
    static int ok = 0;
    if (ok == 0) {
        if (n_in != 17 || in_sizes[0] != T * DM || out_size != T * DM || ws_size < WS_END) {
            fprintf(stderr, "kernel_launch: shape/workspace mismatch: n_in %d in0 %d out %d ws %zu (need %zu)\n", n_in, n_in > 0 ? in_sizes[0] : -1, out_size, ws_size, (size_t)WS_END);
            ok = -1; return; }
        if (hipFuncSetAttribute((const void*)mk, hipFuncAttributeMaxDynamicSharedMemorySize, MK_LDS) != hipSuccess) { fprintf(stderr, "kernel_launch: hipFuncSetAttribute failed\n"); ok = -1; return; }
        ok = 1;
    }
    if (ok < 0) return;
    unsigned char* ws = (unsigned char*)d_ws;
    Params p{};
    p.x = (const float*)d_in[0]; p.pos = (const int*)d_in[1];
    for (int i = 0; i < 15; ++i) p.in[i] = (const float*)d_in[2 + i];
    p.out = (float*)d_out; p.ws = ws; p.ph_lo = 0; p.ph_hi = 1;
    hipLaunchKernelGGL(mk, dim3(256), dim3(MK_THREADS), MK_LDS, stream, p);

    bf16_t *XB = (bf16_t*)(ws + WS_XB), *MIX = (bf16_t*)(ws + WS_MIX), *Q = (bf16_t*)(ws + WS_Q), *Kb = (bf16_t*)(ws + WS_K), *V = (bf16_t*)(ws + WS_V), *PQ = (bf16_t*)(ws + WS_PQ),
           *UT = (bf16_t*)(ws + WS_UT), *H = (bf16_t*)(ws + WS_H), *CQ = (bf16_t*)(ws + WS_CQ), *CKV = (bf16_t*)(ws + WS_CKV), *KPE = (bf16_t*)(ws + WS_KPE), *KRAW = (bf16_t*)(ws + WS_KRAW), *F = (bf16_t*)(ws + WS_F);
    float *SSQX = (float*)(ws + WS_SSQX), *SSQCQ = (float*)(ws + WS_SSQCQ), *SSQCKV = (float*)(ws + WS_SSQCKV), *SSQPE = (float*)(ws + WS_SSQPE), *SSQA = (float*)(ws + WS_SSQA),
          *ROPE = (float*)(ws + WS_ROPE), *S = (float*)(ws + WS_S);
    float *RX = (float*)(ws + WS_RSTD), *RCQ = RX + T, *RCKV = RCQ + T, *RA = RCKV + T;
    float* out = (float*)d_out;
    const int RB = T * 64 / 256;
    for (int l = 0; l < DEPTH; ++l) {
        unsigned char* wl = ws + WS_W + (size_t)l * LW;
        const bf16_t *W_IN = (const bf16_t*)(wl + OW_IN), *W_QUP = (const bf16_t*)(wl + OW_QUP), *W_KVUP = (const bf16_t*)(wl + OW_KVUP), *W_OUT = (const bf16_t*)(wl + OW_OUT),
                     *W_MI = (const bf16_t*)(wl + OW_MI), *W_MO = (const bf16_t*)(wl + OW_MO), *W_Y = (const bf16_t*)(wl + OW_Y);
        const float* xold = l == 0 ? p.x : out;
        hipLaunchKernelGGL(k_rstd, dim3(T / 256), dim3(256), 0, stream, SSQX, 16, 16, 1024.f, RX);
        gemm(stream, T, INW, DM, 1, XB, DM, 0, W_IN, DM, 0, EpiIn{RX, UT, CQ, CKV, KPE});
        hipLaunchKernelGGL(k_rowssq, dim3(RB), dim3(256), 0, stream, CQ, 256, 256, 4, SSQCQ, 4);
        hipLaunchKernelGGL(k_rowssq, dim3(RB), dim3(256), 0, stream, CKV, 256, 256, 4, SSQCKV, 4);
        hipLaunchKernelGGL(k_rowssq, dim3(RB), dim3(256), 0, stream, KPE, 64, 64, 2, SSQPE, 2);
        hipLaunchKernelGGL(k_rstd, dim3(T / 256), dim3(256), 0, stream, SSQCQ, 4, 4, 256.f, RCQ);
        hipLaunchKernelGGL(k_rstd, dim3(T / 256), dim3(256), 0, stream, SSQCKV, 4, 4, 256.f, RCKV);
        gemm(stream, 4096, 4096, 2048, 1, F, 2048, 0, UT, 2048, 0, EpiDft{PQ});
        gemm(stream, T, 256, 512, 1, PQ, 512, 0, W_Y, 512, 0, EpiY{MIX});
        hipLaunchKernelGGL(k_ynorm, dim3(RB), dim3(256), 0, stream, MIX);
        gemm(stream, T, QUPW, QL, 1, CQ, QL, 0, W_QUP, QL, 0, EpiQ{RCQ, Q});
        hipLaunchKernelGGL(k_qkfin, dim3(T * NH * 64 / 256), dim3(256), 0, stream, (const bf16_t*)Q, QUPW, 192, (const bf16_t*)Q + 128, QUPW, 192, p.in[I_QNG] + l * QKD, (const float*)ROPE, QSCALE, Q);
        gemm(stream, T, KVUPW, KVL, 1, CKV, KVL, 0, W_KVUP, KVL, 0, EpiKV{RCKV, KRAW, V});
        hipLaunchKernelGGL(k_qkfin, dim3(T * NH * 64 / 256), dim3(256), 0, stream, (const bf16_t*)KRAW, 768, 128, (const bf16_t*)KPE, 64, 0, p.in[I_KNG] + l * QKD, (const float*)ROPE, 1.0f, Kb);
        for (int b = 0; b < BATCH; ++b)
            for (int hg = 0; hg < 2; ++hg) {
                const size_t qo = (size_t)b * SEQ * QUPW + (size_t)hg * 3 * QKD;
                gemm(stream, SEQ, SEQ, QKD, 3, Q + qo, QUPW, QKD, Kb + qo, QUPW, QKD, EpiS{S});
                hipLaunchKernelGGL(k_softmax, dim3(3 * SEQ), dim3(256), 0, stream, S);
                gemm<EpiO, true>(stream, SEQ, VD, SEQ, 3, (const bf16_t*)S, 4096, (long)SEQ * 4096, V + (size_t)b * SEQ * AW + (size_t)hg * 3 * VD, AW, VD, EpiO{MIX, b, hg * 3});
            }
        hipLaunchKernelGGL(k_rowssq, dim3(RB), dim3(256), 0, stream, MIX, 1024, 768, 6, SSQA, 8);
        hipLaunchKernelGGL(k_rstd, dim3(T / 256), dim3(256), 0, stream, SSQA, 8, 6, 768.f, RA);
        gemm(stream, T, DM, DM, 1, MIX, DM, 0, W_OUT, DM, 0, EpiRes{xold, out, XB}, 768, RA);
        hipLaunchKernelGGL(k_rowssq, dim3(RB), dim3(256), 0, stream, XB, 1024, 1024, 16, SSQX, 16);
        hipLaunchKernelGGL(k_rstd, dim3(T / 256), dim3(256), 0, stream, SSQX, 16, 16, 1024.f, RX);
        gemm(stream, T, FF, DM, 1, XB, DM, 0, W_MI, DM, 0, EpiH{RX, H});
        gemm(stream, T, DM, FF, 1, H, FF, 0, W_MO, FF, 0, EpiRes{out, out, XB});
        hipLaunchKernelGGL(k_rowssq, dim3(RB), dim3(256), 0, stream, XB, 1024, 1024, 16, SSQX, 16);
    }
    const hipError_t le = hipPeekAtLastError();
    if (le != hipSuccess) fprintf(stderr, "kernel_launch: launch failed: %s\n", hipGetErrorName(le));
}
```

```cpp
#include <hip/hip_runtime.h>
#include <hip/hip_cooperative_groups.h>
#include <cstdio>
#include <cstdint>

typedef unsigned short bf16_t;
typedef short bf16x8 __attribute__((ext_vector_type(8)));
typedef float f32x4 __attribute__((ext_vector_type(4)));
typedef unsigned u32x4 __attribute__((ext_vector_type(4)));
typedef unsigned u32x2 __attribute__((ext_vector_type(2)));
#define LAS __attribute__((address_space(3)))

constexpr int BATCH = 16, SEQ = 2048, DM = 1024, T = BATCH * SEQ, DEPTH = 2;
constexpr int FW = 256, QL = 256, KVL = 256, ROPE_D = 64, NOPE = 128, VD = 128, NH = 6, QKD = 192;
constexpr int INW = 832, INWP = 1024, QUPW = NH * QKD  , QUPWP = 1280, KVUPW = NH * 256  , AW = NH * VD  , FF = 4096;
constexpr float EPS = 1e-6f;
constexpr float QSCALE = 0.07216878364870322f * 1.4426950408889634f;
constexpr float DFT_NRM = 0.0027621358640099515f;

constexpr size_t MiB = 1u << 20;
constexpr size_t WS_CTL = 0;
constexpr size_t WS_W = 1 * MiB, LW = 22 * MiB;
constexpr size_t OW_IN = 0, OW_QUP = 2 * MiB, OW_KVUP = OW_QUP + 640 * 1024, OW_OUT = OW_KVUP + 768 * 1024, OW_MI = OW_OUT + 2 * MiB, OW_MO = OW_MI + 8 * MiB, OW_Y = OW_MO + 8 * MiB;
static_assert(OW_Y + 256 * 1024 <= LW, "layer weight block");
constexpr size_t WS_F = 45 * MiB;
constexpr size_t WS_SSQX = 61 * MiB;
constexpr size_t WS_SSQCQ = 63 * MiB, WS_SSQCKV = WS_SSQCQ + 512 * 1024;
constexpr size_t WS_XB = 64 * MiB;
constexpr size_t WS_MIX = 128 * MiB;
constexpr size_t WS_Q = 192 * MiB;
constexpr size_t WS_K = 264 * MiB;
constexpr size_t WS_V = 336 * MiB;
constexpr size_t WS_PQ = 384 * MiB;
constexpr size_t WS_UT = 416 * MiB;
constexpr size_t WS_H = 192 * MiB;
constexpr size_t WS_CQ = 448 * MiB, WS_CKV = 464 * MiB;
constexpr size_t WS_KPE = 480 * MiB;
constexpr size_t WS_ROPE = 484 * MiB;
constexpr size_t WS_SSQPE = 492 * MiB;
constexpr size_t WS_SSQA = WS_SSQPE + 256 * 1024;
constexpr size_t WS_RSTD = 494 * MiB;
constexpr size_t WS_END = 495 * MiB;
constexpr size_t WS_KRAW = 384 * MiB;
constexpr size_t WS_S = 384 * MiB;

__device__ __forceinline__ unsigned f2bf(float f) { unsigned u = __builtin_bit_cast(unsigned, f); return (u + 0x7fffu + ((u >> 16) & 1u)) >> 16; }
__device__ __forceinline__ unsigned pk2(float lo, float hi) { return f2bf(lo) | (f2bf(hi) << 16); }
__device__ __forceinline__ float bf2f(bf16_t h) { return __builtin_bit_cast(float, (unsigned)h << 16); }
__device__ __forceinline__ float add_xor32(float v) { auto rr = __builtin_amdgcn_permlane32_swap(__float_as_uint(v), __float_as_uint(v), false, false); return __uint_as_float(rr[0]) + __uint_as_float(rr[1]); }
__device__ __forceinline__ float add_xor16(float v) { return v + __uint_as_float(__builtin_amdgcn_ds_swizzle(__float_as_uint(v), 0x401F)); }
__device__ __forceinline__ float add_xor1(float v) { return v + __uint_as_float(__builtin_amdgcn_ds_swizzle(__float_as_uint(v), 0x041F)); }
__device__ __forceinline__ float wave_sum(float v) {
#pragma unroll
    for (int o = 1; o < 64; o <<= 1) v += __shfl_xor(v, o);
    return v;
}

struct Params {
    const float* x; const int* pos; const float* in[15];
    float* out; unsigned char* ws; int ph_lo, ph_hi, sub, pad;
};
enum { I_ANG = 0, I_WIN, I_WF, I_QAG, I_WQUP, I_KVAG, I_WKVUP, I_QNG, I_KNG, I_FOG, I_AOG, I_WOUT, I_MNG, I_WMI, I_WMO };

namespace pg8 {
#define PG8_LAS __attribute__((address_space(3)))
typedef unsigned short bf16_t;
typedef short bf16x8 __attribute__((ext_vector_type(8)));
typedef float f32x4 __attribute__((ext_vector_type(4)));
typedef unsigned u32x4 __attribute__((ext_vector_type(4)));
constexpr int BM = 256, BK = 64, HALF = 128, HTB = HALF * BK * 2  , STAGE_BYTES = 8 * HTB, NXCD = 8, WGM = 8;

__host__ __device__ __forceinline__ int lds_byte(int r, int c) { const int st = (r >> 4) * 2 + (c >> 5), rr = r & 15, cc = c & 31, ob = rr * 64 + cc * 2; return st * 1024 + (ob ^ (((ob >> 9) & 1) << 5)); }
__host__ __device__ __forceinline__ void stage_rc(int b, int& R, int& C) { const int st = b / 1024, sb = b % 1024, swz = sb ^ (((sb >> 9) & 1) << 5); R = (st >> 1) * 16 + swz / 64; C = (st & 1) * 32 + (swz % 64) / 2; }
__host__ __device__ __forceinline__ int perm32(int rho) { const int n = rho >> 4, i = rho & 15; return 8 * (i >> 2) + 4 * n + (i & 3); }

struct Unit { int pm, pn; };
struct Gemm { const bf16_t* A; const bf16_t* Bt; int M, N, K; };

struct StaticOrder {
    int nM, nN, nwg, G, c;
    __host__ __device__ void init(int M, int N, int G_, int c_) { nM = M / BM; nN = N / BM; nwg = nM * nN; G = G_; c = c_; }
    __host__ __device__ bool next(int i, Unit& u) const {
        const long L = (long)i * G + c; if (L >= nwg) return false;
        int wgid = (int)L; { const int q = nwg / NXCD, r = nwg % NXCD, xcd = wgid % NXCD, off = wgid / NXCD; wgid = (xcd < r ? xcd * (q + 1) : r * (q + 1) + (xcd - r) * q) + off; }
        const int nig = WGM * nN, gid = wgid / nig, fm = gid * WGM, gsz = (nM - fm) < WGM ? (nM - fm) : WGM;
        u.pm = fm + ((wgid % nig) % gsz); u.pn = (wgid % nig) / gsz; return true;
    }
    __device__ __forceinline__ void a_ready(const Unit&) const {}
    __device__ __forceinline__ void done(const Unit&) const {}
};

template <class Epi, class Sched, bool ALIGN_EPI = false, bool SP2 = false>
__device__ __forceinline__ void gemm_phase(PG8_LAS unsigned char* lds, const Gemm g, const Sched& S, const Epi& E, const int tid) {
    const int wid = __builtin_amdgcn_readfirstlane(tid >> 6), lane = tid & 63, wr = wid >> 2, wc = wid & 3, fr = lane & 15, fq = lane >> 4;
    int K_ = g.K; asm volatile("" : "+s"(K_));
    const int K = K_, nt = K / BK;
    unsigned voffA[2], voffB[2];
#pragma unroll
    for (int i = 0; i < 2; ++i) { int R, C; stage_rc(tid * 16 + i * 8192, R, C); const int Rb = Epi::PERM ? ((R & ~31) + perm32(R & 31)) : R;
        voffA[i] = (unsigned)(R * K + C) * 2u; voffB[i] = (unsigned)(Rb * K + C) * 2u; }
    const size_t kstep = (size_t)(BK * 2);
    const size_t hstep = (size_t)HALF * K * 2;
    const size_t tstep = 2 * hstep;
    const unsigned ldsw = (unsigned)wid * 1024u;
    const int aoff = lds_byte(wr * 64 + fr, fq * 8), boff = lds_byte(wc * 32 + fr, fq * 8);
#define PG8_SA(b, h) (((b) * 2 + (h)) * HTB)
#define PG8_SB(b, h) ((4 + (b) * 2 + (h)) * HTB)
#define PG8_STAGE(bufoff, gbase, voff) do { _Pragma("unroll") for (int _i = 0; _i < 2; ++_i) \
        __builtin_amdgcn_global_load_lds((const unsigned*)((const char*)(gbase) + (voff)[_i]), (PG8_LAS unsigned*)(lds + (bufoff) + ldsw + _i * 8192), 16, 0, 0); } while (0)
#define PG8_LDA(dst, b, h) do { _Pragma("unroll") for (int m = 0; m < 4; ++m) _Pragma("unroll") for (int k = 0; k < 2; ++k) dst[m][k] = *(const PG8_LAS bf16x8*)(lds + PG8_SA(b, h) + aoff + m * 2048 + k * 1024); } while (0)
#define PG8_LDB(dst, b, h) do { _Pragma("unroll") for (int n = 0; n < 2; ++n) _Pragma("unroll") for (int k = 0; k < 2; ++k) dst[n][k] = *(const PG8_LAS bf16x8*)(lds + PG8_SB(b, h) + boff + n * 2048 + k * 1024); } while (0)
#define PG8_MMA(ai, bj, At, Bt) do { __builtin_amdgcn_s_setprio(1); _Pragma("unroll") for (int m = 0; m < 4; ++m) _Pragma("unroll") for (int n = 0; n < 2; ++n) _Pragma("unroll") for (int k = 0; k < 2; ++k) \
        acc[ai][bj][m][n] = __builtin_amdgcn_mfma_f32_16x16x32_bf16(Bt[n][k], At[m][k], acc[ai][bj][m][n], 0, 0, 0); __builtin_amdgcn_s_setprio(0); } while (0)
#define PG8_WAIT_V(n) asm volatile("s_waitcnt vmcnt(" #n ")" ::: "memory")
#define PG8_WAIT_L(n) asm volatile("s_waitcnt lgkmcnt(" #n ")" ::: "memory")
#define PG8_BAR __builtin_amdgcn_s_barrier()
#define PG8_SCHED __builtin_amdgcn_sched_barrier(0)
    Unit cur, nxt; int ui = 0;
    if (!S.next(0, cur)) return;
    f32x4 acc[2][2][4][2];
#pragma unroll
    for (int a = 0; a < 2; ++a)
#pragma unroll
        for (int b = 0; b < 2; ++b)
#pragma unroll
            for (int m = 0; m < 4; ++m)
#pragma unroll
                for (int n = 0; n < 2; ++n) acc[a][b][m][n] = (f32x4){0.f, 0.f, 0.f, 0.f};
    bf16x8 At[4][2], B0[2][2], B1[2][2];
    const char* cA = (const char*)g.A + (size_t)cur.pm * tstep; const char* cB = (const char*)g.Bt + (size_t)cur.pn * tstep;
    S.a_ready(cur);
    if constexpr (SP2) {
        PG8_STAGE(PG8_SB(0, 0), cB, voffB); PG8_STAGE(PG8_SB(0, 1), cB + hstep, voffB); PG8_STAGE(PG8_SA(0, 0), cA, voffA); PG8_STAGE(PG8_SA(0, 1), cA + hstep, voffA);
        if (wr == 1) PG8_BAR;
        PG8_WAIT_V(2); PG8_BAR;
        PG8_STAGE(PG8_SB(1, 0), cB + kstep, voffB); PG8_STAGE(PG8_SA(1, 0), cA + kstep, voffA); PG8_STAGE(PG8_SB(1, 1), cB + hstep + kstep, voffB);
        PG8_WAIT_V(6); PG8_BAR;
    } else {
        PG8_STAGE(PG8_SB(0, 0), cB, voffB); PG8_STAGE(PG8_SA(0, 0), cA, voffA); PG8_STAGE(PG8_SB(0, 1), cB + hstep, voffB); PG8_STAGE(PG8_SA(0, 1), cA + hstep, voffA);
        if (wr == 1) PG8_BAR;
        PG8_WAIT_V(4); PG8_BAR;
        PG8_STAGE(PG8_SB(1, 0), cB + kstep, voffB); PG8_STAGE(PG8_SA(1, 0), cA + kstep, voffA); PG8_STAGE(PG8_SB(1, 1), cB + hstep + kstep, voffB);
        PG8_WAIT_V(6); PG8_BAR;
    }
    for (;;) {
        const bool has_next = S.next(ui + 1, nxt);
        const char* nA = has_next ? (const char*)g.A + (size_t)nxt.pm * tstep : cA; const char* nB = has_next ? (const char*)g.Bt + (size_t)nxt.pn * tstep : cB;
        for (int t = 0; t < nt; t += 2) {
            const bool last = (t == nt - 2);
            const char* a1 = cA + (size_t)(t + 1) * kstep;
            const char* a2 = last ? nA : cA + (size_t)(t + 2) * kstep; const char* b2 = last ? nB : cB + (size_t)(t + 2) * kstep;
            const char* a3 = a2 + kstep; const char* b3 = b2 + kstep;
            if (last && has_next) S.a_ready(nxt);
            if constexpr (SP2) {
            PG8_LDB(B0, 0, 0); PG8_LDB(B1, 0, 1); PG8_SCHED; PG8_LDA(At, 0, 0); PG8_STAGE(PG8_SA(1, 1), a1 + hstep, voffA);
            PG8_WAIT_V(8); PG8_WAIT_L(0); PG8_BAR; PG8_MMA(0, 0, At, B0); PG8_MMA(0, 1, At, B1); PG8_BAR; PG8_SCHED;
            PG8_LDA(At, 0, 1); PG8_STAGE(PG8_SB(0, 0), b2, voffB); PG8_STAGE(PG8_SB(0, 1), b2 + hstep, voffB); PG8_STAGE(PG8_SA(0, 0), a2, voffA);
            PG8_WAIT_V(8); PG8_WAIT_L(0); PG8_BAR; PG8_MMA(1, 0, At, B0); PG8_MMA(1, 1, At, B1); PG8_BAR; PG8_SCHED;
            PG8_LDB(B0, 1, 0); PG8_LDB(B1, 1, 1); PG8_SCHED; PG8_LDA(At, 1, 0); PG8_STAGE(PG8_SA(0, 1), a2 + hstep, voffA);
            PG8_WAIT_V(8); PG8_WAIT_L(0); PG8_BAR; PG8_MMA(0, 0, At, B0); PG8_MMA(0, 1, At, B1); PG8_BAR; PG8_SCHED;
            PG8_LDA(At, 1, 1); PG8_STAGE(PG8_SB(1, 0), b3, voffB); PG8_STAGE(PG8_SB(1, 1), b3 + hstep, voffB); PG8_STAGE(PG8_SA(1, 0), a3, voffA);
            PG8_WAIT_V(8); PG8_WAIT_L(0); PG8_BAR; PG8_MMA(1, 0, At, B0); PG8_MMA(1, 1, At, B1); PG8_BAR; PG8_SCHED;
            } else {
            PG8_LDB(B0, 0, 0); PG8_SCHED; PG8_LDA(At, 0, 0); PG8_STAGE(PG8_SA(1, 1), a1 + hstep, voffA);
            PG8_WAIT_L(8); PG8_BAR; PG8_WAIT_L(0); PG8_MMA(0, 0, At, B0); PG8_BAR; PG8_SCHED;
            PG8_LDB(B1, 0, 1); PG8_STAGE(PG8_SB(0, 0), b2, voffB);
            PG8_BAR; PG8_WAIT_L(0); PG8_MMA(0, 1, At, B1); PG8_BAR;
            PG8_LDA(At, 0, 1); PG8_STAGE(PG8_SA(0, 0), a2, voffA);
            PG8_BAR; PG8_WAIT_L(0); PG8_MMA(1, 0, At, B0); PG8_BAR; PG8_SCHED;
            PG8_STAGE(PG8_SB(0, 1), b2 + hstep, voffB);
            PG8_WAIT_V(6); PG8_BAR; PG8_MMA(1, 1, At, B1); PG8_BAR;
            PG8_LDB(B0, 1, 0); PG8_SCHED; PG8_LDA(At, 1, 0); PG8_STAGE(PG8_SA(0, 1), a2 + hstep, voffA);
            PG8_WAIT_L(8); PG8_BAR; PG8_WAIT_L(0); PG8_MMA(0, 0, At, B0); PG8_BAR; PG8_SCHED;
            PG8_LDB(B1, 1, 1); PG8_STAGE(PG8_SB(1, 0), b3, voffB);
            PG8_BAR; PG8_WAIT_L(0); PG8_MMA(0, 1, At, B1); PG8_BAR;
            PG8_LDA(At, 1, 1); PG8_STAGE(PG8_SA(1, 0), a3, voffA);
            PG8_BAR; PG8_WAIT_L(0); PG8_MMA(1, 0, At, B0); PG8_BAR; PG8_SCHED;
            PG8_STAGE(PG8_SB(1, 1), b3 + hstep, voffB);
            PG8_WAIT_V(6); PG8_BAR; PG8_MMA(1, 1, At, B1); PG8_BAR;
            }
            if constexpr (Epi::MIDK > 0) { if (t + 2 == Epi::MIDK) E.midk(acc, cur, wr, fr); }
        }
        if constexpr (ALIGN_EPI) { if (wr == 0) PG8_BAR; }
        if constexpr (!Epi::AFTER_DRAIN) { E(acc, cur, wr, wc, fr, fq); S.done(cur); }
        if (!has_next) break;
#pragma unroll
        for (int a = 0; a < 2; ++a)
#pragma unroll
            for (int b = 0; b < 2; ++b)
#pragma unroll
                for (int m = 0; m < 4; ++m)
#pragma unroll
                    for (int n = 0; n < 2; ++n) acc[a][b][m][n] = (f32x4){0.f, 0.f, 0.f, 0.f};
        cur = nxt; cA = nA; cB = nB; ++ui;
        if constexpr (ALIGN_EPI) { if (wr == 1) PG8_BAR; }
    }
    PG8_WAIT_V(0);
    if constexpr (!ALIGN_EPI) { if (wr == 0) PG8_BAR; }
    PG8_BAR;
    if constexpr (Epi::AFTER_DRAIN) { E.fused(acc, cur, wr, wc, fr, fq, lds, wid, lane); S.done(cur); }
#undef PG8_SA
#undef PG8_SB
#undef PG8_STAGE
#undef PG8_LDA
#undef PG8_LDB
#undef PG8_MMA
#undef PG8_WAIT_V
#undef PG8_WAIT_L
#undef PG8_BAR
#undef PG8_SCHED
}
}

namespace pg8 {
__device__ __forceinline__ unsigned cvt_pk_bf16(float lo, float hi) { unsigned r; asm volatile("v_cvt_pk_bf16_f32 %0, %1, %2" : "=v"(r) : "v"(lo), "v"(hi)); return r; }
__device__ __forceinline__ u32x4 pack8(const f32x4 a, const f32x4 b) { u32x4 w; w.x = cvt_pk_bf16(a[0], a[1]); w.y = cvt_pk_bf16(a[2], a[3]); w.z = cvt_pk_bf16(b[0], b[1]); w.w = cvt_pk_bf16(b[2], b[3]); return w; }
__device__ __forceinline__ float sum4(const f32x4 a) { return (a[0] + a[1]) + (a[2] + a[3]); }
__device__ __forceinline__ float ssq4(const f32x4 a) { return (a[0] * a[0] + a[1] * a[1]) + (a[2] * a[2] + a[3] * a[3]); }
__device__ __forceinline__ float rstd16(const float* p, float invn) { const f32x4* q = (const f32x4*)p; const f32x4 a = q[0], b = q[1], c = q[2], d = q[3]; return rsqrtf(((sum4(a) + sum4(b)) + (sum4(c) + sum4(d))) * invn + 1e-6f); }
__device__ __forceinline__ float rstd4(const float* p, float invn) { const f32x4 a = *(const f32x4*)p; return rsqrtf(sum4(a) * invn + 1e-6f); }
__device__ __forceinline__ float fq_sum(float s) { return add_xor32(add_xor16(s)); }

struct EpiMlpIn { static constexpr bool PERM = true, AFTER_DRAIN = false; static constexpr int MIDK = 0;
    const float* ssqx; bf16_t* H;
    __device__ __forceinline__ void operator()(const f32x4 (&acc)[2][2][4][2], const Unit& u, int wr, int wc, int fr, int fq) const {
        const int row0 = u.pm * BM + wr * 64 + fr, col0 = u.pn * BM + wc * 32 + 8 * fq;
#pragma unroll
        for (int ai = 0; ai < 2; ++ai)
#pragma unroll
            for (int m = 0; m < 4; ++m) { const int row = row0 + ai * HALF + m * 16; const float rs = rstd16(ssqx + (size_t)row * 16, 1.f / 1024.f);
                bf16_t* rowp = H + (size_t)row * 4096 + col0;
#pragma unroll
                for (int bj = 0; bj < 2; ++bj) { f32x4 v0 = acc[ai][bj][m][0] * rs, v1 = acc[ai][bj][m][1] * rs;
#pragma unroll
                    for (int i = 0; i < 4; ++i) { const float a = fmaxf(v0[i], 0.f), b = fmaxf(v1[i], 0.f); v0[i] = a * a; v1[i] = b * b; }
                    *(u32x4*)(rowp + bj * HALF) = pack8(v0, v1); } asm volatile("" ::: "memory"); }
    }
};
template <int MIDK_> struct EpiRes { static constexpr bool PERM = true, AFTER_DRAIN = false; static constexpr int MIDK = MIDK_;
    const float* xold; float* xnew; bf16_t* XB; float* ssqx; const float* ssqa;
    __device__ __forceinline__ void midk(f32x4 (&acc)[2][2][4][2], const Unit& u, int wr, int fr) const {
#pragma unroll
        for (int ai = 0; ai < 2; ++ai)
#pragma unroll
            for (int m = 0; m < 4; ++m) { const int row = u.pm * BM + ai * HALF + wr * 64 + m * 16 + fr; const f32x4 a = *(const f32x4*)(ssqa + (size_t)row * 8), b = *(const f32x4*)(ssqa + (size_t)row * 8 + 4);
                const float rs = rsqrtf((sum4(a) + (b[0] + b[1])) * (1.f / 768.f) + 1e-6f);
#pragma unroll
                for (int bj = 0; bj < 2; ++bj)
#pragma unroll
                    for (int n = 0; n < 2; ++n) acc[ai][bj][m][n] *= rs; asm volatile("" ::: "memory"); }
    }
    __device__ __forceinline__ void operator()(const f32x4 (&acc)[2][2][4][2], const Unit& u, int wr, int wc, int fr, int fq) const {
        const int row0 = u.pm * BM + wr * 64 + fr, col0 = u.pn * BM + wc * 32 + 8 * fq;
#pragma unroll
        for (int ai = 0; ai < 2; ++ai)
#pragma unroll
            for (int m = 0; m < 4; ++m) { const int row = row0 + ai * HALF + m * 16; float s = 0.f;
#pragma unroll
                for (int bj = 0; bj < 2; ++bj) { const size_t off = (size_t)row * 1024 + col0 + bj * HALF;
                    const f32x4 o0 = *(const f32x4*)(xold + off) + acc[ai][bj][m][0], o1 = *(const f32x4*)(xold + off + 4) + acc[ai][bj][m][1];
                    *(f32x4*)(xnew + off) = o0; *(f32x4*)(xnew + off + 4) = o1; *(u32x4*)(XB + off) = pack8(o0, o1); s += ssq4(o0) + ssq4(o1); }
                s = fq_sum(s); if (fq == 0) ssqx[(size_t)row * 16 + u.pn * 4 + wc] = s; asm volatile("" ::: "memory"); }
    }
};
struct EpiIn { static constexpr bool PERM = true, AFTER_DRAIN = false; static constexpr int MIDK = 0;
    const float* ssqx; bf16_t *UT, *CQ, *CKV, *KPE; float *ssqcq, *ssqckv, *ssqpe;
    __device__ __forceinline__ void operator()(const f32x4 (&acc)[2][2][4][2], const Unit& u, int wr, int wc, int fr, int fq) const {
        const int row0 = u.pm * BM + wr * 64 + fr, c0 = wc * 32 + 8 * fq, pn = u.pn;
#pragma unroll
        for (int ai = 0; ai < 2; ++ai)
#pragma unroll
            for (int m = 0; m < 4; ++m) { const int row = row0 + ai * HALF + m * 16; const float rs = rstd16(ssqx + (size_t)row * 16, 1.f / 1024.f);
                if (pn == 0) { const int b = row >> 11, s = row & 2047; bf16_t* base = UT + ((size_t)(b * 256 + c0)) * 2048 + s;
#pragma unroll
                    for (int bj = 0; bj < 2; ++bj)
#pragma unroll
                        for (int n = 0; n < 2; ++n)
#pragma unroll
                            for (int i = 0; i < 4; ++i) base[(size_t)(bj * HALF + 4 * n + i) * 2048] = (bf16_t)(cvt_pk_bf16(acc[ai][bj][m][n][i] * rs, 0.f) & 0xffffu);
                } else if (pn < 3) { bf16_t* dst = (pn == 1 ? CQ : CKV) + (size_t)row * 256 + c0; float s = 0.f;
#pragma unroll
                    for (int bj = 0; bj < 2; ++bj) { const f32x4 v0 = acc[ai][bj][m][0] * rs, v1 = acc[ai][bj][m][1] * rs; *(u32x4*)(dst + bj * HALF) = pack8(v0, v1); s += ssq4(v0) + ssq4(v1); }
                    s = fq_sum(s); if (fq == 0) (pn == 1 ? ssqcq : ssqckv)[(size_t)row * 4 + wc] = s;
                } else if (wc < 2) { const f32x4 v0 = acc[ai][0][m][0] * rs, v1 = acc[ai][0][m][1] * rs; *(u32x4*)(KPE + (size_t)row * 64 + c0) = pack8(v0, v1);
                    float s = fq_sum(ssq4(v0) + ssq4(v1)); if (fq == 0) ssqpe[(size_t)row * 2 + wc] = s; } asm volatile("" ::: "memory"); }
    }
};
struct EpiDft { static constexpr bool PERM = true, AFTER_DRAIN = false; static constexpr int MIDK = 0;
    bf16_t* PQ;
    __device__ __forceinline__ void operator()(const f32x4 (&acc)[2][2][4][2], const Unit& u, int wr, int wc, int fr, int fq) const {
        const int pq = u.pm >> 3, sp0 = (u.pm & 7) * 256 + wr * 64 + fr, b = u.pn;
#pragma unroll
        for (int ai = 0; ai < 2; ++ai)
#pragma unroll
            for (int m = 0; m < 4; ++m) { bf16_t* rowp = PQ + ((size_t)(b * 2048 + sp0 + ai * HALF + m * 16)) * 512 + pq * 256 + wc * 32 + 8 * fq;
#pragma unroll
                for (int bj = 0; bj < 2; ++bj) *(u32x4*)(rowp + bj * HALF) = pack8(acc[ai][bj][m][0], acc[ai][bj][m][1]); asm volatile("" ::: "memory"); }
    }
};
struct EpiQ { static constexpr bool PERM = true, AFTER_DRAIN = false; static constexpr int MIDK = 0;
    const float* ssqcq; bf16_t* Q;
    __device__ __forceinline__ void operator()(const f32x4 (&acc)[2][2][4][2], const Unit& u, int wr, int wc, int fr, int fq) const {
        const int row0 = u.pm * BM + wr * 64 + fr, col0 = u.pn * BM + wc * 32 + 8 * fq;
#pragma unroll
        for (int ai = 0; ai < 2; ++ai)
#pragma unroll
            for (int m = 0; m < 4; ++m) { const int row = row0 + ai * HALF + m * 16; const float rs = rstd4(ssqcq + (size_t)row * 4, 1.f / 256.f);
                bf16_t* rowp = Q + (size_t)row * 1152 + col0;
#pragma unroll
                for (int bj = 0; bj < 2; ++bj) if (col0 + bj * HALF < 1152) *(u32x4*)(rowp + bj * HALF) = pack8(acc[ai][bj][m][0] * rs, acc[ai][bj][m][1] * rs); asm volatile("" ::: "memory"); }
    }
};
}

namespace pg8 {
typedef float f32x2 __attribute__((ext_vector_type(2)));
#define PG8_EPI_BAR() do { asm volatile("s_waitcnt lgkmcnt(0)" ::: "memory"); __builtin_amdgcn_s_barrier(); asm volatile("" ::: "memory"); } while (0)
struct EpiKV { static constexpr bool PERM = true, AFTER_DRAIN = false; static constexpr int MIDK = 0;
    const float *ssqckv, *ssqpe, *gk, *rope; const bf16_t* KPE; bf16_t *K, *V; PG8_LAS float* xch;
    __device__ __forceinline__ void operator()(const f32x4 (&acc)[2][2][4][2], const Unit& u, int wr, int wc, int fr, int fq) const {
        const int h = u.pn, row0 = u.pm * BM + wr * 64 + fr, c0 = wc * 32 + 8 * fq;
        float rck[2][4];
#pragma unroll
        for (int ai = 0; ai < 2; ++ai)
#pragma unroll
            for (int m = 0; m < 4; ++m) { const int row = row0 + ai * HALF + m * 16; const float rc = rstd4(ssqckv + (size_t)row * 4, 1.f / 256.f); rck[ai][m] = rc;
                const f32x4 v0 = acc[ai][0][m][0] * rc, v1 = acc[ai][0][m][1] * rc; const float s = fq_sum(ssq4(v0) + ssq4(v1));
                if (fq == 0) xch[(ai * HALF + wr * 64 + m * 16 + fr) * 4 + wc] = s; }
        PG8_EPI_BAR();
        const f32x4 g0 = *(const f32x4*)(gk + c0), g1 = *(const f32x4*)(gk + c0 + 4);
        const int i0 = 2 * (4 * wc + fq);
        const f32x2 gp1 = *(const f32x2*)(gk + 128 + i0), gp2 = *(const f32x2*)(gk + 160 + i0);
#pragma unroll
        for (int ai = 0; ai < 2; ++ai)
#pragma unroll
            for (int m = 0; m < 4; ++m) { const int row = row0 + ai * HALF + m * 16, rowt = ai * HALF + wr * 64 + m * 16 + fr;
                const f32x4 part = *(const PG8_LAS f32x4*)(xch + rowt * 4); const f32x2 pe2 = *(const f32x2*)(ssqpe + (size_t)row * 2);
                const float rc = rck[ai][m], rk = rsqrtf((sum4(part) + (pe2[0] + pe2[1])) * (1.f / 192.f) + 1e-6f), rr = rc * rk;
                *(u32x4*)(K + (size_t)row * 1152 + h * 192 + c0) = pack8(acc[ai][0][m][0] * rr * g0, acc[ai][0][m][1] * rr * g1);
                *(u32x4*)(V + (size_t)row * 768 + h * 128 + c0) = pack8(acc[ai][1][m][0] * rc, acc[ai][1][m][1] * rc);
                const unsigned a = *(const unsigned*)(KPE + (size_t)row * 64 + i0), b = *(const unsigned*)(KPE + (size_t)row * 64 + 32 + i0);
                const f32x2 cs = *(const f32x2*)(rope + (size_t)row * 64 + i0), sn = *(const f32x2*)(rope + (size_t)row * 64 + 32 + i0);
                const float x1a = __builtin_bit_cast(float, a << 16) * rk * gp1[0], x1b = __builtin_bit_cast(float, a & 0xffff0000u) * rk * gp1[1];
                const float x2a = __builtin_bit_cast(float, b << 16) * rk * gp2[0], x2b = __builtin_bit_cast(float, b & 0xffff0000u) * rk * gp2[1];
                *(unsigned*)(K + (size_t)row * 1152 + h * 192 + 128 + i0) = cvt_pk_bf16(x1a * cs[0] - x2a * sn[0], x1b * cs[1] - x2b * sn[1]);
                *(unsigned*)(K + (size_t)row * 1152 + h * 192 + 160 + i0) = cvt_pk_bf16(x2a * cs[0] + x1a * sn[0], x2b * cs[1] + x1b * sn[1]);
                asm volatile("" ::: "memory"); }
    }
};
struct EpiY { static constexpr bool PERM = true, AFTER_DRAIN = false; static constexpr int MIDK = 0;
    bf16_t* MIX; PG8_LAS float* xch;
    __device__ __forceinline__ void operator()(const f32x4 (&acc)[2][2][4][2], const Unit& u, int wr, int wc, int fr, int fq) const {
        const int row0 = u.pm * BM + wr * 64 + fr, c0 = wc * 32 + 8 * fq;
#pragma unroll
        for (int ai = 0; ai < 2; ++ai)
#pragma unroll
            for (int m = 0; m < 4; ++m) { float s = 0.f;
#pragma unroll
                for (int bj = 0; bj < 2; ++bj) s += ssq4(acc[ai][bj][m][0]) + ssq4(acc[ai][bj][m][1]);
                s = fq_sum(s); if (fq == 0) xch[(ai * HALF + wr * 64 + m * 16 + fr) * 4 + wc] = s; }
        PG8_EPI_BAR();
#pragma unroll
        for (int ai = 0; ai < 2; ++ai)
#pragma unroll
            for (int m = 0; m < 4; ++m) { const int row = row0 + ai * HALF + m * 16, rowt = ai * HALF + wr * 64 + m * 16 + fr;
                const f32x4 part = *(const PG8_LAS f32x4*)(xch + rowt * 4); const float rf = rsqrtf(sum4(part) * (1.f / 256.f) + 1e-6f);
                bf16_t* rowp = MIX + (size_t)row * 1024 + 768 + c0;
#pragma unroll
                for (int bj = 0; bj < 2; ++bj) *(u32x4*)(rowp + bj * HALF) = pack8(acc[ai][bj][m][0] * rf, acc[ai][bj][m][1] * rf);
                asm volatile("" ::: "memory"); }
    }
};
}

namespace att {
using f32x16 = __attribute__((ext_vector_type(16))) float;
using s16x4 = __attribute__((ext_vector_type(4))) short;
constexpr int NW = 8, QBLK = 32, KVBLK = 64, LDQ = 1152, LDK = 1152, LDV = 768;
constexpr int SHM_V = KVBLK * 128 * 2, SHM_K = KVBLK * 192 * 2;
constexpr int OFF_V = 0, OFF_K = 2 * SHM_V, OFF_WS = OFF_K + 2 * SHM_K, ATT_LDS = OFF_WS + NW * 64 * 4;
constexpr float THR = 8.f;
__device__ __forceinline__ int k_st(int key, int cc) { const int d0 = cc >> 1, hh = cc & 1; return d0 * 2048 + ((key * 32 + ((hh ^ ((key >> 3) & 1)) * 16)) ^ ((d0 & 1) * 64)); }
#define SBAR() __builtin_amdgcn_sched_barrier(0)
__device__ __forceinline__ int crow(int r, int hi) { return (r & 3) + 8 * (r >> 2) + 4 * hi; }
__device__ __forceinline__ unsigned cvtpk(float lo, float hi) { unsigned r; asm volatile("v_cvt_pk_bf16_f32 %0, %1, %2" : "=v"(r) : "v"(lo), "v"(hi)); return r; }

__device__ __forceinline__ void partialSM(f32x16& p0, f32x16& p1, float& m_reg, float& mn, float& alpha) {
  float pmax = p0[0];
#pragma unroll
  for (int r = 1; r < 16; ++r) pmax = fmaxf(pmax, p0[r]);
#pragma unroll
  for (int r = 0; r < 16; ++r) pmax = fmaxf(pmax, p1[r]);
  { auto rr = __builtin_amdgcn_permlane32_swap(__float_as_uint(pmax), __float_as_uint(pmax), false, false);
    pmax = fmaxf(__uint_as_float(rr[0]), __uint_as_float(rr[1])); }
  if (__builtin_expect(__all(pmax - m_reg <= THR), 1)) { mn = m_reg; alpha = 1.f; }
  else { mn = fmaxf(m_reg, pmax); alpha = __builtin_amdgcn_exp2f(m_reg - mn); m_reg = mn; }
#pragma unroll
  for (int r = 0; r < 16; ++r) p0[r] = p0[r] - mn;
#pragma unroll
  for (int r = 0; r < 16; ++r) p1[r] = p1[r] - mn;
#pragma unroll
  for (int r = 0; r < 16; ++r) p0[r] = __builtin_amdgcn_exp2f(p0[r]);
}
__device__ __forceinline__ void finishSM(f32x16& p0, f32x16& p1, float alpha, float& l_reg, bf16x8& pa0, bf16x8& pa1, bf16x8& pa2, bf16x8& pa3) {
#pragma unroll
  for (int r = 0; r < 16; ++r) p1[r] = __builtin_amdgcn_exp2f(p1[r]);
  float ps = 0;
#pragma unroll
  for (int r = 0; r < 16; ++r) ps += p0[r];
#pragma unroll
  for (int r = 0; r < 16; ++r) ps += p1[r];
  { auto rr = __builtin_amdgcn_permlane32_swap(__float_as_uint(ps), __float_as_uint(ps), false, false);
    ps = __uint_as_float(rr[0]) + __uint_as_float(rr[1]); }
  l_reg = l_reg * alpha + ps;
#define PK4(P, BASE, OUT) do { unsigned a0 = cvtpk(P[BASE + 0], P[BASE + 1]), a1 = cvtpk(P[BASE + 2], P[BASE + 3]);   \
    unsigned b0 = cvtpk(P[BASE + 4], P[BASE + 5]), b1 = cvtpk(P[BASE + 6], P[BASE + 7]);                              \
    auto r0 = __builtin_amdgcn_permlane32_swap(a0, b0, false, false); auto r1 = __builtin_amdgcn_permlane32_swap(a1, b1, false, false); \
    u32x4 w = {r0[0], r1[0], r0[1], r1[1]}; OUT = *reinterpret_cast<bf16x8*>(&w); } while (0)
  PK4(p0, 0, pa0); PK4(p0, 8, pa1); PK4(p1, 0, pa2); PK4(p1, 8, pa3);
#undef PK4
}
__device__ __forceinline__ void qkt(f32x16& p0, f32x16& p1, const LAS char* Ks, const bf16x8* qr, int kb) {
  p0 = f32x16{}; p1 = f32x16{};
  const LAS char* ke = Ks + kb; const LAS char* ko = Ks + (kb ^ 64);
#pragma unroll
  for (int d0 = 0; d0 < 12; ++d0) { const LAS char* a = (d0 & 1) ? ko : ke;
    const bf16x8 b0 = *(const LAS bf16x8*)(a + d0 * 2048);
    const bf16x8 b1 = *(const LAS bf16x8*)(a + d0 * 2048 + 1024);
    p0 = __builtin_amdgcn_mfma_f32_32x32x16_bf16(b0, qr[d0], p0, 0, 0, 0);
    p1 = __builtin_amdgcn_mfma_f32_32x32x16_bf16(b1, qr[d0], p1, 0, 0, 0); }
}
__device__ __forceinline__ int v_st(int k, int c) { const int kk = (k & ~0xC) | ((k & 4) << 1) | ((k & 8) >> 1); return ((kk >> 3) * 4 + (c >> 5)) * 512 + ((kk & 7) * 32 + (c & 31)) * 2; }
__device__ __forceinline__ int v_rd_base(int lane) { return ((lane & 3) << 3) | (((lane >> 2) & 3) << 6) | (((lane >> 4) & 1) << 5) | (((lane >> 5) & 1) << 8); }
constexpr int v_rd_off(int d0, int ks, int half) { return d0 * 512 + ks * 4096 + half * 2048; }
template <int OFF> __device__ __forceinline__ s16x4 tr_read(int vb) {
  s16x4 r; asm volatile("ds_read_b64_tr_b16 %0, %1 offset:%2" : "=&v"(r) : "v"(vb), "i"(OFF) : "memory"); return r;
}
template <int D0> __device__ __forceinline__ void pv_one(f32x16& od, int vb, bf16x8 pa0, bf16x8 pa1, bf16x8 pa2, bf16x8 pa3) {
  const s16x4 l0 = tr_read<v_rd_off(D0, 0, 0)>(vb), h0 = tr_read<v_rd_off(D0, 0, 1)>(vb), l1 = tr_read<v_rd_off(D0, 1, 0)>(vb), h1 = tr_read<v_rd_off(D0, 1, 1)>(vb);
  const s16x4 l2 = tr_read<v_rd_off(D0, 2, 0)>(vb), h2 = tr_read<v_rd_off(D0, 2, 1)>(vb), l3 = tr_read<v_rd_off(D0, 3, 0)>(vb), h3 = tr_read<v_rd_off(D0, 3, 1)>(vb);
  asm volatile("s_waitcnt lgkmcnt(0)" ::: "memory"); SBAR();
#define PK(L, H) (bf16x8){L[0], L[1], L[2], L[3], H[0], H[1], H[2], H[3]}
  od = __builtin_amdgcn_mfma_f32_32x32x16_bf16(pa0, PK(l0, h0), od, 0, 0, 0);
  od = __builtin_amdgcn_mfma_f32_32x32x16_bf16(pa1, PK(l1, h1), od, 0, 0, 0);
  od = __builtin_amdgcn_mfma_f32_32x32x16_bf16(pa2, PK(l2, h2), od, 0, 0, 0);
  od = __builtin_amdgcn_mfma_f32_32x32x16_bf16(pa3, PK(l3, h3), od, 0, 0, 0);
#undef PK
}
__device__ __forceinline__ void pv_d0(f32x16* o, int vb, bf16x8 pa0, bf16x8 pa1, bf16x8 pa2, bf16x8 pa3) {
  pv_one<0>(o[0], vb, pa0, pa1, pa2, pa3); pv_one<1>(o[1], vb, pa0, pa1, pa2, pa3); pv_one<2>(o[2], vb, pa0, pa1, pa2, pa3); pv_one<3>(o[3], vb, pa0, pa1, pa2, pa3);
}

__device__ __forceinline__ void attn_unit(const bf16_t* __restrict__ Qb, const bf16_t* __restrict__ Kh, const bf16_t* __restrict__ Vh, bf16_t* __restrict__ Ob, float* __restrict__ ssq,
                                          const float* __restrict__ gq, const float* __restrict__ rope, LAS char* lds, const int tid) {
  const int wid = tid >> 6, lane = tid & 63, r32 = lane & 31, hi = lane >> 5;
  LAS char* V_lds = lds + OFF_V; LAS char* K_lds = lds + OFF_K;
  LAS float* wsf = (LAS float*)(lds + OFF_WS) + wid * 64; LAS float* li_l = wsf; LAS float* al_l = wsf + 32;
  float m_reg = -1e30f, l_reg = 0; f32x16 o[4] = {}; bf16x8 qr[12];
  {
    const bf16_t* Qw = Qb + (long)(wid * QBLK + r32) * LDQ + hi * 8;
    bf16x8 raw[12]; float ss = 0.f;
#pragma unroll
    for (int d0 = 0; d0 < 12; ++d0) raw[d0] = *reinterpret_cast<const bf16x8*>(Qw + d0 * 16);
#pragma unroll
    for (int d0 = 0; d0 < 12; ++d0)
#pragma unroll
      for (int j = 0; j < 8; ++j) { const float v = bf2f((bf16_t)raw[d0][j]); ss += v * v; }
    ss = add_xor32(ss);
    const float rq = rsqrtf(ss * (1.f / 192.f) + EPS) * QSCALE;
    const float* rp = rope + (long)(wid * QBLK + r32) * 64 + hi * 8;
#pragma unroll
    for (int d0 = 0; d0 < 8; ++d0) { const f32x4 g0 = *(const f32x4*)(gq + d0 * 16 + hi * 8), g1 = *(const f32x4*)(gq + d0 * 16 + hi * 8 + 4); float v[8];
#pragma unroll
      for (int j = 0; j < 8; ++j) v[j] = bf2f((bf16_t)raw[d0][j]) * rq * (j < 4 ? g0[j] : g1[j - 4]);
      u32x4 w = {cvtpk(v[0], v[1]), cvtpk(v[2], v[3]), cvtpk(v[4], v[5]), cvtpk(v[6], v[7])}; qr[d0] = *reinterpret_cast<bf16x8*>(&w);
      if (d0 & 1) asm volatile("" ::: "memory"); }
#pragma unroll
    for (int dd = 0; dd < 2; ++dd) {
      const f32x4 ga0 = *(const f32x4*)(gq + 128 + dd * 16 + hi * 8), ga1 = *(const f32x4*)(gq + 128 + dd * 16 + hi * 8 + 4);
      const f32x4 gb0 = *(const f32x4*)(gq + 160 + dd * 16 + hi * 8), gb1 = *(const f32x4*)(gq + 160 + dd * 16 + hi * 8 + 4);
      const f32x4 c0 = *(const f32x4*)(rp + dd * 16), c1 = *(const f32x4*)(rp + dd * 16 + 4), s0 = *(const f32x4*)(rp + 32 + dd * 16), s1 = *(const f32x4*)(rp + 32 + dd * 16 + 4);
      float o1[8], o2[8];
#pragma unroll
      for (int j = 0; j < 8; ++j) { const float x1 = bf2f((bf16_t)raw[8 + dd][j]) * rq * (j < 4 ? ga0[j] : ga1[j - 4]), x2 = bf2f((bf16_t)raw[10 + dd][j]) * rq * (j < 4 ? gb0[j] : gb1[j - 4]);
        const float c = j < 4 ? c0[j] : c1[j - 4], s = j < 4 ? s0[j] : s1[j - 4]; o1[j] = x1 * c - x2 * s; o2[j] = x2 * c + x1 * s; }
      u32x4 w1 = {cvtpk(o1[0], o1[1]), cvtpk(o1[2], o1[3]), cvtpk(o1[4], o1[5]), cvtpk(o1[6], o1[7])}; qr[8 + dd] = *reinterpret_cast<bf16x8*>(&w1);
      u32x4 w2 = {cvtpk(o2[0], o2[1]), cvtpk(o2[2], o2[3]), cvtpk(o2[4], o2[5]), cvtpk(o2[6], o2[7])}; qr[10 + dd] = *reinterpret_cast<bf16x8*>(&w2);
      asm volatile("" ::: "memory");
    }
  }
  int t1 = tid; asm volatile("" : "+v"(t1));
  const int sr = t1 >> 4, sc = (t1 & 15) * 8, vst0 = v_st(sr, sc), vst1 = v_st(32 + sr, sc);
  int kgo[3], kst[3];
#pragma unroll
  for (int i = 0; i < 3; ++i) { const int c = t1 + 512 * i, rest = c >> 3, key2 = rest / 6, cch = rest - key2 * 6, key = key2 * 2 + ((c >> 2) & 1), cc = cch * 4 + (c & 3); kgo[i] = key * LDK + cc * 8; kst[i] = k_st(key, cc); }
  const int kb = (t1 & 31) * 32 + ((((t1 >> 5) & 1) ^ ((t1 >> 3) & 1)) * 16);
  const int vb0 = (int)(unsigned)(size_t)V_lds + v_rd_base(t1 & 63);
  bf16x8 sv0, sv1, sk0, sk1, sk2;
#define SLOAD(k0) do { sv0 = *reinterpret_cast<const bf16x8*>(&Vh[(long)((k0) + sr) * LDV + sc]); sv1 = *reinterpret_cast<const bf16x8*>(&Vh[(long)((k0) + 32 + sr) * LDV + sc]); \
    sk0 = *reinterpret_cast<const bf16x8*>(&Kh[(long)(k0) * LDK + kgo[0]]); sk1 = *reinterpret_cast<const bf16x8*>(&Kh[(long)(k0) * LDK + kgo[1]]); sk2 = *reinterpret_cast<const bf16x8*>(&Kh[(long)(k0) * LDK + kgo[2]]); } while (0)
#define SWRITE(b) do { *(LAS bf16x8*)(V_lds + (b) * SHM_V + vst0) = sv0; *(LAS bf16x8*)(V_lds + (b) * SHM_V + vst1) = sv1; \
    *(LAS bf16x8*)(K_lds + (b) * SHM_K + kst[0]) = sk0; *(LAS bf16x8*)(K_lds + (b) * SHM_K + kst[1]) = sk1; *(LAS bf16x8*)(K_lds + (b) * SHM_K + kst[2]) = sk2; } while (0)
#define SWAIT() asm volatile("s_waitcnt vmcnt(0)" ::: "memory")
#define RESC(a) do { if (__any((a) < 1.f)) { if (hi == 0) al_l[r32] = (a); asm volatile("s_waitcnt lgkmcnt(0)" ::: "memory"); \
    _Pragma("unroll") for (int d = 0; d < 4; ++d) _Pragma("unroll") for (int r = 0; r < 16; ++r) o[d][r] *= al_l[crow(r, hi)]; } } while (0)
  f32x16 pA0, pA1, pB0, pB1; float mnA, mnB, alA, alB; bf16x8 pa0, pa1, pa2, pa3; constexpr int NT = SEQ / KVBLK;
  SLOAD(0); SWAIT(); SWRITE(0); __syncthreads();
  qkt(pA0, pA1, K_lds, qr, kb); partialSM(pA0, pA1, m_reg, mnA, alA);
  SLOAD(KVBLK); SWAIT(); SWRITE(1); __syncthreads();
  for (int j = 1; j + 1 < NT; j += 2) {
    SBAR(); qkt(pB0, pB1, K_lds + SHM_K, qr, kb);
    finishSM(pA0, pA1, alA, l_reg, pa0, pa1, pa2, pa3); SBAR();
    SLOAD((j + 1) * KVBLK); SBAR();
    pv_d0(o, vb0, pa0, pa1, pa2, pa3); partialSM(pB0, pB1, m_reg, mnB, alB);
    __syncthreads(); SWAIT(); SWRITE(0);
    RESC(alB); __syncthreads();
    SBAR(); qkt(pA0, pA1, K_lds, qr, kb);
    finishSM(pB0, pB1, alB, l_reg, pa0, pa1, pa2, pa3); SBAR();
    SLOAD((j + 2) * KVBLK); SBAR();
    pv_d0(o, vb0 + SHM_V, pa0, pa1, pa2, pa3); partialSM(pA0, pA1, m_reg, mnA, alA);
    __syncthreads(); SWAIT(); SWRITE(1);
    RESC(alA); __syncthreads();
  }
  SBAR(); qkt(pB0, pB1, K_lds + SHM_K, qr, kb);
  finishSM(pA0, pA1, alA, l_reg, pa0, pa1, pa2, pa3); SBAR();
  pv_d0(o, vb0, pa0, pa1, pa2, pa3); partialSM(pB0, pB1, m_reg, mnB, alB);
  __syncthreads(); RESC(alB);
  finishSM(pB0, pB1, alB, l_reg, pa0, pa1, pa2, pa3); SBAR();
  pv_d0(o, vb0 + SHM_V, pa0, pa1, pa2, pa3);
  if (hi == 0) li_l[r32] = l_reg;
  __syncthreads();
  { int t2 = tid; asm volatile("" : "+v"(t2));
  const int wid = t2 >> 6, lane = t2 & 63, r32 = lane & 31, hi = lane >> 5;
  LAS float* li_l = (LAS float*)(lds + OFF_WS) + wid * 64;
  LAS bf16_t* stg = (LAS bf16_t*)(lds + wid * 8192);
#pragma unroll
  for (int r = 0; r < 16; ++r) { const int orow = crow(r, hi); const float rl = __builtin_amdgcn_rcpf(li_l[orow]);
#pragma unroll
    for (int d0 = 0; d0 < 4; ++d0) stg[orow * 128 + d0 * 32 + r32] = (bf16_t)(cvtpk(o[d0][r] * rl, 0.f) & 0xffffu); }
  asm volatile("s_waitcnt lgkmcnt(0)" ::: "memory");
  { const int row = lane >> 1, half = lane & 1; const LAS u32x4* src = (const LAS u32x4*)(stg + row * 128 + half * 64); float s = 0.f;
    bf16_t* orow = Ob + (long)(wid * QBLK + row) * 1024 + half * 64;
#pragma unroll
    for (int i = 0; i < 8; ++i) { const u32x4 v = src[i]; *(u32x4*)(orow + i * 8) = v;
#pragma unroll
      for (int e = 0; e < 4; ++e) { const float a = __builtin_bit_cast(float, v[e] << 16), b = __builtin_bit_cast(float, v[e] & 0xffff0000u); s += a * a + b * b; } }
    s = add_xor1(s);
    if (half == 0) ssq[(long)(wid * QBLK + row) * 8] = s; }
  }
  __syncthreads();
#undef SLOAD
#undef SWRITE
#undef SWAIT
#undef RESC
}
#undef SBAR
}

constexpr int NWAVES = 8, MK_THREADS = NWAVES * 64;
constexpr int MK_LDS = 147456, XCH_OFF = 131072;

__device__ __forceinline__ void tr_item(const float* W, int K, int N, int koff, const float* g1, const float* g2, int ksplit, bf16_t* WT, LAS float* scr, int item, int lane) {
    const int nblk = N / 32, kb = item / nblk, nb = item % nblk, k0 = 64 * kb, n0 = 32 * nb;
#pragma unroll 8
    for (int i = 0; i < 32; ++i) {
        const int kk = 2 * i + (lane >> 5), kp = k0 + kk, ks = (kp + koff) & (K - 1);
        const float g = g1 ? (kp < ksplit ? g1[kp] : g2[kp - ksplit]) : 1.f;
        scr[kk * 33 + (lane & 31)] = W[(size_t)ks * N + n0 + (lane & 31)] * g;
    }
    asm volatile("s_waitcnt lgkmcnt(0)" ::: "memory");
    const int c = lane & 7;
#pragma unroll
    for (int j = 0; j < 4; ++j) {
        const int n = (lane >> 3) + 8 * j; const LAS float* s = scr + (8 * c) * 33 + n;
        u32x4 o; o.x = pk2(s[0 * 33], s[1 * 33]); o.y = pk2(s[2 * 33], s[3 * 33]); o.z = pk2(s[4 * 33], s[5 * 33]); o.w = pk2(s[6 * 33], s[7 * 33]);
        *(u32x4*)(WT + (size_t)(n0 + n) * K + k0 + 8 * c) = o;
    }
    asm volatile("s_waitcnt lgkmcnt(0)" ::: "memory");
}

__device__ __forceinline__ void phase_prologue(const Params& p, LAS unsigned char* lds, const int tid) {
    const int lane = tid & 63, wave = tid >> 6;
    const int G = gridDim.x, gw = blockIdx.x * NWAVES + wave, NGW = G * NWAVES;
    const int gt = blockIdx.x * MK_THREADS + tid, NGT = G * MK_THREADS;
    LAS float* tab = (LAS float*)lds;
    LAS float* scr = (LAS float*)(lds + 8192 + wave * 8704);
    for (int j = tid; j < 2048; j += MK_THREADS) tab[j] = cospif((float)j * (1.0f / 1024.0f));
    __syncthreads();
    unsigned char* ws = p.ws;
    {
        constexpr int I_IN = 16 * 26, I_QU = 4 * 36, I_KV = 4 * 48, I_OUT = 16 * 32, I_MI = 16 * 128, I_MO = 64 * 32, I_L = I_IN + I_QU + I_KV + I_OUT + I_MI + I_MO;
        for (int it = gw; it < DEPTH * I_L; it += NGW) {
            const int l = it / I_L; int r = it % I_L; unsigned char* wl = ws + WS_W + (size_t)l * LW;
            if (r < I_IN) { tr_item(p.in[I_WIN] + (size_t)l * DM * INW, DM, INW, 0, p.in[I_ANG] + l * DM, nullptr, DM, (bf16_t*)(wl + OW_IN), scr, r, lane); continue; } r -= I_IN;
            if (r < I_QU) { tr_item(p.in[I_WQUP] + (size_t)l * QL * QUPW, QL, QUPW, 0, p.in[I_QAG] + l * QL, nullptr, QL, (bf16_t*)(wl + OW_QUP), scr, r, lane); continue; } r -= I_QU;
            if (r < I_KV) { tr_item(p.in[I_WKVUP] + (size_t)l * KVL * KVUPW, KVL, KVUPW, 0, p.in[I_KVAG] + l * KVL, nullptr, KVL, (bf16_t*)(wl + OW_KVUP), scr, r, lane); continue; } r -= I_KV;
            if (r < I_OUT) { tr_item(p.in[I_WOUT] + (size_t)l * DM * DM, DM, DM, FW, p.in[I_AOG] + l * AW, p.in[I_FOG] + l * FW, AW, (bf16_t*)(wl + OW_OUT), scr, r, lane); continue; } r -= I_OUT;
            if (r < I_MI) { tr_item(p.in[I_WMI] + (size_t)l * DM * FF, DM, FF, 0, p.in[I_MNG] + l * DM, nullptr, DM, (bf16_t*)(wl + OW_MI), scr, r, lane); continue; } r -= I_MI;
            tr_item(p.in[I_WMO] + (size_t)l * FF * DM, FF, DM, 0, nullptr, nullptr, FF, (bf16_t*)(wl + OW_MO), scr, r, lane);
        }
    }
    {
        constexpr int C_IN = (INWP - INW) * DM / 8, C_QU = (QUPWP - QUPW) * QL / 8, C_L = C_IN + C_QU;
        for (int i = gt; i < DEPTH * C_L; i += NGT) {
            const int l = i / C_L, r = i % C_L; unsigned char* wl = ws + WS_W + (size_t)l * LW;
            u32x4* dst = (r < C_IN) ? (u32x4*)(wl + OW_IN + (size_t)INW * DM * 2) + r : (u32x4*)(wl + OW_QUP + (size_t)QUPW * QL * 2) + (r - C_IN);
            *dst = (u32x4){0u, 0u, 0u, 0u};
        }
    }
    {
        bf16_t* F = (bf16_t*)(ws + WS_F);
        for (int ci = gt; ci < 4096 * 256; ci += NGT) {
            const int r = ci >> 8, s0 = (ci & 255) * 8, pq = r >> 11, sp = r & 2047, sh = pq ? 1536 : 0;
            float v[8];
#pragma unroll
            for (int e = 0; e < 8; ++e) v[e] = tab[(sp * (s0 + e) + sh) & 2047];
            u32x4 o; o.x = pk2(v[0], v[1]); o.y = pk2(v[2], v[3]); o.z = pk2(v[4], v[5]); o.w = pk2(v[6], v[7]);
            *(u32x4*)(F + (size_t)r * 2048 + s0) = o;
        }
    }
    {
        for (int i = gt; i < DEPTH * 256 * 512; i += NGT) {
            const int l = i / (256 * 512), r = i % (256 * 512), n = r >> 9, k = r & 511, g = n >> 6, d = n & 63, pq = k >> 8, g2 = (k >> 6) & 3, c = k & 63;
            float acc = 0.f;
            if (g2 == g) {
                const float* wf = p.in[I_WF] + ((size_t)(l * 4 + g) * 64) * 64 + d;
                const int sh = pq ? 1536 : 0;
                for (int c2 = 0; c2 < 64; ++c2) acc += tab[((((c * c2) & 63) * 32) + sh) & 2047] * wf[(size_t)c2 * 64];
                acc *= pq ? -DFT_NRM : DFT_NRM;
            }
            ((bf16_t*)(ws + WS_W + (size_t)l * LW + OW_Y))[r] = (bf16_t)f2bf(acc);
        }
    }
    {
        bf16_t* XB = (bf16_t*)(ws + WS_XB); float* SSQ = (float*)(ws + WS_SSQX);
        for (int m = gw; m < T; m += NGW) {
            const f32x4* xr = (const f32x4*)(p.x + (size_t)m * DM) + lane; f32x4 v[4]; float s = 0.f;
#pragma unroll
            for (int j = 0; j < 4; ++j) { v[j] = xr[64 * j]; s += (v[j].x * v[j].x + v[j].y * v[j].y) + (v[j].z * v[j].z + v[j].w * v[j].w); }
            s = wave_sum(s);
            u32x2* o8 = (u32x2*)(XB + (size_t)m * DM) + lane;
#pragma unroll
            for (int j = 0; j < 4; ++j) o8[64 * j] = (u32x2){pk2(v[j].x, v[j].y), pk2(v[j].z, v[j].w)};
            if (lane < 16) SSQ[(size_t)m * 16 + lane] = lane == 0 ? s : 0.f;
        }
    }
    {
        float* R = (float*)(ws + WS_ROPE);
        for (int i = gt; i < T * 32; i += NGT) {
            const int row = i >> 5, j = i & 31;
            const float inv = powf(10000.0f, -(float)j * (1.0f / 32.0f));
            const float ang = (float)p.pos[row] * inv;
            R[(size_t)row * 64 + j] = cosf(ang); R[(size_t)row * 64 + 32 + j] = sinf(ang);
        }
    }
}

constexpr int N_PHASES = 1 + 6 * DEPTH;
#ifndef PHM
#define PHM 0xffff
#endif
__global__ void __launch_bounds__(MK_THREADS, 2) mk(Params p) {
    extern __shared__ __attribute__((aligned(16))) unsigned char lds_raw[];
    LAS unsigned char* lds = (LAS unsigned char*)lds_raw;
    const int G = gridDim.x, bid = blockIdx.x;
#define BP(off) ((bf16_t*)(ws + (off)))
#define FP(off) ((float*)(ws + (off)))
    cooperative_groups::grid_group grid = cooperative_groups::this_grid();
    if (p.ph_lo == 0) {
        phase_prologue(p, lds, threadIdx.x);
        __syncthreads();
        if (p.ph_hi > 1) grid.sync();
    }
    for (int ph = p.ph_lo < 1 ? 1 : p.ph_lo; ph < p.ph_hi; ++ph) {
        int tid = threadIdx.x; asm volatile("" : "+v"(tid));
        unsigned char* ws; { unsigned long long w_ = (unsigned long long)p.ws; asm volatile("" : "+s"(w_)); ws = (unsigned char*)(__attribute__((address_space(1))) unsigned char*)w_; }
        {
            const int l = (ph - 1) / 6, s = (ph - 1) % 6;
            unsigned char* wl = ws + WS_W + (size_t)l * LW;
            pg8::StaticOrder S;
            if (s == 0 && ((PHM & 1) != 0)) {
                pg8::Gemm g{BP(WS_XB), (const bf16_t*)(wl + OW_IN), T, INWP, DM}; S.init(T, INWP, G, bid);
                pg8::EpiIn E{FP(WS_SSQX), BP(WS_UT), BP(WS_CQ), BP(WS_CKV), BP(WS_KPE), FP(WS_SSQCQ), FP(WS_SSQCKV), FP(WS_SSQPE)};
                pg8::gemm_phase<pg8::EpiIn, pg8::StaticOrder, true, true>(lds, g, S, E, tid);
            } else if (s == 1 && ((PHM & 2) != 0)) {
                if ((p.sub & 1) && ((PHM & 64) != 0)) { pg8::Gemm g{BP(WS_F), BP(WS_UT), 4096, 4096, 2048}; S.init(4096, 4096, G, bid); pg8::EpiDft E{BP(WS_PQ)};
                    pg8::gemm_phase<pg8::EpiDft, pg8::StaticOrder, true, true>(lds, g, S, E, tid); }
                if ((p.sub & 2) && ((PHM & 128) != 0)) { pg8::Gemm g{BP(WS_CQ), (const bf16_t*)(wl + OW_QUP), T, QUPWP, QL}; S.init(T, QUPWP, G, bid); pg8::EpiQ E{FP(WS_SSQCQ), BP(WS_Q)};
                    pg8::gemm_phase<pg8::EpiQ, pg8::StaticOrder, true, true>(lds, g, S, E, tid); }
                if ((p.sub & 4) && ((PHM & 512) != 0)) { pg8::Gemm g{BP(WS_CKV), (const bf16_t*)(wl + OW_KVUP), T, KVUPW, KVL}; S.init(T, KVUPW, G, bid);
                    pg8::EpiKV E{FP(WS_SSQCKV), FP(WS_SSQPE), p.in[I_KNG] + l * QKD, FP(WS_ROPE), BP(WS_KPE), BP(WS_K), BP(WS_V), (LAS float*)(lds + XCH_OFF)};
                    pg8::gemm_phase<pg8::EpiKV, pg8::StaticOrder, true, true>(lds, g, S, E, tid); }
            } else if (s == 2 && ((PHM & 4) != 0)) {
                if ((p.sub & 1) && ((PHM & 1024) != 0)) {
                    const int vcu = (G % 8 == 0) ? (bid % 8) * (G / 8) + bid / 8 : bid;
                    for (int ui = vcu; ui < BATCH * NH * 8; ui += G) { const int bh = ui >> 3, qb = ui & 7, b = bh / NH, h = bh - b * NH; const size_t row0 = (size_t)b * SEQ + qb * 256;
                        att::attn_unit(BP(WS_Q) + row0 * QUPW + h * QKD, BP(WS_K) + (size_t)b * SEQ * QUPW + h * QKD, BP(WS_V) + (size_t)b * SEQ * AW + h * VD, BP(WS_MIX) + row0 * 1024 + h * VD,
                                       FP(WS_SSQA) + row0 * 8 + h, p.in[I_QNG] + l * QKD, FP(WS_ROPE) + row0 * 64, (LAS char*)lds, tid); }
                }
                if ((p.sub & 2) && ((PHM & 2048) != 0)) { pg8::Gemm g{BP(WS_PQ), (const bf16_t*)(wl + OW_Y), T, 256, 512}; S.init(T, 256, G, bid);
                    pg8::EpiY E{BP(WS_MIX), (LAS float*)(lds + XCH_OFF)};
                    pg8::gemm_phase<pg8::EpiY, pg8::StaticOrder, true, true>(lds, g, S, E, tid); }
            } else if (s == 3 && ((PHM & 8) != 0)) {
                pg8::Gemm g{BP(WS_MIX), (const bf16_t*)(wl + OW_OUT), T, DM, DM}; S.init(T, DM, G, bid);
                pg8::EpiRes<12> E{l == 0 ? p.x : p.out, p.out, BP(WS_XB), FP(WS_SSQX), FP(WS_SSQA)};
                pg8::gemm_phase<pg8::EpiRes<12>, pg8::StaticOrder, true, true>(lds, g, S, E, tid);
            } else if (s == 4 && ((PHM & 16) != 0)) {
                pg8::Gemm g{BP(WS_XB), (const bf16_t*)(wl + OW_MI), T, FF, DM}; S.init(T, FF, G, bid);
                pg8::EpiMlpIn E{FP(WS_SSQX), BP(WS_H)};
                pg8::gemm_phase<pg8::EpiMlpIn, pg8::StaticOrder, true, true>(lds, g, S, E, tid);
            } else if ((PHM & 32) != 0) {
                pg8::Gemm g{BP(WS_H), (const bf16_t*)(wl + OW_MO), T, DM, FF}; S.init(T, DM, G, bid);
                pg8::EpiRes<0> E{p.out, p.out, BP(WS_XB), FP(WS_SSQX), nullptr};
                pg8::gemm_phase<pg8::EpiRes<0>, pg8::StaticOrder, true, true>(lds, g, S, E, tid);
            }
        }
        __syncthreads();
        if (ph + 1 < p.ph_hi) grid.sync();
    }
}


extern "C" void kernel_launch(void* const* d_in, const int* in_sizes, int n_in, void* d_out, int out_size, void* d_ws, size_t ws_size, hipStream_t stream) {
    static int grid = 0;
    if (grid == 0) {
        if (n_in != 17 || in_sizes[0] != T * DM || out_size != T * DM || ws_size < WS_END) {
            fprintf(stderr, "kernel_launch: shape/workspace mismatch: n_in %d in0 %d out %d ws %zu (need %zu)\n", n_in, n_in > 0 ? in_sizes[0] : -1, out_size, ws_size, (size_t)WS_END);
            grid = -1; return; }
        if (hipFuncSetAttribute((const void*)mk, hipFuncAttributeMaxDynamicSharedMemorySize, MK_LDS) != hipSuccess) { fprintf(stderr, "kernel_launch: hipFuncSetAttribute failed\n"); grid = -1; return; }
        int dev = 0, cus = 0, per_cu = 0;
        if (hipGetDevice(&dev) != hipSuccess || hipDeviceGetAttribute(&cus, hipDeviceAttributeMultiprocessorCount, dev) != hipSuccess) { fprintf(stderr, "kernel_launch: device query failed\n"); grid = -1; return; }
        if (hipOccupancyMaxActiveBlocksPerMultiprocessor(&per_cu, (const void*)mk, MK_THREADS, MK_LDS) != hipSuccess || per_cu < 1) { fprintf(stderr, "kernel_launch: occupancy query says %d blocks per CU\n", per_cu); grid = -1; return; }
        grid = cus;
    }
    if (grid < 0) return;
    Params p{};
    p.x = (const float*)d_in[0]; p.pos = (const int*)d_in[1];
    for (int i = 0; i < 15; ++i) p.in[i] = (const float*)d_in[2 + i];
    p.out = (float*)d_out; p.ws = (unsigned char*)d_ws; p.ph_lo = 0; p.ph_hi = N_PHASES; p.sub = 7; p.pad = 0;
    void* args[] = {&p};
    const hipError_t le = hipLaunchCooperativeKernel((const void*)mk, dim3(grid), dim3(MK_THREADS), args, MK_LDS, stream);
    if (le != hipSuccess) fprintf(stderr, "kernel_launch: cooperative launch failed: %s (grid %d)\n", hipGetErrorName(le), grid);
}
```

```cpp
#include <hip/hip_runtime.h>
#include <cstdio>
#include <cstdint>

typedef unsigned short bf16_t;
typedef short bf16x8 __attribute__((ext_vector_type(8)));
typedef float f32x4 __attribute__((ext_vector_type(4)));
typedef unsigned u32x4 __attribute__((ext_vector_type(4)));
typedef unsigned u32x2 __attribute__((ext_vector_type(2)));
#define LAS __attribute__((address_space(3)))

constexpr int BATCH = 16, SEQ = 2048, DM = 1024, T = BATCH * SEQ, DEPTH = 2;
constexpr int FW = 256, QL = 256, KVL = 256, ROPE_D = 64, NOPE = 128, VD = 128, NH = 6, QKD = 192;
constexpr int INW = 832, INWP = 1024, QUPW = NH * QKD  , QUPWP = 1280, KVUPW = NH * 256  , AW = NH * VD  , FF = 4096;
constexpr float EPS = 1e-6f;
constexpr float QSCALE = 0.07216878364870322f * 1.4426950408889634f;
constexpr float DFT_NRM = 0.0027621358640099515f;

constexpr size_t MiB = 1u << 20;
constexpr size_t WS_CTL = 0;
constexpr size_t WS_W = 1 * MiB, LW = 22 * MiB;
constexpr size_t OW_IN = 0, OW_QUP = 2 * MiB, OW_KVUP = OW_QUP + 640 * 1024, OW_OUT = OW_KVUP + 768 * 1024, OW_MI = OW_OUT + 2 * MiB, OW_MO = OW_MI + 8 * MiB, OW_Y = OW_MO + 8 * MiB;
static_assert(OW_Y + 256 * 1024 <= LW, "layer weight block");
constexpr size_t WS_F = 45 * MiB;
constexpr size_t WS_SSQX = 61 * MiB;
constexpr size_t WS_SSQCQ = 63 * MiB, WS_SSQCKV = WS_SSQCQ + 512 * 1024;
constexpr size_t WS_XB = 64 * MiB;
constexpr size_t WS_MIX = 128 * MiB;
constexpr size_t WS_Q = 192 * MiB;
constexpr size_t WS_K = 264 * MiB;
constexpr size_t WS_V = 336 * MiB;
constexpr size_t WS_PQ = 384 * MiB;
constexpr size_t WS_UT = 416 * MiB;
constexpr size_t WS_H = 192 * MiB;
constexpr size_t WS_CQ = 448 * MiB, WS_CKV = 464 * MiB;
constexpr size_t WS_KPE = 480 * MiB;
constexpr size_t WS_ROPE = 484 * MiB;
constexpr size_t WS_SSQPE = 492 * MiB;
constexpr size_t WS_SSQA = WS_SSQPE + 256 * 1024;
constexpr size_t WS_RSTD = 494 * MiB;
constexpr size_t WS_END = 495 * MiB;
constexpr size_t WS_KRAW = 384 * MiB;
constexpr size_t WS_S = 384 * MiB;

__device__ __forceinline__ unsigned f2bf(float f) { unsigned u = __builtin_bit_cast(unsigned, f); return (u + 0x7fffu + ((u >> 16) & 1u)) >> 16; }
__device__ __forceinline__ unsigned pk2(float lo, float hi) { return f2bf(lo) | (f2bf(hi) << 16); }
__device__ __forceinline__ float bf2f(bf16_t h) { return __builtin_bit_cast(float, (unsigned)h << 16); }
__device__ __forceinline__ float add_xor32(float v) { auto rr = __builtin_amdgcn_permlane32_swap(__float_as_uint(v), __float_as_uint(v), false, false); return __uint_as_float(rr[0]) + __uint_as_float(rr[1]); }
__device__ __forceinline__ float add_xor16(float v) { return v + __uint_as_float(__builtin_amdgcn_ds_swizzle(__float_as_uint(v), 0x401F)); }
__device__ __forceinline__ float add_xor1(float v) { return v + __uint_as_float(__builtin_amdgcn_ds_swizzle(__float_as_uint(v), 0x041F)); }
__device__ __forceinline__ float wave_sum(float v) {
#pragma unroll
    for (int o = 1; o < 64; o <<= 1) v += __shfl_xor(v, o);
    return v;
}

struct Params {
    const float* x; const int* pos; const float* in[15];
    float* out; unsigned char* ws; int ph_lo, ph_hi, sub, pad;
};
enum { I_ANG = 0, I_WIN, I_WF, I_QAG, I_WQUP, I_KVAG, I_WKVUP, I_QNG, I_KNG, I_FOG, I_AOG, I_WOUT, I_MNG, I_WMI, I_WMO };

namespace pg8 {
#define PG8_LAS __attribute__((address_space(3)))
typedef unsigned short bf16_t;
typedef short bf16x8 __attribute__((ext_vector_type(8)));
typedef float f32x4 __attribute__((ext_vector_type(4)));
typedef unsigned u32x4 __attribute__((ext_vector_type(4)));
constexpr int BM = 256, BK = 64, HALF = 128, HTB = HALF * BK * 2  , STAGE_BYTES = 8 * HTB, NXCD = 8, WGM = 8;

__host__ __device__ __forceinline__ int lds_byte(int r, int c) { const int st = (r >> 4) * 2 + (c >> 5), rr = r & 15, cc = c & 31, ob = rr * 64 + cc * 2; return st * 1024 + (ob ^ (((ob >> 9) & 1) << 5)); }
__host__ __device__ __forceinline__ void stage_rc(int b, int& R, int& C) { const int st = b / 1024, sb = b % 1024, swz = sb ^ (((sb >> 9) & 1) << 5); R = (st >> 1) * 16 + swz / 64; C = (st & 1) * 32 + (swz % 64) / 2; }
__host__ __device__ __forceinline__ int perm32(int rho) { const int n = rho >> 4, i = rho & 15; return 8 * (i >> 2) + 4 * n + (i & 3); }

struct Unit { int pm, pn; };
struct Gemm { const bf16_t* A; const bf16_t* Bt; int M, N, K; };

struct StaticOrder {
    int nM, nN, nwg, G, c;
    __host__ __device__ void init(int M, int N, int G_, int c_) { nM = M / BM; nN = N / BM; nwg = nM * nN; G = G_; c = c_; }
    __host__ __device__ bool next(int i, Unit& u) const {
        const long L = (long)i * G + c; if (L >= nwg) return false;
        int wgid = (int)L; { const int q = nwg / NXCD, r = nwg % NXCD, xcd = wgid % NXCD, off = wgid / NXCD; wgid = (xcd < r ? xcd * (q + 1) : r * (q + 1) + (xcd - r) * q) + off; }
        const int nig = WGM * nN, gid = wgid / nig, fm = gid * WGM, gsz = (nM - fm) < WGM ? (nM - fm) : WGM;
        u.pm = fm + ((wgid % nig) % gsz); u.pn = (wgid % nig) / gsz; return true;
    }
    __device__ __forceinline__ void a_ready(const Unit&) const {}
    __device__ __forceinline__ void done(const Unit&) const {}
};

template <class Epi, class Sched, bool ALIGN_EPI = false, bool SP2 = false>
__device__ __forceinline__ void gemm_phase(PG8_LAS unsigned char* lds, const Gemm g, const Sched& S, const Epi& E, const int tid) {
    const int wid = __builtin_amdgcn_readfirstlane(tid >> 6), lane = tid & 63, wr = wid >> 2, wc = wid & 3, fr = lane & 15, fq = lane >> 4;
    int K_ = g.K; asm volatile("" : "+s"(K_));
    const int K = K_, nt = K / BK;
    unsigned voffA[2], voffB[2];
#pragma unroll
    for (int i = 0; i < 2; ++i) { int R, C; stage_rc(tid * 16 + i * 8192, R, C); const int Rb = Epi::PERM ? ((R & ~31) + perm32(R & 31)) : R;
        voffA[i] = (unsigned)(R * K + C) * 2u; voffB[i] = (unsigned)(Rb * K + C) * 2u; }
    const size_t kstep = (size_t)(BK * 2);
    const size_t hstep = (size_t)HALF * K * 2;
    const size_t tstep = 2 * hstep;
    const unsigned ldsw = (unsigned)wid * 1024u;
    const int aoff = lds_byte(wr * 64 + fr, fq * 8), boff = lds_byte(wc * 32 + fr, fq * 8);
#define PG8_SA(b, h) (((b) * 2 + (h)) * HTB)
#define PG8_SB(b, h) ((4 + (b) * 2 + (h)) * HTB)
#define PG8_STAGE(bufoff, gbase, voff) do { _Pragma("unroll") for (int _i = 0; _i < 2; ++_i) \
        __builtin_amdgcn_global_load_lds((const unsigned*)((const char*)(gbase) + (voff)[_i]), (PG8_LAS unsigned*)(lds + (bufoff) + ldsw + _i * 8192), 16, 0, 0); } while (0)
#define PG8_LDA(dst, b, h) do { _Pragma("unroll") for (int m = 0; m < 4; ++m) _Pragma("unroll") for (int k = 0; k < 2; ++k) dst[m][k] = *(const PG8_LAS bf16x8*)(lds + PG8_SA(b, h) + aoff + m * 2048 + k * 1024); } while (0)
#define PG8_LDB(dst, b, h) do { _Pragma("unroll") for (int n = 0; n < 2; ++n) _Pragma("unroll") for (int k = 0; k < 2; ++k) dst[n][k] = *(const PG8_LAS bf16x8*)(lds + PG8_SB(b, h) + boff + n * 2048 + k * 1024); } while (0)
#define PG8_MMA(ai, bj, At, Bt) do { __builtin_amdgcn_s_setprio(1); _Pragma("unroll") for (int m = 0; m < 4; ++m) _Pragma("unroll") for (int n = 0; n < 2; ++n) _Pragma("unroll") for (int k = 0; k < 2; ++k) \
        acc[ai][bj][m][n] = __builtin_amdgcn_mfma_f32_16x16x32_bf16(Bt[n][k], At[m][k], acc[ai][bj][m][n], 0, 0, 0); __builtin_amdgcn_s_setprio(0); } while (0)
#define PG8_WAIT_V(n) asm volatile("s_waitcnt vmcnt(" #n ")" ::: "memory")
#define PG8_WAIT_L(n) asm volatile("s_waitcnt lgkmcnt(" #n ")" ::: "memory")
#define PG8_BAR __builtin_amdgcn_s_barrier()
#define PG8_SCHED __builtin_amdgcn_sched_barrier(0)
    Unit cur, nxt; int ui = 0;
    if (!S.next(0, cur)) return;
    f32x4 acc[2][2][4][2];
#pragma unroll
    for (int a = 0; a < 2; ++a)
#pragma unroll
        for (int b = 0; b < 2; ++b)
#pragma unroll
            for (int m = 0; m < 4; ++m)
#pragma unroll
                for (int n = 0; n < 2; ++n) acc[a][b][m][n] = (f32x4){0.f, 0.f, 0.f, 0.f};
    bf16x8 At[4][2], B0[2][2], B1[2][2];
    const char* cA = (const char*)g.A + (size_t)cur.pm * tstep; const char* cB = (const char*)g.Bt + (size_t)cur.pn * tstep;
    S.a_ready(cur);
    if constexpr (SP2) {
        PG8_STAGE(PG8_SB(0, 0), cB, voffB); PG8_STAGE(PG8_SB(0, 1), cB + hstep, voffB); PG8_STAGE(PG8_SA(0, 0), cA, voffA); PG8_STAGE(PG8_SA(0, 1), cA + hstep, voffA);
        if (wr == 1) PG8_BAR;
        PG8_WAIT_V(2); PG8_BAR;
        PG8_STAGE(PG8_SB(1, 0), cB + kstep, voffB); PG8_STAGE(PG8_SA(1, 0), cA + kstep, voffA); PG8_STAGE(PG8_SB(1, 1), cB + hstep + kstep, voffB);
        PG8_WAIT_V(6); PG8_BAR;
    } else {
        PG8_STAGE(PG8_SB(0, 0), cB, voffB); PG8_STAGE(PG8_SA(0, 0), cA, voffA); PG8_STAGE(PG8_SB(0, 1), cB + hstep, voffB); PG8_STAGE(PG8_SA(0, 1), cA + hstep, voffA);
        if (wr == 1) PG8_BAR;
        PG8_WAIT_V(4); PG8_BAR;
        PG8_STAGE(PG8_SB(1, 0), cB + kstep, voffB); PG8_STAGE(PG8_SA(1, 0), cA + kstep, voffA); PG8_STAGE(PG8_SB(1, 1), cB + hstep + kstep, voffB);
        PG8_WAIT_V(6); PG8_BAR;
    }
    for (;;) {
        const bool has_next = S.next(ui + 1, nxt);
        const char* nA = has_next ? (const char*)g.A + (size_t)nxt.pm * tstep : cA; const char* nB = has_next ? (const char*)g.Bt + (size_t)nxt.pn * tstep : cB;
        for (int t = 0; t < nt; t += 2) {
            const bool last = (t == nt - 2);
            const char* a1 = cA + (size_t)(t + 1) * kstep;
            const char* a2 = last ? nA : cA + (size_t)(t + 2) * kstep; const char* b2 = last ? nB : cB + (size_t)(t + 2) * kstep;
            const char* a3 = a2 + kstep; const char* b3 = b2 + kstep;
            if (last && has_next) S.a_ready(nxt);
            if constexpr (SP2) {
            PG8_LDB(B0, 0, 0); PG8_LDB(B1, 0, 1); PG8_SCHED; PG8_LDA(At, 0, 0); PG8_STAGE(PG8_SA(1, 1), a1 + hstep, voffA);
            PG8_WAIT_V(8); PG8_WAIT_L(0); PG8_BAR; PG8_MMA(0, 0, At, B0); PG8_MMA(0, 1, At, B1); PG8_BAR; PG8_SCHED;
            PG8_LDA(At, 0, 1); PG8_STAGE(PG8_SB(0, 0), b2, voffB); PG8_STAGE(PG8_SB(0, 1), b2 + hstep, voffB); PG8_STAGE(PG8_SA(0, 0), a2, voffA);
            PG8_WAIT_V(8); PG8_WAIT_L(0); PG8_BAR; PG8_MMA(1, 0, At, B0); PG8_MMA(1, 1, At, B1); PG8_BAR; PG8_SCHED;
            PG8_LDB(B0, 1, 0); PG8_LDB(B1, 1, 1); PG8_SCHED; PG8_LDA(At, 1, 0); PG8_STAGE(PG8_SA(0, 1), a2 + hstep, voffA);
            PG8_WAIT_V(8); PG8_WAIT_L(0); PG8_BAR; PG8_MMA(0, 0, At, B0); PG8_MMA(0, 1, At, B1); PG8_BAR; PG8_SCHED;
            PG8_LDA(At, 1, 1); PG8_STAGE(PG8_SB(1, 0), b3, voffB); PG8_STAGE(PG8_SB(1, 1), b3 + hstep, voffB); PG8_STAGE(PG8_SA(1, 0), a3, voffA);
            PG8_WAIT_V(8); PG8_WAIT_L(0); PG8_BAR; PG8_MMA(1, 0, At, B0); PG8_MMA(1, 1, At, B1); PG8_BAR; PG8_SCHED;
            } else {
            PG8_LDB(B0, 0, 0); PG8_SCHED; PG8_LDA(At, 0, 0); PG8_STAGE(PG8_SA(1, 1), a1 + hstep, voffA);
            PG8_WAIT_L(8); PG8_BAR; PG8_WAIT_L(0); PG8_MMA(0, 0, At, B0); PG8_BAR; PG8_SCHED;
            PG8_LDB(B1, 0, 1); PG8_STAGE(PG8_SB(0, 0), b2, voffB);
            PG8_BAR; PG8_WAIT_L(0); PG8_MMA(0, 1, At, B1); PG8_BAR;
            PG8_LDA(At, 0, 1); PG8_STAGE(PG8_SA(0, 0), a2, voffA);
            PG8_BAR; PG8_WAIT_L(0); PG8_MMA(1, 0, At, B0); PG8_BAR; PG8_SCHED;
            PG8_STAGE(PG8_SB(0, 1), b2 + hstep, voffB);
            PG8_WAIT_V(6); PG8_BAR; PG8_MMA(1, 1, At, B1); PG8_BAR;
            PG8_LDB(B0, 1, 0); PG8_SCHED; PG8_LDA(At, 1, 0); PG8_STAGE(PG8_SA(0, 1), a2 + hstep, voffA);
            PG8_WAIT_L(8); PG8_BAR; PG8_WAIT_L(0); PG8_MMA(0, 0, At, B0); PG8_BAR; PG8_SCHED;
            PG8_LDB(B1, 1, 1); PG8_STAGE(PG8_SB(1, 0), b3, voffB);
            PG8_BAR; PG8_WAIT_L(0); PG8_MMA(0, 1, At, B1); PG8_BAR;
            PG8_LDA(At, 1, 1); PG8_STAGE(PG8_SA(1, 0), a3, voffA);
            PG8_BAR; PG8_WAIT_L(0); PG8_MMA(1, 0, At, B0); PG8_BAR; PG8_SCHED;
            PG8_STAGE(PG8_SB(1, 1), b3 + hstep, voffB);
            PG8_WAIT_V(6); PG8_BAR; PG8_MMA(1, 1, At, B1); PG8_BAR;
            }
            if constexpr (Epi::MIDK > 0) { if (t + 2 == Epi::MIDK) E.midk(acc, cur, wr, fr); }
        }
        if constexpr (ALIGN_EPI) { if (wr == 0) PG8_BAR; }
        if constexpr (!Epi::AFTER_DRAIN) { E(acc, cur, wr, wc, fr, fq); S.done(cur); }
        if (!has_next) break;
#pragma unroll
        for (int a = 0; a < 2; ++a)
#pragma unroll
            for (int b = 0; b < 2; ++b)
#pragma unroll
                for (int m = 0; m < 4; ++m)
#pragma unroll
                    for (int n = 0; n < 2; ++n) acc[a][b][m][n] = (f32x4){0.f, 0.f, 0.f, 0.f};
        cur = nxt; cA = nA; cB = nB; ++ui;
        if constexpr (ALIGN_EPI) { if (wr == 1) PG8_BAR; }
    }
    PG8_WAIT_V(0);
    if constexpr (!ALIGN_EPI) { if (wr == 0) PG8_BAR; }
    PG8_BAR;
    if constexpr (Epi::AFTER_DRAIN) { E.fused(acc, cur, wr, wc, fr, fq, lds, wid, lane); S.done(cur); }
#undef PG8_SA
#undef PG8_SB
#undef PG8_STAGE
#undef PG8_LDA
#undef PG8_LDB
#undef PG8_MMA
#undef PG8_WAIT_V
#undef PG8_WAIT_L
#undef PG8_BAR
#undef PG8_SCHED
}
}

namespace pg8 {
__device__ __forceinline__ unsigned cvt_pk_bf16(float lo, float hi) { unsigned r; asm volatile("v_cvt_pk_bf16_f32 %0, %1, %2" : "=v"(r) : "v"(lo), "v"(hi)); return r; }
__device__ __forceinline__ u32x4 pack8(const f32x4 a, const f32x4 b) { u32x4 w; w.x = cvt_pk_bf16(a[0], a[1]); w.y = cvt_pk_bf16(a[2], a[3]); w.z = cvt_pk_bf16(b[0], b[1]); w.w = cvt_pk_bf16(b[2], b[3]); return w; }
__device__ __forceinline__ float sum4(const f32x4 a) { return (a[0] + a[1]) + (a[2] + a[3]); }
__device__ __forceinline__ float ssq4(const f32x4 a) { return (a[0] * a[0] + a[1] * a[1]) + (a[2] * a[2] + a[3] * a[3]); }
__device__ __forceinline__ float rstd16(const float* p, float invn) { const f32x4* q = (const f32x4*)p; const f32x4 a = q[0], b = q[1], c = q[2], d = q[3]; return rsqrtf(((sum4(a) + sum4(b)) + (sum4(c) + sum4(d))) * invn + 1e-6f); }
__device__ __forceinline__ float rstd4(const float* p, float invn) { const f32x4 a = *(const f32x4*)p; return rsqrtf(sum4(a) * invn + 1e-6f); }
__device__ __forceinline__ float fq_sum(float s) { return add_xor32(add_xor16(s)); }

struct EpiMlpIn { static constexpr bool PERM = true, AFTER_DRAIN = false; static constexpr int MIDK = 0;
    const float* ssqx; bf16_t* H;
    __device__ __forceinline__ void operator()(const f32x4 (&acc)[2][2][4][2], const Unit& u, int wr, int wc, int fr, int fq) const {
        const int row0 = u.pm * BM + wr * 64 + fr, col0 = u.pn * BM + wc * 32 + 8 * fq;
#pragma unroll
        for (int ai = 0; ai < 2; ++ai)
#pragma unroll
            for (int m = 0; m < 4; ++m) { const int row = row0 + ai * HALF + m * 16; const float rs = rstd16(ssqx + (size_t)row * 16, 1.f / 1024.f);
                bf16_t* rowp = H + (size_t)row * 4096 + col0;
#pragma unroll
                for (int bj = 0; bj < 2; ++bj) { f32x4 v0 = acc[ai][bj][m][0] * rs, v1 = acc[ai][bj][m][1] * rs;
#pragma unroll
                    for (int i = 0; i < 4; ++i) { const float a = fmaxf(v0[i], 0.f), b = fmaxf(v1[i], 0.f); v0[i] = a * a; v1[i] = b * b; }
                    *(u32x4*)(rowp + bj * HALF) = pack8(v0, v1); } asm volatile("" ::: "memory"); }
    }
};
template <int MIDK_> struct EpiRes { static constexpr bool PERM = true, AFTER_DRAIN = false; static constexpr int MIDK = MIDK_;
    const float* xold; float* xnew; bf16_t* XB; float* ssqx; const float* ssqa;
    __device__ __forceinline__ void midk(f32x4 (&acc)[2][2][4][2], const Unit& u, int wr, int fr) const {
#pragma unroll
        for (int ai = 0; ai < 2; ++ai)
#pragma unroll
            for (int m = 0; m < 4; ++m) { const int row = u.pm * BM + ai * HALF + wr * 64 + m * 16 + fr; const f32x4 a = *(const f32x4*)(ssqa + (size_t)row * 8), b = *(const f32x4*)(ssqa + (size_t)row * 8 + 4);
                const float rs = rsqrtf((sum4(a) + (b[0] + b[1])) * (1.f / 768.f) + 1e-6f);
#pragma unroll
                for (int bj = 0; bj < 2; ++bj)
#pragma unroll
                    for (int n = 0; n < 2; ++n) acc[ai][bj][m][n] *= rs; asm volatile("" ::: "memory"); }
    }
    __device__ __forceinline__ void operator()(const f32x4 (&acc)[2][2][4][2], const Unit& u, int wr, int wc, int fr, int fq) const {
        const int row0 = u.pm * BM + wr * 64 + fr, col0 = u.pn * BM + wc * 32 + 8 * fq;
#pragma unroll
        for (int ai = 0; ai < 2; ++ai)
#pragma unroll
            for (int m = 0; m < 4; ++m) { const int row = row0 + ai * HALF + m * 16; float s = 0.f;
#pragma unroll
                for (int bj = 0; bj < 2; ++bj) { const size_t off = (size_t)row * 1024 + col0 + bj * HALF;
                    const f32x4 o0 = *(const f32x4*)(xold + off) + acc[ai][bj][m][0], o1 = *(const f32x4*)(xold + off + 4) + acc[ai][bj][m][1];
                    *(f32x4*)(xnew + off) = o0; *(f32x4*)(xnew + off + 4) = o1; *(u32x4*)(XB + off) = pack8(o0, o1); s += ssq4(o0) + ssq4(o1); }
                s = fq_sum(s); if (fq == 0) ssqx[(size_t)row * 16 + u.pn * 4 + wc] = s; asm volatile("" ::: "memory"); }
    }
};
struct EpiIn { static constexpr bool PERM = true, AFTER_DRAIN = false; static constexpr int MIDK = 0;
    const float* ssqx; bf16_t *UT, *CQ, *CKV, *KPE; float *ssqcq, *ssqckv, *ssqpe;
    __device__ __forceinline__ void operator()(const f32x4 (&acc)[2][2][4][2], const Unit& u, int wr, int wc, int fr, int fq) const {
        const int row0 = u.pm * BM + wr * 64 + fr, c0 = wc * 32 + 8 * fq, pn = u.pn;
#pragma unroll
        for (int ai = 0; ai < 2; ++ai)
#pragma unroll
            for (int m = 0; m < 4; ++m) { const int row = row0 + ai * HALF + m * 16; const float rs = rstd16(ssqx + (size_t)row * 16, 1.f / 1024.f);
                if (pn == 0) { const int b = row >> 11, s = row & 2047; bf16_t* base = UT + ((size_t)(b * 256 + c0)) * 2048 + s;
#pragma unroll
                    for (int bj = 0; bj < 2; ++bj)
#pragma unroll
                        for (int n = 0; n < 2; ++n)
#pragma unroll
                            for (int i = 0; i < 4; ++i) base[(size_t)(bj * HALF + 4 * n + i) * 2048] = (bf16_t)(cvt_pk_bf16(acc[ai][bj][m][n][i] * rs, 0.f) & 0xffffu);
                } else if (pn < 3) { bf16_t* dst = (pn == 1 ? CQ : CKV) + (size_t)row * 256 + c0; float s = 0.f;
#pragma unroll
                    for (int bj = 0; bj < 2; ++bj) { const f32x4 v0 = acc[ai][bj][m][0] * rs, v1 = acc[ai][bj][m][1] * rs; *(u32x4*)(dst + bj * HALF) = pack8(v0, v1); s += ssq4(v0) + ssq4(v1); }
                    s = fq_sum(s); if (fq == 0) (pn == 1 ? ssqcq : ssqckv)[(size_t)row * 4 + wc] = s;
                } else if (wc < 2) { const f32x4 v0 = acc[ai][0][m][0] * rs, v1 = acc[ai][0][m][1] * rs; *(u32x4*)(KPE + (size_t)row * 64 + c0) = pack8(v0, v1);
                    float s = fq_sum(ssq4(v0) + ssq4(v1)); if (fq == 0) ssqpe[(size_t)row * 2 + wc] = s; } asm volatile("" ::: "memory"); }
    }
};
struct EpiDft { static constexpr bool PERM = true, AFTER_DRAIN = false; static constexpr int MIDK = 0;
    bf16_t* PQ;
    __device__ __forceinline__ void operator()(const f32x4 (&acc)[2][2][4][2], const Unit& u, int wr, int wc, int fr, int fq) const {
        const int pq = u.pm >> 3, sp0 = (u.pm & 7) * 256 + wr * 64 + fr, b = u.pn;
#pragma unroll
        for (int ai = 0; ai < 2; ++ai)
#pragma unroll
            for (int m = 0; m < 4; ++m) { bf16_t* rowp = PQ + ((size_t)(b * 2048 + sp0 + ai * HALF + m * 16)) * 512 + pq * 256 + wc * 32 + 8 * fq;
#pragma unroll
                for (int bj = 0; bj < 2; ++bj) *(u32x4*)(rowp + bj * HALF) = pack8(acc[ai][bj][m][0], acc[ai][bj][m][1]); asm volatile("" ::: "memory"); }
    }
};
struct EpiQ { static constexpr bool PERM = true, AFTER_DRAIN = false; static constexpr int MIDK = 0;
    const float* ssqcq; bf16_t* Q;
    __device__ __forceinline__ void operator()(const f32x4 (&acc)[2][2][4][2], const Unit& u, int wr, int wc, int fr, int fq) const {
        const int row0 = u.pm * BM + wr * 64 + fr, col0 = u.pn * BM + wc * 32 + 8 * fq;
#pragma unroll
        for (int ai = 0; ai < 2; ++ai)
#pragma unroll
            for (int m = 0; m < 4; ++m) { const int row = row0 + ai * HALF + m * 16; const float rs = rstd4(ssqcq + (size_t)row * 4, 1.f / 256.f);
                bf16_t* rowp = Q + (size_t)row * 1152 + col0;
#pragma unroll
                for (int bj = 0; bj < 2; ++bj) if (col0 + bj * HALF < 1152) *(u32x4*)(rowp + bj * HALF) = pack8(acc[ai][bj][m][0] * rs, acc[ai][bj][m][1] * rs); asm volatile("" ::: "memory"); }
    }
};
}

namespace pg8 {
typedef float f32x2 __attribute__((ext_vector_type(2)));
#define PG8_EPI_BAR() do { asm volatile("s_waitcnt lgkmcnt(0)" ::: "memory"); __builtin_amdgcn_s_barrier(); asm volatile("" ::: "memory"); } while (0)
struct EpiKV { static constexpr bool PERM = true, AFTER_DRAIN = false; static constexpr int MIDK = 0;
    const float *ssqckv, *ssqpe, *gk, *rope; const bf16_t* KPE; bf16_t *K, *V; PG8_LAS float* xch;
    __device__ __forceinline__ void operator()(const f32x4 (&acc)[2][2][4][2], const Unit& u, int wr, int wc, int fr, int fq) const {
        const int h = u.pn, row0 = u.pm * BM + wr * 64 + fr, c0 = wc * 32 + 8 * fq;
        float rck[2][4];
#pragma unroll
        for (int ai = 0; ai < 2; ++ai)
#pragma unroll
            for (int m = 0; m < 4; ++m) { const int row = row0 + ai * HALF + m * 16; const float rc = rstd4(ssqckv + (size_t)row * 4, 1.f / 256.f); rck[ai][m] = rc;
                const f32x4 v0 = acc[ai][0][m][0] * rc, v1 = acc[ai][0][m][1] * rc; const float s = fq_sum(ssq4(v0) + ssq4(v1));
                if (fq == 0) xch[(ai * HALF + wr * 64 + m * 16 + fr) * 4 + wc] = s; }
        PG8_EPI_BAR();
        const f32x4 g0 = *(const f32x4*)(gk + c0), g1 = *(const f32x4*)(gk + c0 + 4);
        const int i0 = 2 * (4 * wc + fq);
        const f32x2 gp1 = *(const f32x2*)(gk + 128 + i0), gp2 = *(const f32x2*)(gk + 160 + i0);
#pragma unroll
        for (int ai = 0; ai < 2; ++ai)
#pragma unroll
            for (int m = 0; m < 4; ++m) { const int row = row0 + ai * HALF + m * 16, rowt = ai * HALF + wr * 64 + m * 16 + fr;
                const f32x4 part = *(const PG8_LAS f32x4*)(xch + rowt * 4); const f32x2 pe2 = *(const f32x2*)(ssqpe + (size_t)row * 2);
                const float rc = rck[ai][m], rk = rsqrtf((sum4(part) + (pe2[0] + pe2[1])) * (1.f / 192.f) + 1e-6f), rr = rc * rk;
                *(u32x4*)(K + (size_t)row * 1152 + h * 192 + c0) = pack8(acc[ai][0][m][0] * rr * g0, acc[ai][0][m][1] * rr * g1);
                *(u32x4*)(V + (size_t)row * 768 + h * 128 + c0) = pack8(acc[ai][1][m][0] * rc, acc[ai][1][m][1] * rc);
                const unsigned a = *(const unsigned*)(KPE + (size_t)row * 64 + i0), b = *(const unsigned*)(KPE + (size_t)row * 64 + 32 + i0);
                const f32x2 cs = *(const f32x2*)(rope + (size_t)row * 64 + i0), sn = *(const f32x2*)(rope + (size_t)row * 64 + 32 + i0);
                const float x1a = __builtin_bit_cast(float, a << 16) * rk * gp1[0], x1b = __builtin_bit_cast(float, a & 0xffff0000u) * rk * gp1[1];
                const float x2a = __builtin_bit_cast(float, b << 16) * rk * gp2[0], x2b = __builtin_bit_cast(float, b & 0xffff0000u) * rk * gp2[1];
                *(unsigned*)(K + (size_t)row * 1152 + h * 192 + 128 + i0) = cvt_pk_bf16(x1a * cs[0] - x2a * sn[0], x1b * cs[1] - x2b * sn[1]);
                *(unsigned*)(K + (size_t)row * 1152 + h * 192 + 160 + i0) = cvt_pk_bf16(x2a * cs[0] + x1a * sn[0], x2b * cs[1] + x1b * sn[1]);
                asm volatile("" ::: "memory"); }
    }
};
struct EpiY { static constexpr bool PERM = true, AFTER_DRAIN = false; static constexpr int MIDK = 0;
    bf16_t* MIX; PG8_LAS float* xch;
    __device__ __forceinline__ void operator()(const f32x4 (&acc)[2][2][4][2], const Unit& u, int wr, int wc, int fr, int fq) const {
        const int row0 = u.pm * BM + wr * 64 + fr, c0 = wc * 32 + 8 * fq;
#pragma unroll
        for (int ai = 0; ai < 2; ++ai)
#pragma unroll
            for (int m = 0; m < 4; ++m) { float s = 0.f;
#pragma unroll
                for (int bj = 0; bj < 2; ++bj) s += ssq4(acc[ai][bj][m][0]) + ssq4(acc[ai][bj][m][1]);
                s = fq_sum(s); if (fq == 0) xch[(ai * HALF + wr * 64 + m * 16 + fr) * 4 + wc] = s; }
        PG8_EPI_BAR();
#pragma unroll
        for (int ai = 0; ai < 2; ++ai)
#pragma unroll
            for (int m = 0; m < 4; ++m) { const int row = row0 + ai * HALF + m * 16, rowt = ai * HALF + wr * 64 + m * 16 + fr;
                const f32x4 part = *(const PG8_LAS f32x4*)(xch + rowt * 4); const float rf = rsqrtf(sum4(part) * (1.f / 256.f) + 1e-6f);
                bf16_t* rowp = MIX + (size_t)row * 1024 + 768 + c0;
#pragma unroll
                for (int bj = 0; bj < 2; ++bj) *(u32x4*)(rowp + bj * HALF) = pack8(acc[ai][bj][m][0] * rf, acc[ai][bj][m][1] * rf);
                asm volatile("" ::: "memory"); }
    }
};
}

namespace att {
using f32x16 = __attribute__((ext_vector_type(16))) float;
using s16x4 = __attribute__((ext_vector_type(4))) short;
constexpr int NW = 8, QBLK = 32, KVBLK = 64, LDQ = 1152, LDK = 1152, LDV = 768;
constexpr int SHM_V = KVBLK * 128 * 2, SHM_K = KVBLK * 192 * 2;
constexpr int OFF_V = 0, OFF_K = 2 * SHM_V, OFF_WS = OFF_K + 2 * SHM_K, ATT_LDS = OFF_WS + NW * 64 * 4;
constexpr float THR = 8.f;
__device__ __forceinline__ int k_st(int key, int cc) { const int d0 = cc >> 1, hh = cc & 1; return d0 * 2048 + ((key * 32 + ((hh ^ ((key >> 3) & 1)) * 16)) ^ ((d0 & 1) * 64)); }
#define SBAR() __builtin_amdgcn_sched_barrier(0)
__device__ __forceinline__ int crow(int r, int hi) { return (r & 3) + 8 * (r >> 2) + 4 * hi; }
__device__ __forceinline__ unsigned cvtpk(float lo, float hi) { unsigned r; asm volatile("v_cvt_pk_bf16_f32 %0, %1, %2" : "=v"(r) : "v"(lo), "v"(hi)); return r; }

__device__ __forceinline__ void partialSM(f32x16& p0, f32x16& p1, float& m_reg, float& mn, float& alpha) {
  float pmax = p0[0];
#pragma unroll
  for (int r = 1; r < 16; ++r) pmax = fmaxf(pmax, p0[r]);
#pragma unroll
  for (int r = 0; r < 16; ++r) pmax = fmaxf(pmax, p1[r]);
  { auto rr = __builtin_amdgcn_permlane32_swap(__float_as_uint(pmax), __float_as_uint(pmax), false, false);
    pmax = fmaxf(__uint_as_float(rr[0]), __uint_as_float(rr[1])); }
  if (__builtin_expect(__all(pmax - m_reg <= THR), 1)) { mn = m_reg; alpha = 1.f; }
  else { mn = fmaxf(m_reg, pmax); alpha = __builtin_amdgcn_exp2f(m_reg - mn); m_reg = mn; }
#pragma unroll
  for (int r = 0; r < 16; ++r) p0[r] = p0[r] - mn;
#pragma unroll
  for (int r = 0; r < 16; ++r) p1[r] = p1[r] - mn;
#pragma unroll
  for (int r = 0; r < 16; ++r) p0[r] = __builtin_amdgcn_exp2f(p0[r]);
}
__device__ __forceinline__ void finishSM(f32x16& p0, f32x16& p1, float alpha, float& l_reg, bf16x8& pa0, bf16x8& pa1, bf16x8& pa2, bf16x8& pa3) {
#pragma unroll
  for (int r = 0; r < 16; ++r) p1[r] = __builtin_amdgcn_exp2f(p1[r]);
  float ps = 0;
#pragma unroll
  for (int r = 0; r < 16; ++r) ps += p0[r];
#pragma unroll
  for (int r = 0; r < 16; ++r) ps += p1[r];
  { auto rr = __builtin_amdgcn_permlane32_swap(__float_as_uint(ps), __float_as_uint(ps), false, false);
    ps = __uint_as_float(rr[0]) + __uint_as_float(rr[1]); }
  l_reg = l_reg * alpha + ps;
#define PK4(P, BASE, OUT) do { unsigned a0 = cvtpk(P[BASE + 0], P[BASE + 1]), a1 = cvtpk(P[BASE + 2], P[BASE + 3]);   \
    unsigned b0 = cvtpk(P[BASE + 4], P[BASE + 5]), b1 = cvtpk(P[BASE + 6], P[BASE + 7]);                              \
    auto r0 = __builtin_amdgcn_permlane32_swap(a0, b0, false, false); auto r1 = __builtin_amdgcn_permlane32_swap(a1, b1, false, false); \
    u32x4 w = {r0[0], r1[0], r0[1], r1[1]}; OUT = *reinterpret_cast<bf16x8*>(&w); } while (0)
  PK4(p0, 0, pa0); PK4(p0, 8, pa1); PK4(p1, 0, pa2); PK4(p1, 8, pa3);
#undef PK4
}
__device__ __forceinline__ void qkt(f32x16& p0, f32x16& p1, const LAS char* Ks, const bf16x8* qr, int kb) {
  p0 = f32x16{}; p1 = f32x16{};
  const LAS char* ke = Ks + kb; const LAS char* ko = Ks + (kb ^ 64);
#pragma unroll
  for (int d0 = 0; d0 < 12; ++d0) { const LAS char* a = (d0 & 1) ? ko : ke;
    const bf16x8 b0 = *(const LAS bf16x8*)(a + d0 * 2048);
    const bf16x8 b1 = *(const LAS bf16x8*)(a + d0 * 2048 + 1024);
    p0 = __builtin_amdgcn_mfma_f32_32x32x16_bf16(b0, qr[d0], p0, 0, 0, 0);
    p1 = __builtin_amdgcn_mfma_f32_32x32x16_bf16(b1, qr[d0], p1, 0, 0, 0); }
}
__device__ __forceinline__ int v_st(int k, int c) { const int kk = (k & ~0xC) | ((k & 4) << 1) | ((k & 8) >> 1); return ((kk >> 3) * 4 + (c >> 5)) * 512 + ((kk & 7) * 32 + (c & 31)) * 2; }
__device__ __forceinline__ int v_rd_base(int lane) { return ((lane & 3) << 3) | (((lane >> 2) & 3) << 6) | (((lane >> 4) & 1) << 5) | (((lane >> 5) & 1) << 8); }
constexpr int v_rd_off(int d0, int ks, int half) { return d0 * 512 + ks * 4096 + half * 2048; }
template <int OFF> __device__ __forceinline__ s16x4 tr_read(int vb) {
  s16x4 r; asm volatile("ds_read_b64_tr_b16 %0, %1 offset:%2" : "=&v"(r) : "v"(vb), "i"(OFF) : "memory"); return r;
}
template <int D0> __device__ __forceinline__ void pv_one(f32x16& od, int vb, bf16x8 pa0, bf16x8 pa1, bf16x8 pa2, bf16x8 pa3) {
  const s16x4 l0 = tr_read<v_rd_off(D0, 0, 0)>(vb), h0 = tr_read<v_rd_off(D0, 0, 1)>(vb), l1 = tr_read<v_rd_off(D0, 1, 0)>(vb), h1 = tr_read<v_rd_off(D0, 1, 1)>(vb);
  const s16x4 l2 = tr_read<v_rd_off(D0, 2, 0)>(vb), h2 = tr_read<v_rd_off(D0, 2, 1)>(vb), l3 = tr_read<v_rd_off(D0, 3, 0)>(vb), h3 = tr_read<v_rd_off(D0, 3, 1)>(vb);
  asm volatile("s_waitcnt lgkmcnt(0)" ::: "memory"); SBAR();
#define PK(L, H) (bf16x8){L[0], L[1], L[2], L[3], H[0], H[1], H[2], H[3]}
  od = __builtin_amdgcn_mfma_f32_32x32x16_bf16(pa0, PK(l0, h0), od, 0, 0, 0);
  od = __builtin_amdgcn_mfma_f32_32x32x16_bf16(pa1, PK(l1, h1), od, 0, 0, 0);
  od = __builtin_amdgcn_mfma_f32_32x32x16_bf16(pa2, PK(l2, h2), od, 0, 0, 0);
  od = __builtin_amdgcn_mfma_f32_32x32x16_bf16(pa3, PK(l3, h3), od, 0, 0, 0);
#undef PK
}
__device__ __forceinline__ void pv_d0(f32x16* o, int vb, bf16x8 pa0, bf16x8 pa1, bf16x8 pa2, bf16x8 pa3) {
  pv_one<0>(o[0], vb, pa0, pa1, pa2, pa3); pv_one<1>(o[1], vb, pa0, pa1, pa2, pa3); pv_one<2>(o[2], vb, pa0, pa1, pa2, pa3); pv_one<3>(o[3], vb, pa0, pa1, pa2, pa3);
}

__device__ __forceinline__ void attn_unit(const bf16_t* __restrict__ Qb, const bf16_t* __restrict__ Kh, const bf16_t* __restrict__ Vh, bf16_t* __restrict__ Ob, float* __restrict__ ssq,
                                          const float* __restrict__ gq, const float* __restrict__ rope, LAS char* lds, const int tid) {
  const int wid = tid >> 6, lane = tid & 63, r32 = lane & 31, hi = lane >> 5;
  LAS char* V_lds = lds + OFF_V; LAS char* K_lds = lds + OFF_K;
  LAS float* wsf = (LAS float*)(lds + OFF_WS) + wid * 64; LAS float* li_l = wsf; LAS float* al_l = wsf + 32;
  float m_reg = -1e30f, l_reg = 0; f32x16 o[4] = {}; bf16x8 qr[12];
  {
    const bf16_t* Qw = Qb + (long)(wid * QBLK + r32) * LDQ + hi * 8;
    bf16x8 raw[12]; float ss = 0.f;
#pragma unroll
    for (int d0 = 0; d0 < 12; ++d0) raw[d0] = *reinterpret_cast<const bf16x8*>(Qw + d0 * 16);
#pragma unroll
    for (int d0 = 0; d0 < 12; ++d0)
#pragma unroll
      for (int j = 0; j < 8; ++j) { const float v = bf2f((bf16_t)raw[d0][j]); ss += v * v; }
    ss = add_xor32(ss);
    const float rq = rsqrtf(ss * (1.f / 192.f) + EPS) * QSCALE;
    const float* rp = rope + (long)(wid * QBLK + r32) * 64 + hi * 8;
#pragma unroll
    for (int d0 = 0; d0 < 8; ++d0) { const f32x4 g0 = *(const f32x4*)(gq + d0 * 16 + hi * 8), g1 = *(const f32x4*)(gq + d0 * 16 + hi * 8 + 4); float v[8];
#pragma unroll
      for (int j = 0; j < 8; ++j) v[j] = bf2f((bf16_t)raw[d0][j]) * rq * (j < 4 ? g0[j] : g1[j - 4]);
      u32x4 w = {cvtpk(v[0], v[1]), cvtpk(v[2], v[3]), cvtpk(v[4], v[5]), cvtpk(v[6], v[7])}; qr[d0] = *reinterpret_cast<bf16x8*>(&w);
      if (d0 & 1) asm volatile("" ::: "memory"); }
#pragma unroll
    for (int dd = 0; dd < 2; ++dd) {
      const f32x4 ga0 = *(const f32x4*)(gq + 128 + dd * 16 + hi * 8), ga1 = *(const f32x4*)(gq + 128 + dd * 16 + hi * 8 + 4);
      const f32x4 gb0 = *(const f32x4*)(gq + 160 + dd * 16 + hi * 8), gb1 = *(const f32x4*)(gq + 160 + dd * 16 + hi * 8 + 4);
      const f32x4 c0 = *(const f32x4*)(rp + dd * 16), c1 = *(const f32x4*)(rp + dd * 16 + 4), s0 = *(const f32x4*)(rp + 32 + dd * 16), s1 = *(const f32x4*)(rp + 32 + dd * 16 + 4);
      float o1[8], o2[8];
#pragma unroll
      for (int j = 0; j < 8; ++j) { const float x1 = bf2f((bf16_t)raw[8 + dd][j]) * rq * (j < 4 ? ga0[j] : ga1[j - 4]), x2 = bf2f((bf16_t)raw[10 + dd][j]) * rq * (j < 4 ? gb0[j] : gb1[j - 4]);
        const float c = j < 4 ? c0[j] : c1[j - 4], s = j < 4 ? s0[j] : s1[j - 4]; o1[j] = x1 * c - x2 * s; o2[j] = x2 * c + x1 * s; }
      u32x4 w1 = {cvtpk(o1[0], o1[1]), cvtpk(o1[2], o1[3]), cvtpk(o1[4], o1[5]), cvtpk(o1[6], o1[7])}; qr[8 + dd] = *reinterpret_cast<bf16x8*>(&w1);
      u32x4 w2 = {cvtpk(o2[0], o2[1]), cvtpk(o2[2], o2[3]), cvtpk(o2[4], o2[5]), cvtpk(o2[6], o2[7])}; qr[10 + dd] = *reinterpret_cast<bf16x8*>(&w2);
      asm volatile("" ::: "memory");
    }
  }
  int t1 = tid; asm volatile("" : "+v"(t1));
  const int sr = t1 >> 4, sc = (t1 & 15) * 8, vst0 = v_st(sr, sc), vst1 = v_st(32 + sr, sc);
  int kgo[3], kst[3];
#pragma unroll
  for (int i = 0; i < 3; ++i) { const int c = t1 + 512 * i, rest = c >> 3, key2 = rest / 6, cch = rest - key2 * 6, key = key2 * 2 + ((c >> 2) & 1), cc = cch * 4 + (c & 3); kgo[i] = key * LDK + cc * 8; kst[i] = k_st(key, cc); }
  const int kb = (t1 & 31) * 32 + ((((t1 >> 5) & 1) ^ ((t1 >> 3) & 1)) * 16);
  const int vb0 = (int)(unsigned)(size_t)V_lds + v_rd_base(t1 & 63);
  bf16x8 sv0, sv1, sk0, sk1, sk2;
#define SLOAD(k0) do { sv0 = *reinterpret_cast<const bf16x8*>(&Vh[(long)((k0) + sr) * LDV + sc]); sv1 = *reinterpret_cast<const bf16x8*>(&Vh[(long)((k0) + 32 + sr) * LDV + sc]); \
    sk0 = *reinterpret_cast<const bf16x8*>(&Kh[(long)(k0) * LDK + kgo[0]]); sk1 = *reinterpret_cast<const bf16x8*>(&Kh[(long)(k0) * LDK + kgo[1]]); sk2 = *reinterpret_cast<const bf16x8*>(&Kh[(long)(k0) * LDK + kgo[2]]); } while (0)
#define SWRITE(b) do { *(LAS bf16x8*)(V_lds + (b) * SHM_V + vst0) = sv0; *(LAS bf16x8*)(V_lds + (b) * SHM_V + vst1) = sv1; \
    *(LAS bf16x8*)(K_lds + (b) * SHM_K + kst[0]) = sk0; *(LAS bf16x8*)(K_lds + (b) * SHM_K + kst[1]) = sk1; *(LAS bf16x8*)(K_lds + (b) * SHM_K + kst[2]) = sk2; } while (0)
#define SWAIT() asm volatile("s_waitcnt vmcnt(0)" ::: "memory")
#define RESC(a) do { if (__any((a) < 1.f)) { if (hi == 0) al_l[r32] = (a); asm volatile("s_waitcnt lgkmcnt(0)" ::: "memory"); \
    _Pragma("unroll") for (int d = 0; d < 4; ++d) _Pragma("unroll") for (int r = 0; r < 16; ++r) o[d][r] *= al_l[crow(r, hi)]; } } while (0)
  f32x16 pA0, pA1, pB0, pB1; float mnA, mnB, alA, alB; bf16x8 pa0, pa1, pa2, pa3; constexpr int NT = SEQ / KVBLK;
  SLOAD(0); SWAIT(); SWRITE(0); __syncthreads();
  qkt(pA0, pA1, K_lds, qr, kb); partialSM(pA0, pA1, m_reg, mnA, alA);
  SLOAD(KVBLK); SWAIT(); SWRITE(1); __syncthreads();
  for (int j = 1; j + 1 < NT; j += 2) {
    SBAR(); qkt(pB0, pB1, K_lds + SHM_K, qr, kb);
    finishSM(pA0, pA1, alA, l_reg, pa0, pa1, pa2, pa3); SBAR();
    SLOAD((j + 1) * KVBLK); SBAR();
    pv_d0(o, vb0, pa0, pa1, pa2, pa3); partialSM(pB0, pB1, m_reg, mnB, alB);
    __syncthreads(); SWAIT(); SWRITE(0);
    RESC(alB); __syncthreads();
    SBAR(); qkt(pA0, pA1, K_lds, qr, kb);
    finishSM(pB0, pB1, alB, l_reg, pa0, pa1, pa2, pa3); SBAR();
    SLOAD((j + 2) * KVBLK); SBAR();
    pv_d0(o, vb0 + SHM_V, pa0, pa1, pa2, pa3); partialSM(pA0, pA1, m_reg, mnA, alA);
    __syncthreads(); SWAIT(); SWRITE(1);
    RESC(alA); __syncthreads();
  }
  SBAR(); qkt(pB0, pB1, K_lds + SHM_K, qr, kb);
  finishSM(pA0, pA1, alA, l_reg, pa0, pa1, pa2, pa3); SBAR();
  pv_d0(o, vb0, pa0, pa1, pa2, pa3); partialSM(pB0, pB1, m_reg, mnB, alB);
  __syncthreads(); RESC(alB);
  finishSM(pB0, pB1, alB, l_reg, pa0, pa1, pa2, pa3); SBAR();
  pv_d0(o, vb0 + SHM_V, pa0, pa1, pa2, pa3);
  if (hi == 0) li_l[r32] = l_reg;
  __syncthreads();
  { int t2 = tid; asm volatile("" : "+v"(t2));
  const int wid = t2 >> 6, lane = t2 & 63, r32 = lane & 31, hi = lane >> 5;
  LAS float* li_l = (LAS float*)(lds + OFF_WS) + wid * 64;
  LAS bf16_t* stg = (LAS bf16_t*)(lds + wid * 8192);
#pragma unroll
  for (int r = 0; r < 16; ++r) { const int orow = crow(r, hi); const float rl = __builtin_amdgcn_rcpf(li_l[orow]);
#pragma unroll
    for (int d0 = 0; d0 < 4; ++d0) stg[orow * 128 + d0 * 32 + r32] = (bf16_t)(cvtpk(o[d0][r] * rl, 0.f) & 0xffffu); }
  asm volatile("s_waitcnt lgkmcnt(0)" ::: "memory");
  { const int row = lane >> 1, half = lane & 1; const LAS u32x4* src = (const LAS u32x4*)(stg + row * 128 + half * 64); float s = 0.f;
    bf16_t* orow = Ob + (long)(wid * QBLK + row) * 1024 + half * 64;
#pragma unroll
    for (int i = 0; i < 8; ++i) { const u32x4 v = src[i]; *(u32x4*)(orow + i * 8) = v;
#pragma unroll
      for (int e = 0; e < 4; ++e) { const float a = __builtin_bit_cast(float, v[e] << 16), b = __builtin_bit_cast(float, v[e] & 0xffff0000u); s += a * a + b * b; } }
    s = add_xor1(s);
    if (half == 0) ssq[(long)(wid * QBLK + row) * 8] = s; }
  }
  __syncthreads();
#undef SLOAD
#undef SWRITE
#undef SWAIT
#undef RESC
}
#undef SBAR
}

constexpr int NWAVES = 8, MK_THREADS = NWAVES * 64;
constexpr int MK_LDS = 147456, XCH_OFF = 131072, MISC_OFF = XCH_OFF + 4096, CW_BAR = 4096, CTL_ZERO_BYTES = 65536;

__device__ __forceinline__ void tr_item(const float* W, int K, int N, int koff, const float* g1, const float* g2, int ksplit, bf16_t* WT, LAS float* scr, int item, int lane) {
    const int nblk = N / 32, kb = item / nblk, nb = item % nblk, k0 = 64 * kb, n0 = 32 * nb;
#pragma unroll 8
    for (int i = 0; i < 32; ++i) {
        const int kk = 2 * i + (lane >> 5), kp = k0 + kk, ks = (kp + koff) & (K - 1);
        const float g = g1 ? (kp < ksplit ? g1[kp] : g2[kp - ksplit]) : 1.f;
        scr[kk * 33 + (lane & 31)] = W[(size_t)ks * N + n0 + (lane & 31)] * g;
    }
    asm volatile("s_waitcnt lgkmcnt(0)" ::: "memory");
    const int c = lane & 7;
#pragma unroll
    for (int j = 0; j < 4; ++j) {
        const int n = (lane >> 3) + 8 * j; const LAS float* s = scr + (8 * c) * 33 + n;
        u32x4 o; o.x = pk2(s[0 * 33], s[1 * 33]); o.y = pk2(s[2 * 33], s[3 * 33]); o.z = pk2(s[4 * 33], s[5 * 33]); o.w = pk2(s[6 * 33], s[7 * 33]);
        *(u32x4*)(WT + (size_t)(n0 + n) * K + k0 + 8 * c) = o;
    }
    asm volatile("s_waitcnt lgkmcnt(0)" ::: "memory");
}

__device__ __forceinline__ void phase_prologue(const Params& p, LAS unsigned char* lds, const int tid) {
    const int lane = tid & 63, wave = tid >> 6;
    const int G = gridDim.x, gw = blockIdx.x * NWAVES + wave, NGW = G * NWAVES;
    const int gt = blockIdx.x * MK_THREADS + tid, NGT = G * MK_THREADS;
    LAS float* tab = (LAS float*)lds;
    LAS float* scr = (LAS float*)(lds + 8192 + wave * 8704);
    for (int j = tid; j < 2048; j += MK_THREADS) tab[j] = cospif((float)j * (1.0f / 1024.0f));
    __syncthreads();
    unsigned char* ws = p.ws;
    {
        constexpr int I_IN = 16 * 26, I_QU = 4 * 36, I_KV = 4 * 48, I_OUT = 16 * 32, I_MI = 16 * 128, I_MO = 64 * 32, I_L = I_IN + I_QU + I_KV + I_OUT + I_MI + I_MO;
        for (int it = gw; it < DEPTH * I_L; it += NGW) {
            const int l = it / I_L; int r = it % I_L; unsigned char* wl = ws + WS_W + (size_t)l * LW;
            if (r < I_IN) { tr_item(p.in[I_WIN] + (size_t)l * DM * INW, DM, INW, 0, p.in[I_ANG] + l * DM, nullptr, DM, (bf16_t*)(wl + OW_IN), scr, r, lane); continue; } r -= I_IN;
            if (r < I_QU) { tr_item(p.in[I_WQUP] + (size_t)l * QL * QUPW, QL, QUPW, 0, p.in[I_QAG] + l * QL, nullptr, QL, (bf16_t*)(wl + OW_QUP), scr, r, lane); continue; } r -= I_QU;
            if (r < I_KV) { tr_item(p.in[I_WKVUP] + (size_t)l * KVL * KVUPW, KVL, KVUPW, 0, p.in[I_KVAG] + l * KVL, nullptr, KVL, (bf16_t*)(wl + OW_KVUP), scr, r, lane); continue; } r -= I_KV;
            if (r < I_OUT) { tr_item(p.in[I_WOUT] + (size_t)l * DM * DM, DM, DM, FW, p.in[I_AOG] + l * AW, p.in[I_FOG] + l * FW, AW, (bf16_t*)(wl + OW_OUT), scr, r, lane); continue; } r -= I_OUT;
            if (r < I_MI) { tr_item(p.in[I_WMI] + (size_t)l * DM * FF, DM, FF, 0, p.in[I_MNG] + l * DM, nullptr, DM, (bf16_t*)(wl + OW_MI), scr, r, lane); continue; } r -= I_MI;
            tr_item(p.in[I_WMO] + (size_t)l * FF * DM, FF, DM, 0, nullptr, nullptr, FF, (bf16_t*)(wl + OW_MO), scr, r, lane);
        }
    }
    {
        constexpr int C_IN = (INWP - INW) * DM / 8, C_QU = (QUPWP - QUPW) * QL / 8, C_L = C_IN + C_QU;
        for (int i = gt; i < DEPTH * C_L; i += NGT) {
            const int l = i / C_L, r = i % C_L; unsigned char* wl = ws + WS_W + (size_t)l * LW;
            u32x4* dst = (r < C_IN) ? (u32x4*)(wl + OW_IN + (size_t)INW * DM * 2) + r : (u32x4*)(wl + OW_QUP + (size_t)QUPW * QL * 2) + (r - C_IN);
            *dst = (u32x4){0u, 0u, 0u, 0u};
        }
    }
    {
        bf16_t* F = (bf16_t*)(ws + WS_F);
        for (int ci = gt; ci < 4096 * 256; ci += NGT) {
            const int r = ci >> 8, s0 = (ci & 255) * 8, pq = r >> 11, sp = r & 2047, sh = pq ? 1536 : 0;
            float v[8];
#pragma unroll
            for (int e = 0; e < 8; ++e) v[e] = tab[(sp * (s0 + e) + sh) & 2047];
            u32x4 o; o.x = pk2(v[0], v[1]); o.y = pk2(v[2], v[3]); o.z = pk2(v[4], v[5]); o.w = pk2(v[6], v[7]);
            *(u32x4*)(F + (size_t)r * 2048 + s0) = o;
        }
    }
    {
        for (int i = gt; i < DEPTH * 256 * 512; i += NGT) {
            const int l = i / (256 * 512), r = i % (256 * 512), n = r >> 9, k = r & 511, g = n >> 6, d = n & 63, pq = k >> 8, g2 = (k >> 6) & 3, c = k & 63;
            float acc = 0.f;
            if (g2 == g) {
                const float* wf = p.in[I_WF] + ((size_t)(l * 4 + g) * 64) * 64 + d;
                const int sh = pq ? 1536 : 0;
                for (int c2 = 0; c2 < 64; ++c2) acc += tab[((((c * c2) & 63) * 32) + sh) & 2047] * wf[(size_t)c2 * 64];
                acc *= pq ? -DFT_NRM : DFT_NRM;
            }
            ((bf16_t*)(ws + WS_W + (size_t)l * LW + OW_Y))[r] = (bf16_t)f2bf(acc);
        }
    }
    {
        bf16_t* XB = (bf16_t*)(ws + WS_XB); float* SSQ = (float*)(ws + WS_SSQX);
        for (int m = gw; m < T; m += NGW) {
            const f32x4* xr = (const f32x4*)(p.x + (size_t)m * DM) + lane; f32x4 v[4]; float s = 0.f;
#pragma unroll
            for (int j = 0; j < 4; ++j) { v[j] = xr[64 * j]; s += (v[j].x * v[j].x + v[j].y * v[j].y) + (v[j].z * v[j].z + v[j].w * v[j].w); }
            s = wave_sum(s);
            u32x2* o8 = (u32x2*)(XB + (size_t)m * DM) + lane;
#pragma unroll
            for (int j = 0; j < 4; ++j) o8[64 * j] = (u32x2){pk2(v[j].x, v[j].y), pk2(v[j].z, v[j].w)};
            if (lane < 16) SSQ[(size_t)m * 16 + lane] = lane == 0 ? s : 0.f;
        }
    }
    {
        float* R = (float*)(ws + WS_ROPE);
        for (int i = gt; i < T * 32; i += NGT) {
            const int row = i >> 5, j = i & 31;
            const float inv = powf(10000.0f, -(float)j * (1.0f / 32.0f));
            const float ang = (float)p.pos[row] * inv;
            R[(size_t)row * 64 + j] = cosf(ang); R[(size_t)row * 64 + 32 + j] = sinf(ang);
        }
    }
}

#define XB_TMO      128
#define XB_XCNT(j)  (256  + 64 * (j))
#define XB_XSUB(j)  (1280 + 64 * (j))
#define XB_XGEN(j)  (2304 + 64 * (j))
#define XB_TOP      3328
#define XB_TOPGEN   3392
#define XCD_BAR_WORDS 3456
#define XB_SPIN_CAP (1u << 18)

__device__ __forceinline__ unsigned xb_ld(unsigned* p)              { return __hip_atomic_load(p, __ATOMIC_RELAXED, __HIP_MEMORY_SCOPE_AGENT); }
__device__ __forceinline__ unsigned xb_add(unsigned* p, unsigned v) { return __hip_atomic_fetch_add(p, v, __ATOMIC_RELAXED, __HIP_MEMORY_SCOPE_AGENT); }
__device__ __forceinline__ unsigned xb_xcc_id() { return (unsigned)__builtin_amdgcn_s_getreg((3 << 11) | 20) & 0xFu; }
#define XB_SPIN(cond, bar) do { unsigned _sp = 0; while (cond) { __builtin_amdgcn_s_sleep(1); \
    if ((++_sp & 255u) == 0u) { if (xb_ld(&(bar)[XB_TMO])) break; if (_sp > XB_SPIN_CAP) { atomicAdd(&(bar)[XB_TMO], 1u); break; } } } } while (0)

struct XcdBarrier {
    unsigned* bar; unsigned x;
    volatile LAS unsigned* st;
};

__device__ __forceinline__ XcdBarrier xcd_barrier_post(unsigned* bar, volatile LAS unsigned* st) {
    XcdBarrier b; b.bar = bar; b.x = xb_xcc_id(); b.st = st;
    if (threadIdx.x == 0) (void)xb_add(&bar[XB_XCNT(b.x)], 1u);
    return b;
}
__device__ __forceinline__ void xcd_barrier_complete(unsigned* bar, unsigned x, unsigned& nloc, unsigned& nx) {
    const unsigned G = gridDim.x * gridDim.y * gridDim.z;
    unsigned sum, cnt, mine, sp = 0u;
    for (;;) {
        sum = 0u; cnt = 0u; mine = 0u;
#pragma unroll
        for (unsigned j = 0; j < 16; ++j) { const unsigned c = xb_ld(&bar[XB_XCNT(j)]); sum += c; cnt += (c > 0u) ? 1u : 0u; mine = (j == x) ? c : mine; }
        if (sum == G) break;
        __builtin_amdgcn_s_sleep(1);
        if ((++sp & 255u) == 0u) { if (xb_ld(&bar[XB_TMO])) break; if (sp > XB_SPIN_CAP) { atomicAdd(&bar[XB_TMO], 1u); break; } }
    }
    nloc = mine > 0u ? mine : 1u; nx = cnt > 0u ? cnt : 1u;
}

__device__ __forceinline__ void xcd_barrier(const XcdBarrier& b) {
    asm volatile("s_waitcnt vmcnt(0)" ::: "memory");
    __syncthreads();
    if (threadIdx.x == 0) {
        unsigned* bar = b.bar;
        __builtin_amdgcn_s_waitcnt(0);
        unsigned nloc = b.st[0], nx = b.st[1];
        if (nloc == 0u) { xcd_barrier_complete(bar, b.x, nloc, nx); b.st[0] = nloc; b.st[1] = nx; }
        const unsigned old = xb_add(&bar[XB_XSUB(b.x)], 1u);
        const unsigned gen = old / nloc;
        if (old + 1u == (gen + 1u) * nloc) {
            __builtin_amdgcn_fence(__ATOMIC_RELEASE, "agent");
            asm volatile("s_waitcnt vmcnt(0)" ::: "memory");
            const unsigned og = xb_add(&bar[XB_TOP], 1u);
            const unsigned tg = og / nx;
            if (og + 1u == (tg + 1u) * nx) xb_add(&bar[XB_TOPGEN], 1u);
            else XB_SPIN(xb_ld(&bar[XB_TOPGEN]) == tg, bar);
            __builtin_amdgcn_fence(__ATOMIC_ACQUIRE, "agent");
            xb_add(&bar[XB_XGEN(b.x)], 1u);
            asm volatile("s_waitcnt vmcnt(0)" ::: "memory");
        } else {
            XB_SPIN(xb_ld(&bar[XB_XGEN(b.x)]) == gen, bar);
            __builtin_amdgcn_fence(__ATOMIC_ACQUIRE, "agent");
            asm volatile("s_waitcnt vmcnt(0)" ::: "memory");
        }
    }
    __syncthreads();
}

constexpr int N_PHASES = 1 + 6 * DEPTH;
#ifndef PHM
#define PHM 0xffff
#endif
__global__ void __launch_bounds__(MK_THREADS, 2) mk(Params p) {
    extern __shared__ __attribute__((aligned(16))) unsigned char lds_raw[];
    LAS unsigned char* lds = (LAS unsigned char*)lds_raw;
    const int G = gridDim.x, bid = blockIdx.x;
#define BP(off) ((bf16_t*)(ws + (off)))
#define FP(off) ((float*)(ws + (off)))
    volatile LAS unsigned* MISC = (volatile LAS unsigned*)(lds + MISC_OFF);
    if (threadIdx.x < 32) MISC[threadIdx.x] = 0u;
    __syncthreads();
    const XcdBarrier bar = xcd_barrier_post((unsigned*)(p.ws + WS_CTL) + CW_BAR, MISC + 8);
    if (p.ph_lo == 0) {
        phase_prologue(p, lds, threadIdx.x);
        if (p.ph_hi > 1) xcd_barrier(bar);
    }
    for (int ph = p.ph_lo < 1 ? 1 : p.ph_lo; ph < p.ph_hi; ++ph) {
        int tid = threadIdx.x; asm volatile("" : "+v"(tid));
        unsigned char* ws; { unsigned long long w_ = (unsigned long long)p.ws; asm volatile("" : "+s"(w_)); ws = (unsigned char*)(__attribute__((address_space(1))) unsigned char*)w_; }
        {
            const int l = (ph - 1) / 6, s = (ph - 1) % 6;
            unsigned char* wl = ws + WS_W + (size_t)l * LW;
            pg8::StaticOrder S;
            if (s == 0 && ((PHM & 1) != 0)) {
                pg8::Gemm g{BP(WS_XB), (const bf16_t*)(wl + OW_IN), T, INWP, DM}; S.init(T, INWP, G, bid);
                pg8::EpiIn E{FP(WS_SSQX), BP(WS_UT), BP(WS_CQ), BP(WS_CKV), BP(WS_KPE), FP(WS_SSQCQ), FP(WS_SSQCKV), FP(WS_SSQPE)};
                pg8::gemm_phase<pg8::EpiIn, pg8::StaticOrder, true, true>(lds, g, S, E, tid);
            } else if (s == 1 && ((PHM & 2) != 0)) {
                if ((p.sub & 1) && ((PHM & 64) != 0)) { pg8::Gemm g{BP(WS_F), BP(WS_UT), 4096, 4096, 2048}; S.init(4096, 4096, G, bid); pg8::EpiDft E{BP(WS_PQ)};
                    pg8::gemm_phase<pg8::EpiDft, pg8::StaticOrder, true, true>(lds, g, S, E, tid); }
                if ((p.sub & 2) && ((PHM & 128) != 0)) { pg8::Gemm g{BP(WS_CQ), (const bf16_t*)(wl + OW_QUP), T, QUPWP, QL}; S.init(T, QUPWP, G, bid); pg8::EpiQ E{FP(WS_SSQCQ), BP(WS_Q)};
                    pg8::gemm_phase<pg8::EpiQ, pg8::StaticOrder, true, true>(lds, g, S, E, tid); }
                if ((p.sub & 4) && ((PHM & 512) != 0)) { pg8::Gemm g{BP(WS_CKV), (const bf16_t*)(wl + OW_KVUP), T, KVUPW, KVL}; S.init(T, KVUPW, G, bid);
                    pg8::EpiKV E{FP(WS_SSQCKV), FP(WS_SSQPE), p.in[I_KNG] + l * QKD, FP(WS_ROPE), BP(WS_KPE), BP(WS_K), BP(WS_V), (LAS float*)(lds + XCH_OFF)};
                    pg8::gemm_phase<pg8::EpiKV, pg8::StaticOrder, true, true>(lds, g, S, E, tid); }
            } else if (s == 2 && ((PHM & 4) != 0)) {
                if ((p.sub & 1) && ((PHM & 1024) != 0)) {
                    const int vcu = (G % 8 == 0) ? (bid % 8) * (G / 8) + bid / 8 : bid;
                    for (int ui = vcu; ui < BATCH * NH * 8; ui += G) { const int bh = ui >> 3, qb = ui & 7, b = bh / NH, h = bh - b * NH; const size_t row0 = (size_t)b * SEQ + qb * 256;
                        att::attn_unit(BP(WS_Q) + row0 * QUPW + h * QKD, BP(WS_K) + (size_t)b * SEQ * QUPW + h * QKD, BP(WS_V) + (size_t)b * SEQ * AW + h * VD, BP(WS_MIX) + row0 * 1024 + h * VD,
                                       FP(WS_SSQA) + row0 * 8 + h, p.in[I_QNG] + l * QKD, FP(WS_ROPE) + row0 * 64, (LAS char*)lds, tid); }
                }
                if ((p.sub & 2) && ((PHM & 2048) != 0)) { pg8::Gemm g{BP(WS_PQ), (const bf16_t*)(wl + OW_Y), T, 256, 512}; S.init(T, 256, G, bid);
                    pg8::EpiY E{BP(WS_MIX), (LAS float*)(lds + XCH_OFF)};
                    pg8::gemm_phase<pg8::EpiY, pg8::StaticOrder, true, true>(lds, g, S, E, tid); }
            } else if (s == 3 && ((PHM & 8) != 0)) {
                pg8::Gemm g{BP(WS_MIX), (const bf16_t*)(wl + OW_OUT), T, DM, DM}; S.init(T, DM, G, bid);
                pg8::EpiRes<12> E{l == 0 ? p.x : p.out, p.out, BP(WS_XB), FP(WS_SSQX), FP(WS_SSQA)};
                pg8::gemm_phase<pg8::EpiRes<12>, pg8::StaticOrder, true, true>(lds, g, S, E, tid);
            } else if (s == 4 && ((PHM & 16) != 0)) {
                pg8::Gemm g{BP(WS_XB), (const bf16_t*)(wl + OW_MI), T, FF, DM}; S.init(T, FF, G, bid);
                pg8::EpiMlpIn E{FP(WS_SSQX), BP(WS_H)};
                pg8::gemm_phase<pg8::EpiMlpIn, pg8::StaticOrder, true, true>(lds, g, S, E, tid);
            } else if ((PHM & 32) != 0) {
                pg8::Gemm g{BP(WS_H), (const bf16_t*)(wl + OW_MO), T, DM, FF}; S.init(T, DM, G, bid);
                pg8::EpiRes<0> E{p.out, p.out, BP(WS_XB), FP(WS_SSQX), nullptr};
                pg8::gemm_phase<pg8::EpiRes<0>, pg8::StaticOrder, true, true>(lds, g, S, E, tid);
            }
        }
        if (ph + 1 < p.ph_hi) xcd_barrier(bar); else __syncthreads();
    }
}


extern "C" void kernel_launch(void* const* d_in, const int* in_sizes, int n_in, void* d_out, int out_size, void* d_ws, size_t ws_size, hipStream_t stream) {
    static int grid = 0;
    if (grid == 0) {
        if (n_in != 17 || in_sizes[0] != T * DM || out_size != T * DM || ws_size < WS_END) {
            fprintf(stderr, "kernel_launch: shape/workspace mismatch: n_in %d in0 %d out %d ws %zu (need %zu)\n", n_in, n_in > 0 ? in_sizes[0] : -1, out_size, ws_size, (size_t)WS_END);
            grid = -1; return; }
        if (hipFuncSetAttribute((const void*)mk, hipFuncAttributeMaxDynamicSharedMemorySize, MK_LDS) != hipSuccess) { fprintf(stderr, "kernel_launch: hipFuncSetAttribute failed\n"); grid = -1; return; }
        int dev = 0, cus = 0, per_cu = 0;
        if (hipGetDevice(&dev) != hipSuccess || hipDeviceGetAttribute(&cus, hipDeviceAttributeMultiprocessorCount, dev) != hipSuccess) { fprintf(stderr, "kernel_launch: device query failed\n"); grid = -1; return; }
        if (hipOccupancyMaxActiveBlocksPerMultiprocessor(&per_cu, (const void*)mk, MK_THREADS, MK_LDS) != hipSuccess || per_cu < 1) { fprintf(stderr, "kernel_launch: occupancy query says %d blocks per CU\n", per_cu); grid = -1; return; }
        grid = cus;
    }
    if (grid < 0) return;
    Params p{};
    p.x = (const float*)d_in[0]; p.pos = (const int*)d_in[1];
    for (int i = 0; i < 15; ++i) p.in[i] = (const float*)d_in[2 + i];
    p.out = (float*)d_out; p.ws = (unsigned char*)d_ws; p.ph_lo = 0; p.ph_hi = N_PHASES; p.sub = 7; p.pad = 0;
    if (hipMemsetAsync((char*)d_ws + WS_CTL, 0, CTL_ZERO_BYTES, stream) != hipSuccess) { fprintf(stderr, "kernel_launch: hipMemsetAsync failed\n"); return; }
    hipLaunchKernelGGL(mk, dim3(grid), dim3(MK_THREADS), MK_LDS, stream, p);
    const hipError_t le = hipPeekAtLastError();
    if (le != hipSuccess) fprintf(stderr, "kernel_launch: launch failed: %s (grid %d)\n", hipGetErrorName(le), grid);
}
```

```cpp
#include <hip/hip_runtime.h>
#include <cstdio>
#include <cstdint>

typedef unsigned short bf16_t;
typedef short bf16x8 __attribute__((ext_vector_type(8)));
typedef float f32x4 __attribute__((ext_vector_type(4)));
typedef unsigned u32x4 __attribute__((ext_vector_type(4)));
typedef unsigned u32x2 __attribute__((ext_vector_type(2)));
#define LAS __attribute__((address_space(3)))

constexpr int BATCH = 16, SEQ = 2048, DM = 1024, T = BATCH * SEQ, DEPTH = 2;
constexpr int FW = 256, QL = 256, KVL = 256, ROPE_D = 64, NOPE = 128, VD = 128, NH = 6, QKD = 192;
constexpr int INW = 832, INWP = 1024, QUPW = NH * QKD  , QUPWP = 1280, KVUPW = NH * 256  , AW = NH * VD  , FF = 4096;
constexpr float EPS = 1e-6f;
constexpr float QSCALE = 0.07216878364870322f * 1.4426950408889634f;
constexpr float DFT_NRM = 0.0027621358640099515f;

constexpr size_t MiB = 1u << 20;
constexpr size_t WS_CTL = 0;
constexpr size_t WS_W = 1 * MiB, LW = 22 * MiB;
constexpr size_t OW_IN = 0, OW_QUP = 2 * MiB, OW_KVUP = OW_QUP + 640 * 1024, OW_OUT = OW_KVUP + 768 * 1024, OW_MI = OW_OUT + 2 * MiB, OW_MO = OW_MI + 8 * MiB, OW_Y = OW_MO + 8 * MiB;
static_assert(OW_Y + 256 * 1024 <= LW, "layer weight block");
constexpr size_t WS_F = 45 * MiB;
constexpr size_t WS_SSQX = 61 * MiB;
constexpr size_t WS_SSQCQ = 63 * MiB, WS_SSQCKV = WS_SSQCQ + 512 * 1024;
constexpr size_t WS_XB = 64 * MiB;
constexpr size_t WS_MIX = 128 * MiB;
constexpr size_t WS_Q = 192 * MiB;
constexpr size_t WS_K = 264 * MiB;
constexpr size_t WS_V = 336 * MiB;
constexpr size_t WS_PQ = 384 * MiB;
constexpr size_t WS_UT = 416 * MiB;
constexpr size_t WS_H = 192 * MiB;
constexpr size_t WS_CQ = 448 * MiB, WS_CKV = 464 * MiB;
constexpr size_t WS_KPE = 480 * MiB;
constexpr size_t WS_ROPE = 484 * MiB;
constexpr size_t WS_SSQPE = 492 * MiB;
constexpr size_t WS_SSQA = WS_SSQPE + 256 * 1024;
constexpr size_t WS_RSTD = 494 * MiB;
constexpr size_t WS_END = 495 * MiB;
constexpr size_t WS_KRAW = 384 * MiB;
constexpr size_t WS_S = 384 * MiB;

__device__ __forceinline__ unsigned f2bf(float f) { unsigned u = __builtin_bit_cast(unsigned, f); return (u + 0x7fffu + ((u >> 16) & 1u)) >> 16; }
__device__ __forceinline__ unsigned pk2(float lo, float hi) { return f2bf(lo) | (f2bf(hi) << 16); }
__device__ __forceinline__ float bf2f(bf16_t h) { return __builtin_bit_cast(float, (unsigned)h << 16); }
__device__ __forceinline__ float add_xor32(float v) { auto rr = __builtin_amdgcn_permlane32_swap(__float_as_uint(v), __float_as_uint(v), false, false); return __uint_as_float(rr[0]) + __uint_as_float(rr[1]); }
__device__ __forceinline__ float add_xor16(float v) { return v + __uint_as_float(__builtin_amdgcn_ds_swizzle(__float_as_uint(v), 0x401F)); }
__device__ __forceinline__ float add_xor1(float v) { return v + __uint_as_float(__builtin_amdgcn_ds_swizzle(__float_as_uint(v), 0x041F)); }
__device__ __forceinline__ float wave_sum(float v) {
#pragma unroll
    for (int o = 1; o < 64; o <<= 1) v += __shfl_xor(v, o);
    return v;
}

struct Params {
    const float* x; const int* pos; const float* in[15];
    float* out; unsigned char* ws; int ph_lo, ph_hi, sub, pad;
};
enum { I_ANG = 0, I_WIN, I_WF, I_QAG, I_WQUP, I_KVAG, I_WKVUP, I_QNG, I_KNG, I_FOG, I_AOG, I_WOUT, I_MNG, I_WMI, I_WMO };

namespace pg8 {
#define PG8_LAS __attribute__((address_space(3)))
typedef unsigned short bf16_t;
typedef short bf16x8 __attribute__((ext_vector_type(8)));
typedef float f32x4 __attribute__((ext_vector_type(4)));
typedef unsigned u32x4 __attribute__((ext_vector_type(4)));
constexpr int BM = 256, BK = 64, HALF = 128, HTB = HALF * BK * 2  , STAGE_BYTES = 8 * HTB, NXCD = 8, WGM = 8;

__host__ __device__ __forceinline__ int lds_byte(int r, int c) { const int st = (r >> 4) * 2 + (c >> 5), rr = r & 15, cc = c & 31, ob = rr * 64 + cc * 2; return st * 1024 + (ob ^ (((ob >> 9) & 1) << 5)); }
__host__ __device__ __forceinline__ void stage_rc(int b, int& R, int& C) { const int st = b / 1024, sb = b % 1024, swz = sb ^ (((sb >> 9) & 1) << 5); R = (st >> 1) * 16 + swz / 64; C = (st & 1) * 32 + (swz % 64) / 2; }
__host__ __device__ __forceinline__ int perm32(int rho) { const int n = rho >> 4, i = rho & 15; return 8 * (i >> 2) + 4 * n + (i & 3); }

struct Unit { int pm, pn; };
struct Gemm { const bf16_t* A; const bf16_t* Bt; int M, N, K; };

struct StaticOrder {
    int nM, nN, nwg, G, c;
    __host__ __device__ void init(int M, int N, int G_, int c_) { nM = M / BM; nN = N / BM; nwg = nM * nN; G = G_; c = c_; }
    __host__ __device__ bool next(int i, Unit& u) const {
        const long L = (long)i * G + c; if (L >= nwg) return false;
        int wgid = (int)L; { const int q = nwg / NXCD, r = nwg % NXCD, xcd = wgid % NXCD, off = wgid / NXCD; wgid = (xcd < r ? xcd * (q + 1) : r * (q + 1) + (xcd - r) * q) + off; }
        const int nig = WGM * nN, gid = wgid / nig, fm = gid * WGM, gsz = (nM - fm) < WGM ? (nM - fm) : WGM;
        u.pm = fm + ((wgid % nig) % gsz); u.pn = (wgid % nig) / gsz; return true;
    }
    __device__ __forceinline__ void a_ready(const Unit&) const {}
    __device__ __forceinline__ void done(const Unit&) const {}
};

template <class Epi, class Sched, bool ALIGN_EPI = false, bool SP2 = false>
__device__ __forceinline__ void gemm_phase(PG8_LAS unsigned char* lds, const Gemm g, const Sched& S, const Epi& E, const int tid) {
    const int wid = __builtin_amdgcn_readfirstlane(tid >> 6), lane = tid & 63, wr = wid >> 2, wc = wid & 3, fr = lane & 15, fq = lane >> 4;
    int K_ = g.K; asm volatile("" : "+s"(K_));
    const int K = K_, nt = K / BK;
    unsigned voffA[2], voffB[2];
#pragma unroll
    for (int i = 0; i < 2; ++i) { int R, C; stage_rc(tid * 16 + i * 8192, R, C); const int Rb = Epi::PERM ? ((R & ~31) + perm32(R & 31)) : R;
        voffA[i] = (unsigned)(R * K + C) * 2u; voffB[i] = (unsigned)(Rb * K + C) * 2u; }
    const size_t kstep = (size_t)(BK * 2);
    const size_t hstep = (size_t)HALF * K * 2;
    const size_t tstep = 2 * hstep;
    const unsigned ldsw = (unsigned)wid * 1024u;
    const int aoff = lds_byte(wr * 64 + fr, fq * 8), boff = lds_byte(wc * 32 + fr, fq * 8);
#define PG8_SA(b, h) (((b) * 2 + (h)) * HTB)
#define PG8_SB(b, h) ((4 + (b) * 2 + (h)) * HTB)
#define PG8_STAGE(bufoff, gbase, voff) do { _Pragma("unroll") for (int _i = 0; _i < 2; ++_i) \
        __builtin_amdgcn_global_load_lds((const unsigned*)((const char*)(gbase) + (voff)[_i]), (PG8_LAS unsigned*)(lds + (bufoff) + ldsw + _i * 8192), 16, 0, 0); } while (0)
#define PG8_LDA(dst, b, h) do { _Pragma("unroll") for (int m = 0; m < 4; ++m) _Pragma("unroll") for (int k = 0; k < 2; ++k) dst[m][k] = *(const PG8_LAS bf16x8*)(lds + PG8_SA(b, h) + aoff + m * 2048 + k * 1024); } while (0)
#define PG8_LDB(dst, b, h) do { _Pragma("unroll") for (int n = 0; n < 2; ++n) _Pragma("unroll") for (int k = 0; k < 2; ++k) dst[n][k] = *(const PG8_LAS bf16x8*)(lds + PG8_SB(b, h) + boff + n * 2048 + k * 1024); } while (0)
#define PG8_MMA(ai, bj, At, Bt) do { __builtin_amdgcn_s_setprio(1); _Pragma("unroll") for (int m = 0; m < 4; ++m) _Pragma("unroll") for (int n = 0; n < 2; ++n) _Pragma("unroll") for (int k = 0; k < 2; ++k) \
        acc[ai][bj][m][n] = __builtin_amdgcn_mfma_f32_16x16x32_bf16(Bt[n][k], At[m][k], acc[ai][bj][m][n], 0, 0, 0); __builtin_amdgcn_s_setprio(0); } while (0)
#define PG8_WAIT_V(n) asm volatile("s_waitcnt vmcnt(" #n ")" ::: "memory")
#define PG8_WAIT_L(n) asm volatile("s_waitcnt lgkmcnt(" #n ")" ::: "memory")
#define PG8_BAR __builtin_amdgcn_s_barrier()
#define PG8_SCHED __builtin_amdgcn_sched_barrier(0)
    Unit cur, nxt; int ui = 0;
    if (!S.next(0, cur)) return;
    f32x4 acc[2][2][4][2];
#pragma unroll
    for (int a = 0; a < 2; ++a)
#pragma unroll
        for (int b = 0; b < 2; ++b)
#pragma unroll
            for (int m = 0; m < 4; ++m)
#pragma unroll
                for (int n = 0; n < 2; ++n) acc[a][b][m][n] = (f32x4){0.f, 0.f, 0.f, 0.f};
    bf16x8 At[4][2], B0[2][2], B1[2][2];
    const char* cA = (const char*)g.A + (size_t)cur.pm * tstep; const char* cB = (const char*)g.Bt + (size_t)cur.pn * tstep;
    S.a_ready(cur);
    if constexpr (SP2) {
        PG8_STAGE(PG8_SB(0, 0), cB, voffB); PG8_STAGE(PG8_SB(0, 1), cB + hstep, voffB); PG8_STAGE(PG8_SA(0, 0), cA, voffA); PG8_STAGE(PG8_SA(0, 1), cA + hstep, voffA);
        if (wr == 1) PG8_BAR;
        PG8_WAIT_V(2); PG8_BAR;
        PG8_STAGE(PG8_SB(1, 0), cB + kstep, voffB); PG8_STAGE(PG8_SA(1, 0), cA + kstep, voffA); PG8_STAGE(PG8_SB(1, 1), cB + hstep + kstep, voffB);
        PG8_WAIT_V(6); PG8_BAR;
    } else {
        PG8_STAGE(PG8_SB(0, 0), cB, voffB); PG8_STAGE(PG8_SA(0, 0), cA, voffA); PG8_STAGE(PG8_SB(0, 1), cB + hstep, voffB); PG8_STAGE(PG8_SA(0, 1), cA + hstep, voffA);
        if (wr == 1) PG8_BAR;
        PG8_WAIT_V(4); PG8_BAR;
        PG8_STAGE(PG8_SB(1, 0), cB + kstep, voffB); PG8_STAGE(PG8_SA(1, 0), cA + kstep, voffA); PG8_STAGE(PG8_SB(1, 1), cB + hstep + kstep, voffB);
        PG8_WAIT_V(6); PG8_BAR;
    }
    for (;;) {
        const bool has_next = S.next(ui + 1, nxt);
        const char* nA = has_next ? (const char*)g.A + (size_t)nxt.pm * tstep : cA; const char* nB = has_next ? (const char*)g.Bt + (size_t)nxt.pn * tstep : cB;
        for (int t = 0; t < nt; t += 2) {
            const bool last = (t == nt - 2);
            const char* a1 = cA + (size_t)(t + 1) * kstep;
            const char* a2 = last ? nA : cA + (size_t)(t + 2) * kstep; const char* b2 = last ? nB : cB + (size_t)(t + 2) * kstep;
            const char* a3 = a2 + kstep; const char* b3 = b2 + kstep;
            if (last && has_next) S.a_ready(nxt);
            if constexpr (SP2) {
            PG8_LDB(B0, 0, 0); PG8_LDB(B1, 0, 1); PG8_SCHED; PG8_LDA(At, 0, 0); PG8_STAGE(PG8_SA(1, 1), a1 + hstep, voffA);
            PG8_WAIT_V(8); PG8_WAIT_L(0); PG8_BAR; PG8_MMA(0, 0, At, B0); PG8_MMA(0, 1, At, B1); PG8_BAR; PG8_SCHED;
            PG8_LDA(At, 0, 1); PG8_STAGE(PG8_SB(0, 0), b2, voffB); PG8_STAGE(PG8_SB(0, 1), b2 + hstep, voffB); PG8_STAGE(PG8_SA(0, 0), a2, voffA);
            PG8_WAIT_V(8); PG8_WAIT_L(0); PG8_BAR; PG8_MMA(1, 0, At, B0); PG8_MMA(1, 1, At, B1); PG8_BAR; PG8_SCHED;
            PG8_LDB(B0, 1, 0); PG8_LDB(B1, 1, 1); PG8_SCHED; PG8_LDA(At, 1, 0); PG8_STAGE(PG8_SA(0, 1), a2 + hstep, voffA);
            PG8_WAIT_V(8); PG8_WAIT_L(0); PG8_BAR; PG8_MMA(0, 0, At, B0); PG8_MMA(0, 1, At, B1); PG8_BAR; PG8_SCHED;
            PG8_LDA(At, 1, 1); PG8_STAGE(PG8_SB(1, 0), b3, voffB); PG8_STAGE(PG8_SB(1, 1), b3 + hstep, voffB); PG8_STAGE(PG8_SA(1, 0), a3, voffA);
            PG8_WAIT_V(8); PG8_WAIT_L(0); PG8_BAR; PG8_MMA(1, 0, At, B0); PG8_MMA(1, 1, At, B1); PG8_BAR; PG8_SCHED;
            } else {
            PG8_LDB(B0, 0, 0); PG8_SCHED; PG8_LDA(At, 0, 0); PG8_STAGE(PG8_SA(1, 1), a1 + hstep, voffA);
            PG8_WAIT_L(8); PG8_BAR; PG8_WAIT_L(0); PG8_MMA(0, 0, At, B0); PG8_BAR; PG8_SCHED;
            PG8_LDB(B1, 0, 1); PG8_STAGE(PG8_SB(0, 0), b2, voffB);
            PG8_BAR; PG8_WAIT_L(0); PG8_MMA(0, 1, At, B1); PG8_BAR;
            PG8_LDA(At, 0, 1); PG8_STAGE(PG8_SA(0, 0), a2, voffA);
            PG8_BAR; PG8_WAIT_L(0); PG8_MMA(1, 0, At, B0); PG8_BAR; PG8_SCHED;
            PG8_STAGE(PG8_SB(0, 1), b2 + hstep, voffB);
            PG8_WAIT_V(6); PG8_BAR; PG8_MMA(1, 1, At, B1); PG8_BAR;
            PG8_LDB(B0, 1, 0); PG8_SCHED; PG8_LDA(At, 1, 0); PG8_STAGE(PG8_SA(0, 1), a2 + hstep, voffA);
            PG8_WAIT_L(8); PG8_BAR; PG8_WAIT_L(0); PG8_MMA(0, 0, At, B0); PG8_BAR; PG8_SCHED;
            PG8_LDB(B1, 1, 1); PG8_STAGE(PG8_SB(1, 0), b3, voffB);
            PG8_BAR; PG8_WAIT_L(0); PG8_MMA(0, 1, At, B1); PG8_BAR;
            PG8_LDA(At, 1, 1); PG8_STAGE(PG8_SA(1, 0), a3, voffA);
            PG8_BAR; PG8_WAIT_L(0); PG8_MMA(1, 0, At, B0); PG8_BAR; PG8_SCHED;
            PG8_STAGE(PG8_SB(1, 1), b3 + hstep, voffB);
            PG8_WAIT_V(6); PG8_BAR; PG8_MMA(1, 1, At, B1); PG8_BAR;
            }
            if constexpr (Epi::MIDK > 0) { if (t + 2 == Epi::MIDK) E.midk(acc, cur, wr, fr); }
        }
        if constexpr (ALIGN_EPI) { if (wr == 0) PG8_BAR; }
        if constexpr (!Epi::AFTER_DRAIN) { E(acc, cur, wr, wc, fr, fq); S.done(cur); }
        if (!has_next) break;
#pragma unroll
        for (int a = 0; a < 2; ++a)
#pragma unroll
            for (int b = 0; b < 2; ++b)
#pragma unroll
                for (int m = 0; m < 4; ++m)
#pragma unroll
                    for (int n = 0; n < 2; ++n) acc[a][b][m][n] = (f32x4){0.f, 0.f, 0.f, 0.f};
        cur = nxt; cA = nA; cB = nB; ++ui;
        if constexpr (ALIGN_EPI) { if (wr == 1) PG8_BAR; }
    }
    PG8_WAIT_V(0);
    if constexpr (!ALIGN_EPI) { if (wr == 0) PG8_BAR; }
    PG8_BAR;
    if constexpr (Epi::AFTER_DRAIN) { E.fused(acc, cur, wr, wc, fr, fq, lds, wid, lane); S.done(cur); }
#undef PG8_SA
#undef PG8_SB
#undef PG8_STAGE
#undef PG8_LDA
#undef PG8_LDB
#undef PG8_MMA
#undef PG8_WAIT_V
#undef PG8_WAIT_L
#undef PG8_BAR
#undef PG8_SCHED
}
}

namespace pg8 {
__device__ __forceinline__ unsigned cvt_pk_bf16(float lo, float hi) { unsigned r; asm volatile("v_cvt_pk_bf16_f32 %0, %1, %2" : "=v"(r) : "v"(lo), "v"(hi)); return r; }
__device__ __forceinline__ u32x4 pack8(const f32x4 a, const f32x4 b) { u32x4 w; w.x = cvt_pk_bf16(a[0], a[1]); w.y = cvt_pk_bf16(a[2], a[3]); w.z = cvt_pk_bf16(b[0], b[1]); w.w = cvt_pk_bf16(b[2], b[3]); return w; }
__device__ __forceinline__ float sum4(const f32x4 a) { return (a[0] + a[1]) + (a[2] + a[3]); }
__device__ __forceinline__ float ssq4(const f32x4 a) { return (a[0] * a[0] + a[1] * a[1]) + (a[2] * a[2] + a[3] * a[3]); }
__device__ __forceinline__ float rstd16(const float* p, float invn) { const f32x4* q = (const f32x4*)p; const f32x4 a = q[0], b = q[1], c = q[2], d = q[3]; return rsqrtf(((sum4(a) + sum4(b)) + (sum4(c) + sum4(d))) * invn + 1e-6f); }
__device__ __forceinline__ float rstd4(const float* p, float invn) { const f32x4 a = *(const f32x4*)p; return rsqrtf(sum4(a) * invn + 1e-6f); }
__device__ __forceinline__ float fq_sum(float s) { return add_xor32(add_xor16(s)); }

#define PG8_EPI_BAR() do { asm volatile("s_waitcnt lgkmcnt(0)" ::: "memory"); __builtin_amdgcn_s_barrier(); asm volatile("" ::: "memory"); } while (0)
typedef float f32x2 __attribute__((ext_vector_type(2)));
typedef unsigned u32x2 __attribute__((ext_vector_type(2)));
__device__ __forceinline__ void rstd8(float (&rs)[2][4], const float* part, int row0, float invn) {
    f32x4 t[2][4];
#pragma unroll
    for (int ai = 0; ai < 2; ++ai)
#pragma unroll
        for (int m = 0; m < 4; ++m) t[ai][m] = *(const f32x4*)(part + (size_t)(row0 + ai * HALF + m * 16) * 4);
#pragma unroll
    for (int ai = 0; ai < 2; ++ai)
#pragma unroll
        for (int m = 0; m < 4; ++m) rs[ai][m] = rsqrtf(sum4(t[ai][m]) * invn + 1e-6f);
}
struct EpiMlpIn { static constexpr bool PERM = true, AFTER_DRAIN = false; static constexpr int MIDK = 0;
    const float* ssqx; bf16_t* H;
    __device__ __forceinline__ void operator()(const f32x4 (&acc)[2][2][4][2], const Unit& u, int wr, int wc, int fr, int fq) const {
        const int row0 = u.pm * BM + wr * 64 + fr, col0 = u.pn * BM + wc * 32 + 8 * fq;
        float rs[2][4]; rstd8(rs, ssqx, row0, 1.f / 1024.f);
#pragma unroll
        for (int ai = 0; ai < 2; ++ai)
#pragma unroll
            for (int m = 0; m < 4; ++m) { bf16_t* rowp = H + (size_t)(row0 + ai * HALF + m * 16) * 4096 + col0;
#pragma unroll
                for (int bj = 0; bj < 2; ++bj) { f32x4 v0 = acc[ai][bj][m][0] * rs[ai][m], v1 = acc[ai][bj][m][1] * rs[ai][m];
#pragma unroll
                    for (int i = 0; i < 4; ++i) { const float a = fmaxf(v0[i], 0.f), b = fmaxf(v1[i], 0.f); v0[i] = a * a; v1[i] = b * b; }
                    *(u32x4*)(rowp + bj * HALF) = pack8(v0, v1); } }
    }
};
template <int MIDK_> struct EpiRes { static constexpr bool PERM = true, AFTER_DRAIN = false; static constexpr int MIDK = MIDK_;
    const float* xold; float* xnew; bf16_t* XB; float* ssqx; const float* ssqa; PG8_LAS float* xch;
    __device__ __forceinline__ void midk(f32x4 (&acc)[2][2][4][2], const Unit& u, int wr, int fr) const {
#pragma unroll
        for (int ai = 0; ai < 2; ++ai)
#pragma unroll
            for (int mp = 0; mp < 2; ++mp) { f32x4 a[2], b[2];
#pragma unroll
                for (int k = 0; k < 2; ++k) { const float* q = ssqa + (size_t)(u.pm * BM + ai * HALF + wr * 64 + (2 * mp + k) * 16 + fr) * 8; a[k] = *(const f32x4*)q; b[k] = *(const f32x4*)(q + 4); }
#pragma unroll
                for (int k = 0; k < 2; ++k) { const float rs = rsqrtf((sum4(a[k]) + (b[k][0] + b[k][1])) * (1.f / 768.f) + 1e-6f);
#pragma unroll
                    for (int bj = 0; bj < 2; ++bj)
#pragma unroll
                        for (int n = 0; n < 2; ++n) acc[ai][bj][2 * mp + k][n] *= rs; }
                asm volatile("" ::: "memory"); }
    }
    __device__ __forceinline__ void operator()(const f32x4 (&acc)[2][2][4][2], const Unit& u, int wr, int wc, int fr, int fq) const {
        const int row0 = u.pm * BM + wr * 64 + fr, col0 = u.pn * BM + wc * 32 + 8 * fq;
        PG8_LAS float* xw = xch + (wr * 64 + fr) * 4 + wc; asm volatile("" : "+v"(xw));
#pragma unroll
        for (int ai = 0; ai < 2; ++ai) { f32x4 pre[4][2][2];
#pragma unroll
            for (int m = 0; m < 4; ++m)
#pragma unroll
                for (int bj = 0; bj < 2; ++bj) { const float* q = xold + (size_t)(row0 + ai * HALF + m * 16) * 1024 + col0 + bj * HALF; pre[m][bj][0] = *(const f32x4*)q; pre[m][bj][1] = *(const f32x4*)(q + 4); }
#pragma unroll
            for (int m = 0; m < 4; ++m) { float s = 0.f;
#pragma unroll
                for (int bj = 0; bj < 2; ++bj) { const size_t off = (size_t)(row0 + ai * HALF + m * 16) * 1024 + col0 + bj * HALF;
                    const f32x4 o0 = pre[m][bj][0] + acc[ai][bj][m][0], o1 = pre[m][bj][1] + acc[ai][bj][m][1];
                    *(f32x4*)(xnew + off) = o0; *(f32x4*)(xnew + off + 4) = o1; *(u32x4*)(XB + off) = pack8(o0, o1); s += ssq4(o0) + ssq4(o1); }
                s = fq_sum(s); if (fq == 0) xw[(ai * HALF + m * 16) * 4] = s; }
            asm volatile("" ::: "memory"); }
        PG8_EPI_BAR();
        const int t = (wr * 4 + wc) * 64 + fq * 16 + fr;
        if (t < 256) { const f32x4 pz = *(const PG8_LAS f32x4*)(xch + t * 4); ssqx[(size_t)(u.pm * BM + t) * 4 + u.pn] = sum4(pz); }
    }
};
struct EpiIn { static constexpr bool PERM = true, AFTER_DRAIN = false; static constexpr int MIDK = 0;
    const float* ssqx; bf16_t *UT, *CQ, *CKV, *KPER; float *ssqcq, *ssqckv, *ssqpe; const float *gk, *rope;
    __device__ __forceinline__ void operator()(const f32x4 (&acc)[2][2][4][2], const Unit& u, int wr, int wc, int fr, int fq) const {
        const int row0 = u.pm * BM + wr * 64 + fr, c0 = wc * 32 + 8 * fq, pn = u.pn;
        float rs8[2][4]; rstd8(rs8, ssqx, row0, 1.f / 1024.f);
#pragma unroll
        for (int ai = 0; ai < 2; ++ai)
#pragma unroll
            for (int m = 0; m < 4; ++m) { const int row = row0 + ai * HALF + m * 16; const float rs = rs8[ai][m];
                if (pn == 0) { const int b = row >> 11, s = row & 2047; bf16_t* base = UT + ((size_t)(b * 256 + c0)) * 2048 + s;
#pragma unroll
                    for (int bj = 0; bj < 2; ++bj)
#pragma unroll
                        for (int n = 0; n < 2; ++n)
#pragma unroll
                            for (int i = 0; i < 4; ++i) base[(size_t)(bj * HALF + 4 * n + i) * 2048] = (bf16_t)(cvt_pk_bf16(acc[ai][bj][m][n][i] * rs, 0.f) & 0xffffu);
                } else if (pn < 3) { bf16_t* dst = (pn == 1 ? CQ : CKV) + (size_t)row * 256 + c0; float s = 0.f;
#pragma unroll
                    for (int bj = 0; bj < 2; ++bj) { const f32x4 v0 = acc[ai][bj][m][0] * rs, v1 = acc[ai][bj][m][1] * rs; *(u32x4*)(dst + bj * HALF) = pack8(v0, v1); s += ssq4(v0) + ssq4(v1); }
                    s = fq_sum(s); if (fq == 0) (pn == 1 ? ssqcq : ssqckv)[(size_t)row * 4 + wc] = s;
                } else if (wc < 2) { const int j = 16 * wc + 4 * fq; const f32x4 v0 = acc[ai][0][m][0] * rs, v1 = acc[ai][0][m][1] * rs;
                    const f32x4 x1 = v0 * *(const f32x4*)(gk + 128 + j), x2 = v1 * *(const f32x4*)(gk + 160 + j);
                    const f32x4 cs = *(const f32x4*)(rope + (size_t)row * 64 + j), sn = *(const f32x4*)(rope + (size_t)row * 64 + 32 + j);
                    const f32x4 o1 = x1 * cs - x2 * sn, o2 = x2 * cs + x1 * sn;
                    *(u32x2*)(KPER + (size_t)row * 64 + j) = (u32x2){cvt_pk_bf16(o1[0], o1[1]), cvt_pk_bf16(o1[2], o1[3])};
                    *(u32x2*)(KPER + (size_t)row * 64 + 32 + j) = (u32x2){cvt_pk_bf16(o2[0], o2[1]), cvt_pk_bf16(o2[2], o2[3])};
                    float s = fq_sum(ssq4(v0) + ssq4(v1)); if (fq == 0) ssqpe[(size_t)row * 2 + wc] = s; } }
    }
};
struct EpiDft { static constexpr bool PERM = true, AFTER_DRAIN = false; static constexpr int MIDK = 0;
    bf16_t* PQ;
    __device__ __forceinline__ void operator()(const f32x4 (&acc)[2][2][4][2], const Unit& u, int wr, int wc, int fr, int fq) const {
        const int pq = u.pm >> 3, sp0 = (u.pm & 7) * 256 + wr * 64 + fr, b = u.pn;
#pragma unroll
        for (int ai = 0; ai < 2; ++ai)
#pragma unroll
            for (int m = 0; m < 4; ++m) { bf16_t* rowp = PQ + ((size_t)(b * 2048 + sp0 + ai * HALF + m * 16)) * 512 + pq * 256 + wc * 32 + 8 * fq;
#pragma unroll
                for (int bj = 0; bj < 2; ++bj) *(u32x4*)(rowp + bj * HALF) = pack8(acc[ai][bj][m][0], acc[ai][bj][m][1]); }
    }
};
struct EpiQ { static constexpr bool PERM = true, AFTER_DRAIN = false; static constexpr int MIDK = 0;
    const float* ssqcq; bf16_t* Q;
    __device__ __forceinline__ void operator()(const f32x4 (&acc)[2][2][4][2], const Unit& u, int wr, int wc, int fr, int fq) const {
        const int row0 = u.pm * BM + wr * 64 + fr, col0 = u.pn * BM + wc * 32 + 8 * fq;
        float rs[2][4]; rstd8(rs, ssqcq, row0, 1.f / 256.f);
#pragma unroll
        for (int ai = 0; ai < 2; ++ai)
#pragma unroll
            for (int m = 0; m < 4; ++m) { bf16_t* rowp = Q + (size_t)(row0 + ai * HALF + m * 16) * 1152 + col0;
#pragma unroll
                for (int bj = 0; bj < 2; ++bj) if (col0 + bj * HALF < 1152) *(u32x4*)(rowp + bj * HALF) = pack8(acc[ai][bj][m][0] * rs[ai][m], acc[ai][bj][m][1] * rs[ai][m]); }
    }
};
struct EpiKV { static constexpr bool PERM = true, AFTER_DRAIN = false; static constexpr int MIDK = 0;
    const float *ssqckv, *ssqpe, *gk; const bf16_t* KPER; bf16_t *K, *V; PG8_LAS float* xch;
    __device__ __forceinline__ void operator()(const f32x4 (&acc)[2][2][4][2], const Unit& u, int wr, int wc, int fr, int fq) const {
        const int h = u.pn, row0 = u.pm * BM + wr * 64 + fr, c0 = wc * 32 + 8 * fq, j4 = 4 * (4 * wc + fq);
        float rck[2][4]; rstd8(rck, ssqckv, row0, 1.f / 256.f);
        PG8_LAS float* xw = xch + (wr * 64 + fr) * 4 + wc; asm volatile("" : "+v"(xw));
        f32x2 pe2[2][4]; u32x2 kp[2][4];
#pragma unroll
        for (int ai = 0; ai < 2; ++ai)
#pragma unroll
            for (int m = 0; m < 4; ++m) { const int row = row0 + ai * HALF + m * 16; pe2[ai][m] = *(const f32x2*)(ssqpe + (size_t)row * 2); kp[ai][m] = *(const u32x2*)(KPER + (size_t)row * 64 + j4);
                const f32x4 v0 = acc[ai][0][m][0] * rck[ai][m], v1 = acc[ai][0][m][1] * rck[ai][m]; const float s = fq_sum(ssq4(v0) + ssq4(v1));
                if (fq == 0) xw[(ai * HALF + m * 16) * 4] = s; }
        const f32x4 g0 = *(const f32x4*)(gk + c0), g1 = *(const f32x4*)(gk + c0 + 4);
        PG8_EPI_BAR();
        const PG8_LAS float* xr = xw - wc;
#pragma unroll
        for (int ai = 0; ai < 2; ++ai)
#pragma unroll
            for (int m = 0; m < 4; ++m) { const int row = row0 + ai * HALF + m * 16;
                const f32x4 part = *(const PG8_LAS f32x4*)(xr + (ai * HALF + m * 16) * 4);
                const float rc = rck[ai][m], rk = rsqrtf((sum4(part) + (pe2[ai][m][0] + pe2[ai][m][1])) * (1.f / 192.f) + 1e-6f), rr = rc * rk;
                *(u32x4*)(K + (size_t)row * 1152 + h * 192 + c0) = pack8(acc[ai][0][m][0] * rr * g0, acc[ai][0][m][1] * rr * g1);
                *(u32x4*)(V + (size_t)row * 768 + h * 128 + c0) = pack8(acc[ai][1][m][0] * rc, acc[ai][1][m][1] * rc);
                const unsigned a = kp[ai][m][0], b = kp[ai][m][1];
                *(u32x2*)(K + (size_t)row * 1152 + h * 192 + 128 + j4) = (u32x2){cvt_pk_bf16(__builtin_bit_cast(float, a << 16) * rk, __builtin_bit_cast(float, a & 0xffff0000u) * rk),
                                                                               cvt_pk_bf16(__builtin_bit_cast(float, b << 16) * rk, __builtin_bit_cast(float, b & 0xffff0000u) * rk)}; }
    }
};
struct EpiY { static constexpr bool PERM = true, AFTER_DRAIN = false; static constexpr int MIDK = 0;
    bf16_t* MIX; PG8_LAS float* xch;
    __device__ __forceinline__ void operator()(const f32x4 (&acc)[2][2][4][2], const Unit& u, int wr, int wc, int fr, int fq) const {
        const int row0 = u.pm * BM + wr * 64 + fr, c0 = wc * 32 + 8 * fq;
        PG8_LAS float* xw = xch + (wr * 64 + fr) * 4 + wc; asm volatile("" : "+v"(xw));
#pragma unroll
        for (int ai = 0; ai < 2; ++ai)
#pragma unroll
            for (int m = 0; m < 4; ++m) { float s = 0.f;
#pragma unroll
                for (int bj = 0; bj < 2; ++bj) s += ssq4(acc[ai][bj][m][0]) + ssq4(acc[ai][bj][m][1]);
                s = fq_sum(s); if (fq == 0) xw[(ai * HALF + m * 16) * 4] = s; }
        PG8_EPI_BAR();
        const PG8_LAS float* xr = xw - wc;
#pragma unroll
        for (int ai = 0; ai < 2; ++ai)
#pragma unroll
            for (int m = 0; m < 4; ++m) { const int row = row0 + ai * HALF + m * 16;
                const f32x4 part = *(const PG8_LAS f32x4*)(xr + (ai * HALF + m * 16) * 4); const float rf = rsqrtf(sum4(part) * (1.f / 256.f) + 1e-6f);
                bf16_t* rowp = MIX + (size_t)row * 1024 + 768 + c0;
#pragma unroll
                for (int bj = 0; bj < 2; ++bj) *(u32x4*)(rowp + bj * HALF) = pack8(acc[ai][bj][m][0] * rf, acc[ai][bj][m][1] * rf); }
    }
};
}

namespace att {
using f32x16 = __attribute__((ext_vector_type(16))) float;
using s16x4 = __attribute__((ext_vector_type(4))) short;
constexpr int NW = 8, QBLK = 32, KVBLK = 64, LDQ = 1152, LDK = 1152, LDV = 768;
constexpr int SHM_V = KVBLK * 128 * 2, SHM_K = KVBLK * 192 * 2;
constexpr int OFF_V = 0, OFF_K = 2 * SHM_V, OFF_WS = OFF_K + 2 * SHM_K, ATT_LDS = OFF_WS + NW * 64 * 4;
constexpr float THR = 8.f;
__device__ __forceinline__ int k_st(int key, int cc) { const int d0 = cc >> 1, hh = cc & 1; return d0 * 2048 + ((key * 32 + ((hh ^ ((key >> 3) & 1)) * 16)) ^ ((d0 & 1) * 64)); }
#define SBAR() __builtin_amdgcn_sched_barrier(0)
__device__ __forceinline__ int crow(int r, int hi) { return (r & 3) + 8 * (r >> 2) + 4 * hi; }
__device__ __forceinline__ unsigned cvtpk(float lo, float hi) { unsigned r; asm volatile("v_cvt_pk_bf16_f32 %0, %1, %2" : "=v"(r) : "v"(lo), "v"(hi)); return r; }

__device__ __forceinline__ void partialSM(f32x16& p0, f32x16& p1, float& m_reg, float& mn, float& alpha) {
  float pmax = p0[0];
#pragma unroll
  for (int r = 1; r < 16; ++r) pmax = fmaxf(pmax, p0[r]);
#pragma unroll
  for (int r = 0; r < 16; ++r) pmax = fmaxf(pmax, p1[r]);
  { auto rr = __builtin_amdgcn_permlane32_swap(__float_as_uint(pmax), __float_as_uint(pmax), false, false);
    pmax = fmaxf(__uint_as_float(rr[0]), __uint_as_float(rr[1])); }
  if (__builtin_expect(__all(pmax - m_reg <= THR), 1)) { mn = m_reg; alpha = 1.f; }
  else { mn = fmaxf(m_reg, pmax); alpha = __builtin_amdgcn_exp2f(m_reg - mn); m_reg = mn; }
#pragma unroll
  for (int r = 0; r < 16; ++r) p0[r] = p0[r] - mn;
#pragma unroll
  for (int r = 0; r < 16; ++r) p1[r] = p1[r] - mn;
#pragma unroll
  for (int r = 0; r < 16; ++r) p0[r] = __builtin_amdgcn_exp2f(p0[r]);
}
__device__ __forceinline__ void finishSM(f32x16& p0, f32x16& p1, float alpha, float& l_reg, bf16x8& pa0, bf16x8& pa1, bf16x8& pa2, bf16x8& pa3) {
#pragma unroll
  for (int r = 0; r < 16; ++r) p1[r] = __builtin_amdgcn_exp2f(p1[r]);
  float ps = 0;
#pragma unroll
  for (int r = 0; r < 16; ++r) ps += p0[r];
#pragma unroll
  for (int r = 0; r < 16; ++r) ps += p1[r];
  { auto rr = __builtin_amdgcn_permlane32_swap(__float_as_uint(ps), __float_as_uint(ps), false, false);
    ps = __uint_as_float(rr[0]) + __uint_as_float(rr[1]); }
  l_reg = l_reg * alpha + ps;
#define PK4(P, BASE, OUT) do { unsigned a0 = cvtpk(P[BASE + 0], P[BASE + 1]), a1 = cvtpk(P[BASE + 2], P[BASE + 3]);   \
    unsigned b0 = cvtpk(P[BASE + 4], P[BASE + 5]), b1 = cvtpk(P[BASE + 6], P[BASE + 7]);                              \
    auto r0 = __builtin_amdgcn_permlane32_swap(a0, b0, false, false); auto r1 = __builtin_amdgcn_permlane32_swap(a1, b1, false, false); \
    u32x4 w = {r0[0], r1[0], r0[1], r1[1]}; OUT = *reinterpret_cast<bf16x8*>(&w); } while (0)
  PK4(p0, 0, pa0); PK4(p0, 8, pa1); PK4(p1, 0, pa2); PK4(p1, 8, pa3);
#undef PK4
}
__device__ __forceinline__ void qkt(f32x16& p0, f32x16& p1, const LAS char* Ks, const bf16x8* qr, int kb) {
  p0 = f32x16{}; p1 = f32x16{};
  const LAS char* ke = Ks + kb; const LAS char* ko = Ks + (kb ^ 64);
#pragma unroll
  for (int d0 = 0; d0 < 12; ++d0) { const LAS char* a = (d0 & 1) ? ko : ke;
    const bf16x8 b0 = *(const LAS bf16x8*)(a + d0 * 2048);
    const bf16x8 b1 = *(const LAS bf16x8*)(a + d0 * 2048 + 1024);
    p0 = __builtin_amdgcn_mfma_f32_32x32x16_bf16(b0, qr[d0], p0, 0, 0, 0);
    p1 = __builtin_amdgcn_mfma_f32_32x32x16_bf16(b1, qr[d0], p1, 0, 0, 0); }
}
__device__ __forceinline__ int v_st(int k, int c) { const int kk = (k & ~0xC) | ((k & 4) << 1) | ((k & 8) >> 1); return ((kk >> 3) * 4 + (c >> 5)) * 512 + ((kk & 7) * 32 + (c & 31)) * 2; }
__device__ __forceinline__ int v_rd_base(int lane) { return ((lane & 3) << 3) | (((lane >> 2) & 3) << 6) | (((lane >> 4) & 1) << 5) | (((lane >> 5) & 1) << 8); }
constexpr int v_rd_off(int d0, int ks, int half) { return d0 * 512 + ks * 4096 + half * 2048; }
template <int OFF> __device__ __forceinline__ s16x4 tr_read(int vb) {
  s16x4 r; asm volatile("ds_read_b64_tr_b16 %0, %1 offset:%2" : "=&v"(r) : "v"(vb), "i"(OFF) : "memory"); return r;
}
template <int D0> __device__ __forceinline__ void pv_one(f32x16& od, int vb, bf16x8 pa0, bf16x8 pa1, bf16x8 pa2, bf16x8 pa3) {
  const s16x4 l0 = tr_read<v_rd_off(D0, 0, 0)>(vb), h0 = tr_read<v_rd_off(D0, 0, 1)>(vb), l1 = tr_read<v_rd_off(D0, 1, 0)>(vb), h1 = tr_read<v_rd_off(D0, 1, 1)>(vb);
  const s16x4 l2 = tr_read<v_rd_off(D0, 2, 0)>(vb), h2 = tr_read<v_rd_off(D0, 2, 1)>(vb), l3 = tr_read<v_rd_off(D0, 3, 0)>(vb), h3 = tr_read<v_rd_off(D0, 3, 1)>(vb);
  asm volatile("s_waitcnt lgkmcnt(0)" ::: "memory"); SBAR();
#define PK(L, H) (bf16x8){L[0], L[1], L[2], L[3], H[0], H[1], H[2], H[3]}
  od = __builtin_amdgcn_mfma_f32_32x32x16_bf16(pa0, PK(l0, h0), od, 0, 0, 0);
  od = __builtin_amdgcn_mfma_f32_32x32x16_bf16(pa1, PK(l1, h1), od, 0, 0, 0);
  od = __builtin_amdgcn_mfma_f32_32x32x16_bf16(pa2, PK(l2, h2), od, 0, 0, 0);
  od = __builtin_amdgcn_mfma_f32_32x32x16_bf16(pa3, PK(l3, h3), od, 0, 0, 0);
#undef PK
}
__device__ __forceinline__ void pv_d0(f32x16* o, int vb, bf16x8 pa0, bf16x8 pa1, bf16x8 pa2, bf16x8 pa3) {
  pv_one<0>(o[0], vb, pa0, pa1, pa2, pa3); pv_one<1>(o[1], vb, pa0, pa1, pa2, pa3); pv_one<2>(o[2], vb, pa0, pa1, pa2, pa3); pv_one<3>(o[3], vb, pa0, pa1, pa2, pa3);
}

__device__ __forceinline__ void attn_unit(const bf16_t* __restrict__ Qb, const bf16_t* __restrict__ Kh, const bf16_t* __restrict__ Vh, bf16_t* __restrict__ Ob, float* __restrict__ ssq,
                                          const float* __restrict__ gq, const float* __restrict__ rope, LAS char* lds, const int tid) {
  const int wid = tid >> 6, lane = tid & 63, r32 = lane & 31, hi = lane >> 5;
  LAS char* V_lds = lds + OFF_V; LAS char* K_lds = lds + OFF_K;
  LAS float* wsf = (LAS float*)(lds + OFF_WS) + wid * 64; LAS float* li_l = wsf; LAS float* al_l = wsf + 32;
  float m_reg = -1e30f, l_reg = 0; f32x16 o[4] = {}; bf16x8 qr[12];
  {
    const bf16_t* Qw = Qb + (long)(wid * QBLK + r32) * LDQ + hi * 8;
    bf16x8 raw[12]; float ss = 0.f;
#pragma unroll
    for (int d0 = 0; d0 < 12; ++d0) raw[d0] = *reinterpret_cast<const bf16x8*>(Qw + d0 * 16);
#pragma unroll
    for (int d0 = 0; d0 < 12; ++d0)
#pragma unroll
      for (int j = 0; j < 8; ++j) { const float v = bf2f((bf16_t)raw[d0][j]); ss += v * v; }
    ss = add_xor32(ss);
    const float rq = rsqrtf(ss * (1.f / 192.f) + EPS) * QSCALE;
    const float* rp = rope + (long)(wid * QBLK + r32) * 64 + hi * 8;
#pragma unroll
    for (int d0 = 0; d0 < 8; ++d0) { const f32x4 g0 = *(const f32x4*)(gq + d0 * 16 + hi * 8), g1 = *(const f32x4*)(gq + d0 * 16 + hi * 8 + 4); float v[8];
#pragma unroll
      for (int j = 0; j < 8; ++j) v[j] = bf2f((bf16_t)raw[d0][j]) * rq * (j < 4 ? g0[j] : g1[j - 4]);
      u32x4 w = {cvtpk(v[0], v[1]), cvtpk(v[2], v[3]), cvtpk(v[4], v[5]), cvtpk(v[6], v[7])}; qr[d0] = *reinterpret_cast<bf16x8*>(&w);
      if (d0 & 1) asm volatile("" ::: "memory"); }
#pragma unroll
    for (int dd = 0; dd < 2; ++dd) {
      const f32x4 ga0 = *(const f32x4*)(gq + 128 + dd * 16 + hi * 8), ga1 = *(const f32x4*)(gq + 128 + dd * 16 + hi * 8 + 4);
      const f32x4 gb0 = *(const f32x4*)(gq + 160 + dd * 16 + hi * 8), gb1 = *(const f32x4*)(gq + 160 + dd * 16 + hi * 8 + 4);
      const f32x4 c0 = *(const f32x4*)(rp + dd * 16), c1 = *(const f32x4*)(rp + dd * 16 + 4), s0 = *(const f32x4*)(rp + 32 + dd * 16), s1 = *(const f32x4*)(rp + 32 + dd * 16 + 4);
      float o1[8], o2[8];
#pragma unroll
      for (int j = 0; j < 8; ++j) { const float x1 = bf2f((bf16_t)raw[8 + dd][j]) * rq * (j < 4 ? ga0[j] : ga1[j - 4]), x2 = bf2f((bf16_t)raw[10 + dd][j]) * rq * (j < 4 ? gb0[j] : gb1[j - 4]);
        const float c = j < 4 ? c0[j] : c1[j - 4], s = j < 4 ? s0[j] : s1[j - 4]; o1[j] = x1 * c - x2 * s; o2[j] = x2 * c + x1 * s; }
      u32x4 w1 = {cvtpk(o1[0], o1[1]), cvtpk(o1[2], o1[3]), cvtpk(o1[4], o1[5]), cvtpk(o1[6], o1[7])}; qr[8 + dd] = *reinterpret_cast<bf16x8*>(&w1);
      u32x4 w2 = {cvtpk(o2[0], o2[1]), cvtpk(o2[2], o2[3]), cvtpk(o2[4], o2[5]), cvtpk(o2[6], o2[7])}; qr[10 + dd] = *reinterpret_cast<bf16x8*>(&w2);
      asm volatile("" ::: "memory");
    }
  }
  int t1 = tid; asm volatile("" : "+v"(t1));
  const int sr = t1 >> 4, sc = (t1 & 15) * 8, vst0 = v_st(sr, sc), vst1 = v_st(32 + sr, sc);
  int kgo[3], kst[3];
#pragma unroll
  for (int i = 0; i < 3; ++i) { const int c = t1 + 512 * i, rest = c >> 3, key2 = rest / 6, cch = rest - key2 * 6, key = key2 * 2 + ((c >> 2) & 1), cc = cch * 4 + (c & 3); kgo[i] = key * LDK + cc * 8; kst[i] = k_st(key, cc); }
  const int kb = (t1 & 31) * 32 + ((((t1 >> 5) & 1) ^ ((t1 >> 3) & 1)) * 16);
  const int vb0 = (int)(unsigned)(size_t)V_lds + v_rd_base(t1 & 63);
  bf16x8 sv0, sv1, sk0, sk1, sk2;
#define SLOAD(k0) do { sv0 = *reinterpret_cast<const bf16x8*>(&Vh[(long)((k0) + sr) * LDV + sc]); sv1 = *reinterpret_cast<const bf16x8*>(&Vh[(long)((k0) + 32 + sr) * LDV + sc]); \
    sk0 = *reinterpret_cast<const bf16x8*>(&Kh[(long)(k0) * LDK + kgo[0]]); sk1 = *reinterpret_cast<const bf16x8*>(&Kh[(long)(k0) * LDK + kgo[1]]); sk2 = *reinterpret_cast<const bf16x8*>(&Kh[(long)(k0) * LDK + kgo[2]]); } while (0)
#define SWRITE(b) do { *(LAS bf16x8*)(V_lds + (b) * SHM_V + vst0) = sv0; *(LAS bf16x8*)(V_lds + (b) * SHM_V + vst1) = sv1; \
    *(LAS bf16x8*)(K_lds + (b) * SHM_K + kst[0]) = sk0; *(LAS bf16x8*)(K_lds + (b) * SHM_K + kst[1]) = sk1; *(LAS bf16x8*)(K_lds + (b) * SHM_K + kst[2]) = sk2; } while (0)
#define SWAIT() asm volatile("s_waitcnt vmcnt(0)" ::: "memory")
#define RESC(a) do { if (__any((a) < 1.f)) { if (hi == 0) al_l[r32] = (a); asm volatile("s_waitcnt lgkmcnt(0)" ::: "memory"); \
    _Pragma("unroll") for (int d = 0; d < 4; ++d) _Pragma("unroll") for (int r = 0; r < 16; ++r) o[d][r] *= al_l[crow(r, hi)]; } } while (0)
  f32x16 pA0, pA1, pB0, pB1; float mnA, mnB, alA, alB; bf16x8 pa0, pa1, pa2, pa3; constexpr int NT = SEQ / KVBLK;
  SLOAD(0); SWAIT(); SWRITE(0); __syncthreads();
  qkt(pA0, pA1, K_lds, qr, kb); partialSM(pA0, pA1, m_reg, mnA, alA);
  SLOAD(KVBLK); SWAIT(); SWRITE(1); __syncthreads();
  for (int j = 1; j + 1 < NT; j += 2) {
    SBAR(); qkt(pB0, pB1, K_lds + SHM_K, qr, kb);
    finishSM(pA0, pA1, alA, l_reg, pa0, pa1, pa2, pa3); SBAR();
    SLOAD((j + 1) * KVBLK); SBAR();
    pv_d0(o, vb0, pa0, pa1, pa2, pa3); partialSM(pB0, pB1, m_reg, mnB, alB);
    __syncthreads(); SWAIT(); SWRITE(0);
    RESC(alB); __syncthreads();
    SBAR(); qkt(pA0, pA1, K_lds, qr, kb);
    finishSM(pB0, pB1, alB, l_reg, pa0, pa1, pa2, pa3); SBAR();
    SLOAD((j + 2) * KVBLK); SBAR();
    pv_d0(o, vb0 + SHM_V, pa0, pa1, pa2, pa3); partialSM(pA0, pA1, m_reg, mnA, alA);
    __syncthreads(); SWAIT(); SWRITE(1);
    RESC(alA); __syncthreads();
  }
  SBAR(); qkt(pB0, pB1, K_lds + SHM_K, qr, kb);
  finishSM(pA0, pA1, alA, l_reg, pa0, pa1, pa2, pa3); SBAR();
  pv_d0(o, vb0, pa0, pa1, pa2, pa3); partialSM(pB0, pB1, m_reg, mnB, alB);
  __syncthreads(); RESC(alB);
  finishSM(pB0, pB1, alB, l_reg, pa0, pa1, pa2, pa3); SBAR();
  pv_d0(o, vb0 + SHM_V, pa0, pa1, pa2, pa3);
  if (hi == 0) li_l[r32] = l_reg;
  __syncthreads();
  { int t2 = tid; asm volatile("" : "+v"(t2));
  const int wid = t2 >> 6, lane = t2 & 63, r32 = lane & 31, hi = lane >> 5;
  LAS float* li_l = (LAS float*)(lds + OFF_WS) + wid * 64;
  LAS bf16_t* stg = (LAS bf16_t*)(lds + wid * 8192);
#pragma unroll
  for (int r = 0; r < 16; ++r) { const int orow = crow(r, hi); const float rl = __builtin_amdgcn_rcpf(li_l[orow]);
#pragma unroll
    for (int d0 = 0; d0 < 4; ++d0) stg[orow * 128 + d0 * 32 + r32] = (bf16_t)(cvtpk(o[d0][r] * rl, 0.f) & 0xffffu); }
  asm volatile("s_waitcnt lgkmcnt(0)" ::: "memory");
  { const int row = lane >> 1, half = lane & 1; const LAS u32x4* src = (const LAS u32x4*)(stg + row * 128 + half * 64); float s = 0.f;
    bf16_t* orow = Ob + (long)(wid * QBLK + row) * 1024 + half * 64;
#pragma unroll
    for (int i = 0; i < 8; ++i) { const u32x4 v = src[i]; *(u32x4*)(orow + i * 8) = v;
#pragma unroll
      for (int e = 0; e < 4; ++e) { const float a = __builtin_bit_cast(float, v[e] << 16), b = __builtin_bit_cast(float, v[e] & 0xffff0000u); s += a * a + b * b; } }
    s = add_xor1(s);
    if (half == 0) ssq[(long)(wid * QBLK + row) * 8] = s; }
  }
  __syncthreads();
#undef SLOAD
#undef SWRITE
#undef SWAIT
#undef RESC
}
#undef SBAR
}

constexpr int NWAVES = 8, MK_THREADS = NWAVES * 64;
constexpr int MK_LDS = 147456, XCH_OFF = 131072, MISC_OFF = XCH_OFF + 4096, CW_BAR = 4096, CTL_ZERO_BYTES = 65536;

__device__ __forceinline__ void tr_item(const float* W, int K, int N, int koff, const float* g1, const float* g2, int ksplit, bf16_t* WT, LAS float* scr, int item, int lane, int perm_from = 1 << 30) {
    const int nblk = N / 32, kb = item / nblk, nb = item % nblk, k0 = 64 * kb, n0 = 32 * nb;
#pragma unroll 8
    for (int i = 0; i < 32; ++i) {
        const int kk = 2 * i + (lane >> 5), kp = k0 + kk, ks = (kp + koff) & (K - 1);
        const float g = g1 ? (kp < ksplit ? g1[kp] : g2[kp - ksplit]) : 1.f;
        int nc = n0 + (lane & 31); if (nc >= perm_from) { const int c = nc - perm_from; nc = perm_from + ((c >> 2) & 1) * 32 + 16 * (c >> 5) + 4 * ((c >> 3) & 3) + (c & 3); }
        scr[kk * 33 + (lane & 31)] = W[(size_t)ks * N + nc] * g;
    }
    asm volatile("s_waitcnt lgkmcnt(0)" ::: "memory");
    const int c = lane & 7;
#pragma unroll
    for (int j = 0; j < 4; ++j) {
        const int n = (lane >> 3) + 8 * j; const LAS float* s = scr + (8 * c) * 33 + n;
        u32x4 o; o.x = pk2(s[0 * 33], s[1 * 33]); o.y = pk2(s[2 * 33], s[3 * 33]); o.z = pk2(s[4 * 33], s[5 * 33]); o.w = pk2(s[6 * 33], s[7 * 33]);
        *(u32x4*)(WT + (size_t)(n0 + n) * K + k0 + 8 * c) = o;
    }
    asm volatile("s_waitcnt lgkmcnt(0)" ::: "memory");
}

__device__ __forceinline__ void phase_prologue(const Params& p, LAS unsigned char* lds, const int tid) {
    const int lane = tid & 63, wave = tid >> 6;
    const int G = gridDim.x, gw = blockIdx.x * NWAVES + wave, NGW = G * NWAVES;
    const int gt = blockIdx.x * MK_THREADS + tid, NGT = G * MK_THREADS;
    LAS float* tab = (LAS float*)lds;
    LAS float* scr = (LAS float*)(lds + 8192 + wave * 8704);
    for (int j = tid; j < 2048; j += MK_THREADS) tab[j] = cospif((float)j * (1.0f / 1024.0f));
    __syncthreads();
    unsigned char* ws = p.ws;
    {
        constexpr int I_IN = 16 * 26, I_QU = 4 * 36, I_KV = 4 * 48, I_OUT = 16 * 32, I_MI = 16 * 128, I_MO = 64 * 32, I_L = I_IN + I_QU + I_KV + I_OUT + I_MI + I_MO;
        for (int it = gw; it < DEPTH * I_L; it += NGW) {
            const int l = it / I_L; int r = it % I_L; unsigned char* wl = ws + WS_W + (size_t)l * LW;
            if (r < I_IN) { tr_item(p.in[I_WIN] + (size_t)l * DM * INW, DM, INW, 0, p.in[I_ANG] + l * DM, nullptr, DM, (bf16_t*)(wl + OW_IN), scr, r, lane, 768); continue; } r -= I_IN;
            if (r < I_QU) { tr_item(p.in[I_WQUP] + (size_t)l * QL * QUPW, QL, QUPW, 0, p.in[I_QAG] + l * QL, nullptr, QL, (bf16_t*)(wl + OW_QUP), scr, r, lane); continue; } r -= I_QU;
            if (r < I_KV) { tr_item(p.in[I_WKVUP] + (size_t)l * KVL * KVUPW, KVL, KVUPW, 0, p.in[I_KVAG] + l * KVL, nullptr, KVL, (bf16_t*)(wl + OW_KVUP), scr, r, lane); continue; } r -= I_KV;
            if (r < I_OUT) { tr_item(p.in[I_WOUT] + (size_t)l * DM * DM, DM, DM, FW, p.in[I_AOG] + l * AW, p.in[I_FOG] + l * FW, AW, (bf16_t*)(wl + OW_OUT), scr, r, lane); continue; } r -= I_OUT;
            if (r < I_MI) { tr_item(p.in[I_WMI] + (size_t)l * DM * FF, DM, FF, 0, p.in[I_MNG] + l * DM, nullptr, DM, (bf16_t*)(wl + OW_MI), scr, r, lane); continue; } r -= I_MI;
            tr_item(p.in[I_WMO] + (size_t)l * FF * DM, FF, DM, 0, nullptr, nullptr, FF, (bf16_t*)(wl + OW_MO), scr, r, lane);
        }
    }
    {
        constexpr int C_IN = (INWP - INW) * DM / 8, C_QU = (QUPWP - QUPW) * QL / 8, C_L = C_IN + C_QU;
        for (int i = gt; i < DEPTH * C_L; i += NGT) {
            const int l = i / C_L, r = i % C_L; unsigned char* wl = ws + WS_W + (size_t)l * LW;
            u32x4* dst = (r < C_IN) ? (u32x4*)(wl + OW_IN + (size_t)INW * DM * 2) + r : (u32x4*)(wl + OW_QUP + (size_t)QUPW * QL * 2) + (r - C_IN);
            *dst = (u32x4){0u, 0u, 0u, 0u};
        }
    }
    {
        bf16_t* F = (bf16_t*)(ws + WS_F);
        for (int ci = gt; ci < 4096 * 256; ci += NGT) {
            const int r = ci >> 8, s0 = (ci & 255) * 8, pq = r >> 11, sp = r & 2047, sh = pq ? 1536 : 0;
            float v[8];
#pragma unroll
            for (int e = 0; e < 8; ++e) v[e] = tab[(sp * (s0 + e) + sh) & 2047];
            u32x4 o; o.x = pk2(v[0], v[1]); o.y = pk2(v[2], v[3]); o.z = pk2(v[4], v[5]); o.w = pk2(v[6], v[7]);
            *(u32x4*)(F + (size_t)r * 2048 + s0) = o;
        }
    }
    {
        for (int i = gt; i < DEPTH * 256 * 512; i += NGT) {
            const int l = i / (256 * 512), r = i % (256 * 512), n = r >> 9, k = r & 511, g = n >> 6, d = n & 63, pq = k >> 8, g2 = (k >> 6) & 3, c = k & 63;
            float acc = 0.f;
            if (g2 == g) {
                const float* wf = p.in[I_WF] + ((size_t)(l * 4 + g) * 64) * 64 + d;
                const int sh = pq ? 1536 : 0;
                for (int c2 = 0; c2 < 64; ++c2) acc += tab[((((c * c2) & 63) * 32) + sh) & 2047] * wf[(size_t)c2 * 64];
                acc *= pq ? -DFT_NRM : DFT_NRM;
            }
            ((bf16_t*)(ws + WS_W + (size_t)l * LW + OW_Y))[r] = (bf16_t)f2bf(acc);
        }
    }
    {
        bf16_t* XB = (bf16_t*)(ws + WS_XB); float* SSQ = (float*)(ws + WS_SSQX);
        for (int m = gw; m < T; m += NGW) {
            const f32x4* xr = (const f32x4*)(p.x + (size_t)m * DM) + lane; f32x4 v[4]; float s = 0.f;
#pragma unroll
            for (int j = 0; j < 4; ++j) { v[j] = xr[64 * j]; s += (v[j].x * v[j].x + v[j].y * v[j].y) + (v[j].z * v[j].z + v[j].w * v[j].w); }
            s = wave_sum(s);
            u32x2* o8 = (u32x2*)(XB + (size_t)m * DM) + lane;
#pragma unroll
            for (int j = 0; j < 4; ++j) o8[64 * j] = (u32x2){pk2(v[j].x, v[j].y), pk2(v[j].z, v[j].w)};
            if (lane < 4) SSQ[(size_t)m * 4 + lane] = lane == 0 ? s : 0.f;
        }
    }
    {
        float* R = (float*)(ws + WS_ROPE);
        for (int i = gt; i < T * 32; i += NGT) {
            const int row = i >> 5, j = i & 31;
            const float inv = powf(10000.0f, -(float)j * (1.0f / 32.0f));
            const float ang = (float)p.pos[row] * inv;
            R[(size_t)row * 64 + j] = cosf(ang); R[(size_t)row * 64 + 32 + j] = sinf(ang);
        }
    }
}

#define XB_TMO      128
#define XB_XCNT(j)  (256  + 64 * (j))
#define XB_XSUB(j)  (1280 + 64 * (j))
#define XB_XGEN(j)  (2304 + 64 * (j))
#define XB_TOP      3328
#define XB_TOPGEN   3392
#define XCD_BAR_WORDS 3456
#define XB_SPIN_CAP (1u << 18)

__device__ __forceinline__ unsigned xb_ld(unsigned* p)              { return __hip_atomic_load(p, __ATOMIC_RELAXED, __HIP_MEMORY_SCOPE_AGENT); }
__device__ __forceinline__ unsigned xb_add(unsigned* p, unsigned v) { return __hip_atomic_fetch_add(p, v, __ATOMIC_RELAXED, __HIP_MEMORY_SCOPE_AGENT); }
__device__ __forceinline__ unsigned xb_xcc_id() { return (unsigned)__builtin_amdgcn_s_getreg((3 << 11) | 20) & 0xFu; }
#define XB_SPIN(cond, bar) do { unsigned _sp = 0; while (cond) { __builtin_amdgcn_s_sleep(1); \
    if ((++_sp & 255u) == 0u) { if (xb_ld(&(bar)[XB_TMO])) break; if (_sp > XB_SPIN_CAP) { atomicAdd(&(bar)[XB_TMO], 1u); break; } } } } while (0)

struct XcdBarrier {
    unsigned* bar; unsigned x;
    volatile LAS unsigned* st;
};

__device__ __forceinline__ XcdBarrier xcd_barrier_post(unsigned* bar, volatile LAS unsigned* st) {
    XcdBarrier b; b.bar = bar; b.x = xb_xcc_id(); b.st = st;
    if (threadIdx.x == 0) (void)xb_add(&bar[XB_XCNT(b.x)], 1u);
    return b;
}
__device__ __forceinline__ void xcd_barrier_complete(unsigned* bar, unsigned x, unsigned& nloc, unsigned& nx) {
    const unsigned G = gridDim.x * gridDim.y * gridDim.z;
    unsigned sum, cnt, mine, sp = 0u;
    for (;;) {
        sum = 0u; cnt = 0u; mine = 0u;
#pragma unroll
        for (unsigned j = 0; j < 16; ++j) { const unsigned c = xb_ld(&bar[XB_XCNT(j)]); sum += c; cnt += (c > 0u) ? 1u : 0u; mine = (j == x) ? c : mine; }
        if (sum == G) break;
        __builtin_amdgcn_s_sleep(1);
        if ((++sp & 255u) == 0u) { if (xb_ld(&bar[XB_TMO])) break; if (sp > XB_SPIN_CAP) { atomicAdd(&bar[XB_TMO], 1u); break; } }
    }
    nloc = mine > 0u ? mine : 1u; nx = cnt > 0u ? cnt : 1u;
}

__device__ __forceinline__ void xcd_barrier(const XcdBarrier& b) {
    asm volatile("s_waitcnt vmcnt(0)" ::: "memory");
    __syncthreads();
    if (threadIdx.x == 0) {
        unsigned* bar = b.bar;
        __builtin_amdgcn_s_waitcnt(0);
        unsigned nloc = b.st[0], nx = b.st[1];
        if (nloc == 0u) { xcd_barrier_complete(bar, b.x, nloc, nx); b.st[0] = nloc; b.st[1] = nx; }
        const unsigned old = xb_add(&bar[XB_XSUB(b.x)], 1u);
        const unsigned gen = old / nloc;
        if (old + 1u == (gen + 1u) * nloc) {
            __builtin_amdgcn_fence(__ATOMIC_RELEASE, "agent");
            asm volatile("s_waitcnt vmcnt(0)" ::: "memory");
            const unsigned og = xb_add(&bar[XB_TOP], 1u);
            const unsigned tg = og / nx;
            if (og + 1u == (tg + 1u) * nx) xb_add(&bar[XB_TOPGEN], 1u);
            else XB_SPIN(xb_ld(&bar[XB_TOPGEN]) == tg, bar);
            __builtin_amdgcn_fence(__ATOMIC_ACQUIRE, "agent");
            xb_add(&bar[XB_XGEN(b.x)], 1u);
            asm volatile("s_waitcnt vmcnt(0)" ::: "memory");
        } else {
            XB_SPIN(xb_ld(&bar[XB_XGEN(b.x)]) == gen, bar);
            __builtin_amdgcn_fence(__ATOMIC_ACQUIRE, "agent");
            asm volatile("s_waitcnt vmcnt(0)" ::: "memory");
        }
    }
    __syncthreads();
}

constexpr int N_PHASES = 1 + 6 * DEPTH;
#ifndef DUP_PH
#define DUP_PH -1
#define DUP_SUB 7
#endif
#ifndef PHM
#define PHM 0xffff
#endif
__global__ void __launch_bounds__(MK_THREADS, 2) mk(Params p) {
    extern __shared__ __attribute__((aligned(16))) unsigned char lds_raw[];
    LAS unsigned char* lds = (LAS unsigned char*)lds_raw;
    const int G = gridDim.x, bid = blockIdx.x;
#define BP(off) ((bf16_t*)(ws + (off)))
#define FP(off) ((float*)(ws + (off)))
    volatile LAS unsigned* MISC = (volatile LAS unsigned*)(lds + MISC_OFF);
    if (threadIdx.x < 32) MISC[threadIdx.x] = 0u;
    __syncthreads();
    const XcdBarrier bar = xcd_barrier_post((unsigned*)(p.ws + WS_CTL) + CW_BAR, MISC + 8);
    if (p.ph_lo == 0) {
        phase_prologue(p, lds, threadIdx.x);
        if (p.ph_hi > 1) xcd_barrier(bar);
    }
    for (int ph = p.ph_lo < 1 ? 1 : p.ph_lo; ph < p.ph_hi; ++ph) {
        for (int rep = 0; rep < ((ph == DUP_PH) ? 2 : 1); ++rep) {
            const int sub = rep == 0 ? p.sub : DUP_SUB; if (rep) __syncthreads();
        int tid = threadIdx.x; asm volatile("" : "+v"(tid));
        unsigned char* ws; { unsigned long long w_ = (unsigned long long)p.ws; asm volatile("" : "+s"(w_)); ws = (unsigned char*)(__attribute__((address_space(1))) unsigned char*)w_; }
            const int l = (ph - 1) / 6, s = (ph - 1) % 6;
            unsigned char* wl = ws + WS_W + (size_t)l * LW;
            pg8::StaticOrder S;
            if (s == 0 && ((PHM & 1) != 0)) {
                pg8::Gemm g{BP(WS_XB), (const bf16_t*)(wl + OW_IN), T, INWP, DM}; S.init(T, INWP, G, bid);
                pg8::EpiIn E{FP(WS_SSQX), BP(WS_UT), BP(WS_CQ), BP(WS_CKV), BP(WS_KPE), FP(WS_SSQCQ), FP(WS_SSQCKV), FP(WS_SSQPE), p.in[I_KNG] + l * QKD, FP(WS_ROPE)};
                pg8::gemm_phase<pg8::EpiIn, pg8::StaticOrder, true, true>(lds, g, S, E, tid);
            } else if (s == 1 && ((PHM & 2) != 0)) {
                if ((sub & 1) && ((PHM & 64) != 0)) { pg8::Gemm g{BP(WS_F), BP(WS_UT), 4096, 4096, 2048}; S.init(4096, 4096, G, bid); pg8::EpiDft E{BP(WS_PQ)};
                    pg8::gemm_phase<pg8::EpiDft, pg8::StaticOrder, true, true>(lds, g, S, E, tid); }
                if ((sub & 2) && ((PHM & 128) != 0)) { pg8::Gemm g{BP(WS_CQ), (const bf16_t*)(wl + OW_QUP), T, QUPWP, QL}; S.init(T, QUPWP, G, bid); pg8::EpiQ E{FP(WS_SSQCQ), BP(WS_Q)};
                    pg8::gemm_phase<pg8::EpiQ, pg8::StaticOrder, true, true>(lds, g, S, E, tid); }
                if ((sub & 4) && ((PHM & 512) != 0)) { pg8::Gemm g{BP(WS_CKV), (const bf16_t*)(wl + OW_KVUP), T, KVUPW, KVL}; S.init(T, KVUPW, G, bid);
                    pg8::EpiKV E{FP(WS_SSQCKV), FP(WS_SSQPE), p.in[I_KNG] + l * QKD, BP(WS_KPE), BP(WS_K), BP(WS_V), (LAS float*)(lds + XCH_OFF)};
                    pg8::gemm_phase<pg8::EpiKV, pg8::StaticOrder, true, true>(lds, g, S, E, tid); }
            } else if (s == 2 && ((PHM & 4) != 0)) {
                if ((sub & 1) && ((PHM & 1024) != 0)) {
                    const int vcu = (G % 8 == 0) ? (bid % 8) * (G / 8) + bid / 8 : bid;
                    for (int ui = vcu; ui < BATCH * NH * 8; ui += G) { const int bh = ui >> 3, qb = ui & 7, b = bh / NH, h = bh - b * NH; const size_t row0 = (size_t)b * SEQ + qb * 256;
                        att::attn_unit(BP(WS_Q) + row0 * QUPW + h * QKD, BP(WS_K) + (size_t)b * SEQ * QUPW + h * QKD, BP(WS_V) + (size_t)b * SEQ * AW + h * VD, BP(WS_MIX) + row0 * 1024 + h * VD,
                                       FP(WS_SSQA) + row0 * 8 + h, p.in[I_QNG] + l * QKD, FP(WS_ROPE) + row0 * 64, (LAS char*)lds, tid); }
                }
                if ((sub & 2) && ((PHM & 2048) != 0)) { pg8::Gemm g{BP(WS_PQ), (const bf16_t*)(wl + OW_Y), T, 256, 512}; S.init(T, 256, G, bid);
                    pg8::EpiY E{BP(WS_MIX), (LAS float*)(lds + XCH_OFF)};
                    pg8::gemm_phase<pg8::EpiY, pg8::StaticOrder, true, true>(lds, g, S, E, tid); }
            } else if (s == 3 && ((PHM & 8) != 0)) {
                pg8::Gemm g{BP(WS_MIX), (const bf16_t*)(wl + OW_OUT), T, DM, DM}; S.init(T, DM, G, bid);
                pg8::EpiRes<12> E{l == 0 ? p.x : p.out, p.out, BP(WS_XB), FP(WS_SSQX), FP(WS_SSQA), (LAS float*)(lds + XCH_OFF)};
                pg8::gemm_phase<pg8::EpiRes<12>, pg8::StaticOrder, true, true>(lds, g, S, E, tid);
            } else if (s == 4 && ((PHM & 16) != 0)) {
                pg8::Gemm g{BP(WS_XB), (const bf16_t*)(wl + OW_MI), T, FF, DM}; S.init(T, FF, G, bid);
                pg8::EpiMlpIn E{FP(WS_SSQX), BP(WS_H)};
                pg8::gemm_phase<pg8::EpiMlpIn, pg8::StaticOrder, true, true>(lds, g, S, E, tid);
            } else if ((PHM & 32) != 0) {
                pg8::Gemm g{BP(WS_H), (const bf16_t*)(wl + OW_MO), T, DM, FF}; S.init(T, DM, G, bid);
                pg8::EpiRes<0> E{p.out, p.out, BP(WS_XB), FP(WS_SSQX), nullptr, (LAS float*)(lds + XCH_OFF)};
                pg8::gemm_phase<pg8::EpiRes<0>, pg8::StaticOrder, true, true>(lds, g, S, E, tid);
            }
        }
        if (ph + 1 < p.ph_hi) xcd_barrier(bar); else __syncthreads();
    }
}


extern "C" void kernel_launch(void* const* d_in, const int* in_sizes, int n_in, void* d_out, int out_size, void* d_ws, size_t ws_size, hipStream_t stream) {
    static int grid = 0;
    if (grid == 0) {
        if (n_in != 17 || in_sizes[0] != T * DM || out_size != T * DM || ws_size < WS_END) {
            fprintf(stderr, "kernel_launch: shape/workspace mismatch: n_in %d in0 %d out %d ws %zu (need %zu)\n", n_in, n_in > 0 ? in_sizes[0] : -1, out_size, ws_size, (size_t)WS_END);
            grid = -1; return; }
        if (hipFuncSetAttribute((const void*)mk, hipFuncAttributeMaxDynamicSharedMemorySize, MK_LDS) != hipSuccess) { fprintf(stderr, "kernel_launch: hipFuncSetAttribute failed\n"); grid = -1; return; }
        int dev = 0, cus = 0, per_cu = 0;
        if (hipGetDevice(&dev) != hipSuccess || hipDeviceGetAttribute(&cus, hipDeviceAttributeMultiprocessorCount, dev) != hipSuccess) { fprintf(stderr, "kernel_launch: device query failed\n"); grid = -1; return; }
        if (hipOccupancyMaxActiveBlocksPerMultiprocessor(&per_cu, (const void*)mk, MK_THREADS, MK_LDS) != hipSuccess || per_cu < 1) { fprintf(stderr, "kernel_launch: occupancy query says %d blocks per CU\n", per_cu); grid = -1; return; }
        grid = cus;
    }
    if (grid < 0) return;
    Params p{};
    p.x = (const float*)d_in[0]; p.pos = (const int*)d_in[1];
    for (int i = 0; i < 15; ++i) p.in[i] = (const float*)d_in[2 + i];
    p.out = (float*)d_out; p.ws = (unsigned char*)d_ws; p.ph_lo = 0; p.ph_hi = N_PHASES; p.sub = 7; p.pad = 0;
    if (hipMemsetAsync((char*)d_ws + WS_CTL, 0, CTL_ZERO_BYTES, stream) != hipSuccess) { fprintf(stderr, "kernel_launch: hipMemsetAsync failed\n"); return; }
    hipLaunchKernelGGL(mk, dim3(grid), dim3(MK_THREADS), MK_LDS, stream, p);
    const hipError_t le = hipPeekAtLastError();
    if (le != hipSuccess) fprintf(stderr, "kernel_launch: launch failed: %s (grid %d)\n", hipGetErrorName(le), grid);
}
```

```cpp
#include <hip/hip_runtime.h>
#include <cstdio>
#include <cstdint>

typedef unsigned short bf16_t;
typedef short bf16x8 __attribute__((ext_vector_type(8)));
typedef float f32x4 __attribute__((ext_vector_type(4)));
typedef unsigned u32x4 __attribute__((ext_vector_type(4)));
typedef unsigned u32x2 __attribute__((ext_vector_type(2)));
#define LAS __attribute__((address_space(3)))

constexpr int BATCH = 16, SEQ = 2048, DM = 1024, T = BATCH * SEQ, DEPTH = 2;
constexpr int FW = 256, QL = 256, KVL = 256, ROPE_D = 64, NOPE = 128, VD = 128, NH = 6, QKD = 192;
constexpr int INW = 832, INWP = 1024, QUPW = NH * QKD  , QUPWP = 1280, KVUPW = NH * 256  , AW = NH * VD  , FF = 4096;
constexpr float EPS = 1e-6f;
constexpr float QSCALE = 0.07216878364870322f * 1.4426950408889634f;
constexpr float DFT_NRM = 0.0027621358640099515f;

constexpr size_t MiB = 1u << 20;
constexpr size_t WS_CTL = 0;
constexpr size_t WS_W = 1 * MiB, LW = 22 * MiB;
constexpr size_t OW_IN = 0, OW_QUP = 2 * MiB, OW_KVUP = OW_QUP + 640 * 1024, OW_OUT = OW_KVUP + 768 * 1024, OW_MI = OW_OUT + 2 * MiB, OW_MO = OW_MI + 8 * MiB, OW_Y = OW_MO + 8 * MiB;
static_assert(OW_Y + 256 * 1024 <= LW, "layer weight block");
constexpr size_t WS_F = 45 * MiB;
constexpr size_t WS_SSQX = 61 * MiB;
constexpr size_t WS_SSQCQ = 63 * MiB, WS_SSQCKV = WS_SSQCQ + 512 * 1024;
constexpr size_t WS_XB = 64 * MiB;
constexpr size_t WS_MIX = 128 * MiB;
constexpr size_t WS_Q = 192 * MiB;
constexpr size_t WS_K = 264 * MiB;
constexpr size_t WS_V = 336 * MiB;
constexpr size_t WS_PQ = 384 * MiB;
constexpr size_t WS_UT = 416 * MiB;
constexpr size_t WS_H = 192 * MiB;
constexpr size_t WS_CQ = 448 * MiB, WS_CKV = 464 * MiB;
constexpr size_t WS_KPE = 480 * MiB;
constexpr size_t WS_ROPE = 484 * MiB;
constexpr size_t WS_SSQPE = 492 * MiB;
constexpr size_t WS_SSQA = WS_SSQPE + 256 * 1024;
constexpr size_t WS_RSTD = 494 * MiB;
constexpr size_t WS_END = 495 * MiB;
constexpr size_t WS_KRAW = 384 * MiB;
constexpr size_t WS_S = 384 * MiB;

__device__ __forceinline__ unsigned f2bf(float f) { unsigned u = __builtin_bit_cast(unsigned, f); return (u + 0x7fffu + ((u >> 16) & 1u)) >> 16; }
__device__ __forceinline__ unsigned pk2(float lo, float hi) { return f2bf(lo) | (f2bf(hi) << 16); }
__device__ __forceinline__ float bf2f(bf16_t h) { return __builtin_bit_cast(float, (unsigned)h << 16); }
__device__ __forceinline__ float add_xor32(float v) { auto rr = __builtin_amdgcn_permlane32_swap(__float_as_uint(v), __float_as_uint(v), false, false); return __uint_as_float(rr[0]) + __uint_as_float(rr[1]); }
__device__ __forceinline__ float add_xor16(float v) { return v + __uint_as_float(__builtin_amdgcn_ds_swizzle(__float_as_uint(v), 0x401F)); }
__device__ __forceinline__ float add_xor1(float v) { return v + __uint_as_float(__builtin_amdgcn_ds_swizzle(__float_as_uint(v), 0x041F)); }
__device__ __forceinline__ float wave_sum(float v) {
#pragma unroll
    for (int o = 1; o < 64; o <<= 1) v += __shfl_xor(v, o);
    return v;
}

struct Params {
    const float* x; const int* pos; const float* in[15];
    float* out; unsigned char* ws; int ph_lo, ph_hi, sub, pad;
};
enum { I_ANG = 0, I_WIN, I_WF, I_QAG, I_WQUP, I_KVAG, I_WKVUP, I_QNG, I_KNG, I_FOG, I_AOG, I_WOUT, I_MNG, I_WMI, I_WMO };

namespace pg8 {
#define PG8_LAS __attribute__((address_space(3)))
typedef unsigned short bf16_t;
typedef short bf16x8 __attribute__((ext_vector_type(8)));
typedef float f32x4 __attribute__((ext_vector_type(4)));
typedef unsigned u32x4 __attribute__((ext_vector_type(4)));
constexpr int BM = 256, BK = 64, HALF = 128, HTB = HALF * BK * 2  , STAGE_BYTES = 8 * HTB, NXCD = 8, WGM = 8;

__host__ __device__ __forceinline__ int lds_byte(int r, int c) { const int st = (r >> 4) * 2 + (c >> 5), rr = r & 15, cc = c & 31, ob = rr * 64 + cc * 2; return st * 1024 + (ob ^ (((ob >> 9) & 1) << 5)); }
__host__ __device__ __forceinline__ void stage_rc(int b, int& R, int& C) { const int st = b / 1024, sb = b % 1024, swz = sb ^ (((sb >> 9) & 1) << 5); R = (st >> 1) * 16 + swz / 64; C = (st & 1) * 32 + (swz % 64) / 2; }
__host__ __device__ __forceinline__ int perm32(int rho) { const int n = rho >> 4, i = rho & 15; return 8 * (i >> 2) + 4 * n + (i & 3); }

struct Unit { int pm, pn; };
struct Gemm { const bf16_t* A; const bf16_t* Bt; int M, N, K; };

struct StaticOrder {
    int nM, nN, nwg, G, c;
    __host__ __device__ void init(int M, int N, int G_, int c_) { nM = M / BM; nN = N / BM; nwg = nM * nN; G = G_; c = c_; }
    __host__ __device__ bool next(int i, Unit& u) const {
        const long L = (long)i * G + c; if (L >= nwg) return false;
        int wgid = (int)L; { const int q = nwg / NXCD, r = nwg % NXCD, xcd = wgid % NXCD, off = wgid / NXCD; wgid = (xcd < r ? xcd * (q + 1) : r * (q + 1) + (xcd - r) * q) + off; }
        const int nig = WGM * nN, gid = wgid / nig, fm = gid * WGM, gsz = (nM - fm) < WGM ? (nM - fm) : WGM;
        u.pm = fm + ((wgid % nig) % gsz); u.pn = (wgid % nig) / gsz; return true;
    }
    __device__ __forceinline__ void a_ready(const Unit&) const {}
    __device__ __forceinline__ void done(const Unit&) const {}
};

template <class Epi, class Sched, bool ALIGN_EPI = false, bool SP2 = false>
__device__ __forceinline__ void gemm_phase(PG8_LAS unsigned char* lds, const Gemm g, const Sched& S, const Epi& E, const int tid) {
    const int wid = __builtin_amdgcn_readfirstlane(tid >> 6), lane = tid & 63, wr = wid >> 2, wc = wid & 3, fr = lane & 15, fq = lane >> 4;
    int K_ = g.K; asm volatile("" : "+s"(K_));
    const int K = K_, nt = K / BK;
    unsigned voffA[2], voffB[2];
#pragma unroll
    for (int i = 0; i < 2; ++i) { int R, C; stage_rc(tid * 16 + i * 8192, R, C); const int Rb = Epi::PERM ? ((R & ~31) + perm32(R & 31)) : R;
        voffA[i] = (unsigned)(R * K + C) * 2u; voffB[i] = (unsigned)(Rb * K + C) * 2u; }
    const size_t kstep = (size_t)(BK * 2);
    const size_t hstep = (size_t)HALF * K * 2;
    const size_t tstep = 2 * hstep;
    const unsigned ldsw = (unsigned)wid * 1024u;
    const int aoff = lds_byte(wr * 64 + fr, fq * 8), boff = lds_byte(wc * 32 + fr, fq * 8);
#define PG8_SA(b, h) (((b) * 2 + (h)) * HTB)
#define PG8_SB(b, h) ((4 + (b) * 2 + (h)) * HTB)
#define PG8_STAGE(bufoff, gbase, voff) do { _Pragma("unroll") for (int _i = 0; _i < 2; ++_i) \
        __builtin_amdgcn_global_load_lds((const unsigned*)((const char*)(gbase) + (voff)[_i]), (PG8_LAS unsigned*)(lds + (bufoff) + ldsw + _i * 8192), 16, 0, 0); } while (0)
#define PG8_LDA(dst, b, h) do { _Pragma("unroll") for (int m = 0; m < 4; ++m) _Pragma("unroll") for (int k = 0; k < 2; ++k) dst[m][k] = *(const PG8_LAS bf16x8*)(lds + PG8_SA(b, h) + aoff + m * 2048 + k * 1024); } while (0)
#define PG8_LDB(dst, b, h) do { _Pragma("unroll") for (int n = 0; n < 2; ++n) _Pragma("unroll") for (int k = 0; k < 2; ++k) dst[n][k] = *(const PG8_LAS bf16x8*)(lds + PG8_SB(b, h) + boff + n * 2048 + k * 1024); } while (0)
#define PG8_MMA(ai, bj, At, Bt) do { __builtin_amdgcn_s_setprio(1); _Pragma("unroll") for (int m = 0; m < 4; ++m) _Pragma("unroll") for (int n = 0; n < 2; ++n) _Pragma("unroll") for (int k = 0; k < 2; ++k) \
        acc[ai][bj][m][n] = __builtin_amdgcn_mfma_f32_16x16x32_bf16(Bt[n][k], At[m][k], acc[ai][bj][m][n], 0, 0, 0); __builtin_amdgcn_s_setprio(0); } while (0)
#define PG8_WAIT_V(n) asm volatile("s_waitcnt vmcnt(" #n ")" ::: "memory")
#define PG8_WAIT_L(n) asm volatile("s_waitcnt lgkmcnt(" #n ")" ::: "memory")
#define PG8_BAR __builtin_amdgcn_s_barrier()
#define PG8_SCHED __builtin_amdgcn_sched_barrier(0)
    Unit cur, nxt; int ui = 0;
    if (!S.next(0, cur)) return;
    f32x4 acc[2][2][4][2];
#pragma unroll
    for (int a = 0; a < 2; ++a)
#pragma unroll
        for (int b = 0; b < 2; ++b)
#pragma unroll
            for (int m = 0; m < 4; ++m)
#pragma unroll
                for (int n = 0; n < 2; ++n) acc[a][b][m][n] = (f32x4){0.f, 0.f, 0.f, 0.f};
    bf16x8 At[4][2], B0[2][2], B1[2][2];
    const char* cA = (const char*)g.A + (size_t)cur.pm * tstep; const char* cB = (const char*)g.Bt + (size_t)cur.pn * tstep;
    S.a_ready(cur);
    if constexpr (SP2) {
        PG8_STAGE(PG8_SB(0, 0), cB, voffB); PG8_STAGE(PG8_SB(0, 1), cB + hstep, voffB); PG8_STAGE(PG8_SA(0, 0), cA, voffA); PG8_STAGE(PG8_SA(0, 1), cA + hstep, voffA);
        if (wr == 1) PG8_BAR;
        PG8_WAIT_V(2); PG8_BAR;
        PG8_STAGE(PG8_SB(1, 0), cB + kstep, voffB); PG8_STAGE(PG8_SA(1, 0), cA + kstep, voffA); PG8_STAGE(PG8_SB(1, 1), cB + hstep + kstep, voffB);
        PG8_WAIT_V(6); PG8_BAR;
    } else {
        PG8_STAGE(PG8_SB(0, 0), cB, voffB); PG8_STAGE(PG8_SA(0, 0), cA, voffA); PG8_STAGE(PG8_SB(0, 1), cB + hstep, voffB); PG8_STAGE(PG8_SA(0, 1), cA + hstep, voffA);
        if (wr == 1) PG8_BAR;
        PG8_WAIT_V(4); PG8_BAR;
        PG8_STAGE(PG8_SB(1, 0), cB + kstep, voffB); PG8_STAGE(PG8_SA(1, 0), cA + kstep, voffA); PG8_STAGE(PG8_SB(1, 1), cB + hstep + kstep, voffB);
        PG8_WAIT_V(6); PG8_BAR;
    }
    for (;;) {
        const bool has_next = S.next(ui + 1, nxt);
        const char* nA = has_next ? (const char*)g.A + (size_t)nxt.pm * tstep : cA; const char* nB = has_next ? (const char*)g.Bt + (size_t)nxt.pn * tstep : cB;
        for (int t = 0; t < nt; t += 2) {
            const bool last = (t == nt - 2);
            const char* a1 = cA + (size_t)(t + 1) * kstep;
            const char* a2 = last ? nA : cA + (size_t)(t + 2) * kstep; const char* b2 = last ? nB : cB + (size_t)(t + 2) * kstep;
            const char* a3 = a2 + kstep; const char* b3 = b2 + kstep;
            if (last && has_next) S.a_ready(nxt);
            if constexpr (SP2) {
            PG8_LDB(B0, 0, 0); PG8_LDB(B1, 0, 1); PG8_SCHED; PG8_LDA(At, 0, 0); PG8_STAGE(PG8_SA(1, 1), a1 + hstep, voffA);
            PG8_WAIT_V(8); PG8_WAIT_L(0); PG8_BAR; PG8_MMA(0, 0, At, B0); PG8_MMA(0, 1, At, B1); PG8_BAR; PG8_SCHED;
            PG8_LDA(At, 0, 1); PG8_STAGE(PG8_SB(0, 0), b2, voffB); PG8_STAGE(PG8_SB(0, 1), b2 + hstep, voffB); PG8_STAGE(PG8_SA(0, 0), a2, voffA);
            PG8_WAIT_V(8); PG8_WAIT_L(0); PG8_BAR; PG8_MMA(1, 0, At, B0); PG8_MMA(1, 1, At, B1); PG8_BAR; PG8_SCHED;
            PG8_LDB(B0, 1, 0); PG8_LDB(B1, 1, 1); PG8_SCHED; PG8_LDA(At, 1, 0); PG8_STAGE(PG8_SA(0, 1), a2 + hstep, voffA);
            PG8_WAIT_V(8); PG8_WAIT_L(0); PG8_BAR; PG8_MMA(0, 0, At, B0); PG8_MMA(0, 1, At, B1); PG8_BAR; PG8_SCHED;
            PG8_LDA(At, 1, 1); PG8_STAGE(PG8_SB(1, 0), b3, voffB); PG8_STAGE(PG8_SB(1, 1), b3 + hstep, voffB); PG8_STAGE(PG8_SA(1, 0), a3, voffA);
            PG8_WAIT_V(8); PG8_WAIT_L(0); PG8_BAR; PG8_MMA(1, 0, At, B0); PG8_MMA(1, 1, At, B1); PG8_BAR; PG8_SCHED;
            } else {
            PG8_LDB(B0, 0, 0); PG8_SCHED; PG8_LDA(At, 0, 0); PG8_STAGE(PG8_SA(1, 1), a1 + hstep, voffA);
            PG8_WAIT_L(8); PG8_BAR; PG8_WAIT_L(0); PG8_MMA(0, 0, At, B0); PG8_BAR; PG8_SCHED;
            PG8_LDB(B1, 0, 1); PG8_STAGE(PG8_SB(0, 0), b2, voffB);
            PG8_BAR; PG8_WAIT_L(0); PG8_MMA(0, 1, At, B1); PG8_BAR;
            PG8_LDA(At, 0, 1); PG8_STAGE(PG8_SA(0, 0), a2, voffA);
            PG8_BAR; PG8_WAIT_L(0); PG8_MMA(1, 0, At, B0); PG8_BAR; PG8_SCHED;
            PG8_STAGE(PG8_SB(0, 1), b2 + hstep, voffB);
            PG8_WAIT_V(6); PG8_BAR; PG8_MMA(1, 1, At, B1); PG8_BAR;
            PG8_LDB(B0, 1, 0); PG8_SCHED; PG8_LDA(At, 1, 0); PG8_STAGE(PG8_SA(0, 1), a2 + hstep, voffA);
            PG8_WAIT_L(8); PG8_BAR; PG8_WAIT_L(0); PG8_MMA(0, 0, At, B0); PG8_BAR; PG8_SCHED;
            PG8_LDB(B1, 1, 1); PG8_STAGE(PG8_SB(1, 0), b3, voffB);
            PG8_BAR; PG8_WAIT_L(0); PG8_MMA(0, 1, At, B1); PG8_BAR;
            PG8_LDA(At, 1, 1); PG8_STAGE(PG8_SA(1, 0), a3, voffA);
            PG8_BAR; PG8_WAIT_L(0); PG8_MMA(1, 0, At, B0); PG8_BAR; PG8_SCHED;
            PG8_STAGE(PG8_SB(1, 1), b3 + hstep, voffB);
            PG8_WAIT_V(6); PG8_BAR; PG8_MMA(1, 1, At, B1); PG8_BAR;
            }
            if constexpr (Epi::MIDK > 0) { if (t + 2 == Epi::MIDK) E.midk(acc, cur, wr, fr); }
        }
        if constexpr (ALIGN_EPI) { if (wr == 0) PG8_BAR; }
        if constexpr (!Epi::AFTER_DRAIN) { E(acc, cur, wr, wc, fr, fq); S.done(cur); }
        if (!has_next) break;
#pragma unroll
        for (int a = 0; a < 2; ++a)
#pragma unroll
            for (int b = 0; b < 2; ++b)
#pragma unroll
                for (int m = 0; m < 4; ++m)
#pragma unroll
                    for (int n = 0; n < 2; ++n) acc[a][b][m][n] = (f32x4){0.f, 0.f, 0.f, 0.f};
        cur = nxt; cA = nA; cB = nB; ++ui;
        if constexpr (ALIGN_EPI) { if (wr == 1) PG8_BAR; }
    }
    PG8_WAIT_V(0);
    if constexpr (!ALIGN_EPI) { if (wr == 0) PG8_BAR; }
    PG8_BAR;
    if constexpr (Epi::AFTER_DRAIN) { E.fused(acc, cur, wr, wc, fr, fq, lds, wid, lane); S.done(cur); }
#undef PG8_SA
#undef PG8_SB
#undef PG8_STAGE
#undef PG8_LDA
#undef PG8_LDB
#undef PG8_MMA
#undef PG8_WAIT_V
#undef PG8_WAIT_L
#undef PG8_BAR
#undef PG8_SCHED
}
}

namespace pg8 {
__device__ __forceinline__ unsigned cvt_pk_bf16(float lo, float hi) { unsigned r; asm volatile("v_cvt_pk_bf16_f32 %0, %1, %2" : "=v"(r) : "v"(lo), "v"(hi)); return r; }
__device__ __forceinline__ u32x4 pack8(const f32x4 a, const f32x4 b) { u32x4 w; w.x = cvt_pk_bf16(a[0], a[1]); w.y = cvt_pk_bf16(a[2], a[3]); w.z = cvt_pk_bf16(b[0], b[1]); w.w = cvt_pk_bf16(b[2], b[3]); return w; }
__device__ __forceinline__ float sum4(const f32x4 a) { return (a[0] + a[1]) + (a[2] + a[3]); }
__device__ __forceinline__ float ssq4(const f32x4 a) { return (a[0] * a[0] + a[1] * a[1]) + (a[2] * a[2] + a[3] * a[3]); }
__device__ __forceinline__ float rstd16(const float* p, float invn) { const f32x4* q = (const f32x4*)p; const f32x4 a = q[0], b = q[1], c = q[2], d = q[3]; return rsqrtf(((sum4(a) + sum4(b)) + (sum4(c) + sum4(d))) * invn + 1e-6f); }
__device__ __forceinline__ float rstd4(const float* p, float invn) { const f32x4 a = *(const f32x4*)p; return rsqrtf(sum4(a) * invn + 1e-6f); }
__device__ __forceinline__ float fq_sum(float s) { return add_xor32(add_xor16(s)); }

#define PG8_EPI_BAR() do { asm volatile("s_waitcnt lgkmcnt(0)" ::: "memory"); __builtin_amdgcn_s_barrier(); asm volatile("" ::: "memory"); } while (0)
typedef float f32x2 __attribute__((ext_vector_type(2)));
typedef unsigned u32x2 __attribute__((ext_vector_type(2)));
__device__ __forceinline__ void rstd8(float (&rs)[2][4], const float* part, int row0, float invn) {
    f32x4 t[2][4];
#pragma unroll
    for (int ai = 0; ai < 2; ++ai)
#pragma unroll
        for (int m = 0; m < 4; ++m) t[ai][m] = *(const f32x4*)(part + (size_t)(row0 + ai * HALF + m * 16) * 4);
#pragma unroll
    for (int ai = 0; ai < 2; ++ai)
#pragma unroll
        for (int m = 0; m < 4; ++m) rs[ai][m] = rsqrtf(sum4(t[ai][m]) * invn + 1e-6f);
}
struct EpiMlpIn { static constexpr bool PERM = true, AFTER_DRAIN = false; static constexpr int MIDK = 0;
    const float* ssqx; bf16_t* H;
    __device__ __forceinline__ void operator()(const f32x4 (&acc)[2][2][4][2], const Unit& u, int wr, int wc, int fr, int fq) const {
        const int row0 = u.pm * BM + wr * 64 + fr, col0 = u.pn * BM + wc * 32 + 8 * fq;
        float rs[2][4]; rstd8(rs, ssqx, row0, 1.f / 1024.f);
#pragma unroll
        for (int ai = 0; ai < 2; ++ai)
#pragma unroll
            for (int m = 0; m < 4; ++m) { bf16_t* rowp = H + (size_t)(row0 + ai * HALF + m * 16) * 4096 + col0;
#pragma unroll
                for (int bj = 0; bj < 2; ++bj) { f32x4 v0 = acc[ai][bj][m][0] * rs[ai][m], v1 = acc[ai][bj][m][1] * rs[ai][m];
#pragma unroll
                    for (int i = 0; i < 4; ++i) { const float a = fmaxf(v0[i], 0.f), b = fmaxf(v1[i], 0.f); v0[i] = a * a; v1[i] = b * b; }
                    *(u32x4*)(rowp + bj * HALF) = pack8(v0, v1); } }
    }
};
template <int MIDK_> struct EpiRes { static constexpr bool PERM = true, AFTER_DRAIN = false; static constexpr int MIDK = MIDK_;
    const float* xf; float* outf; bf16_t* XB; float* ssqx; const float* ssqa; PG8_LAS float* xch;
    __device__ __forceinline__ void midk(f32x4 (&acc)[2][2][4][2], const Unit& u, int wr, int fr) const {
#pragma unroll
        for (int ai = 0; ai < 2; ++ai)
#pragma unroll
            for (int mp = 0; mp < 2; ++mp) { f32x4 a[2], b[2];
#pragma unroll
                for (int k = 0; k < 2; ++k) { const float* q = ssqa + (size_t)(u.pm * BM + ai * HALF + wr * 64 + (2 * mp + k) * 16 + fr) * 8; a[k] = *(const f32x4*)q; b[k] = *(const f32x4*)(q + 4); }
#pragma unroll
                for (int k = 0; k < 2; ++k) { const float rs = rsqrtf((sum4(a[k]) + (b[k][0] + b[k][1])) * (1.f / 768.f) + 1e-6f);
#pragma unroll
                    for (int bj = 0; bj < 2; ++bj)
#pragma unroll
                        for (int n = 0; n < 2; ++n) acc[ai][bj][2 * mp + k][n] *= rs; }
                asm volatile("" ::: "memory"); }
    }
    __device__ __forceinline__ void operator()(const f32x4 (&acc)[2][2][4][2], const Unit& u, int wr, int wc, int fr, int fq) const {
        const int row0 = u.pm * BM + wr * 64 + fr, col0 = u.pn * BM + wc * 32 + 8 * fq;
        PG8_LAS float* xw = xch + (wr * 64 + fr) * 4 + wc; asm volatile("" : "+v"(xw));
#pragma unroll
        for (int ai = 0; ai < 2; ++ai) { f32x4 pre[4][2][2];
            if (xf) {
#pragma unroll
                for (int m = 0; m < 4; ++m)
#pragma unroll
                    for (int bj = 0; bj < 2; ++bj) { const float* q = xf + (size_t)(row0 + ai * HALF + m * 16) * 1024 + col0 + bj * HALF; pre[m][bj][0] = *(const f32x4*)q; pre[m][bj][1] = *(const f32x4*)(q + 4); }
            } else { u32x4 pb[4][2];
#pragma unroll
                for (int m = 0; m < 4; ++m)
#pragma unroll
                    for (int bj = 0; bj < 2; ++bj) pb[m][bj] = *(const u32x4*)(XB + (size_t)(row0 + ai * HALF + m * 16) * 1024 + col0 + bj * HALF);
#pragma unroll
                for (int m = 0; m < 4; ++m)
#pragma unroll
                    for (int bj = 0; bj < 2; ++bj) { const u32x4 w = pb[m][bj];
                        pre[m][bj][0] = (f32x4){__builtin_bit_cast(float, w.x << 16), __builtin_bit_cast(float, w.x & 0xffff0000u), __builtin_bit_cast(float, w.y << 16), __builtin_bit_cast(float, w.y & 0xffff0000u)};
                        pre[m][bj][1] = (f32x4){__builtin_bit_cast(float, w.z << 16), __builtin_bit_cast(float, w.z & 0xffff0000u), __builtin_bit_cast(float, w.w << 16), __builtin_bit_cast(float, w.w & 0xffff0000u)}; }
            }
#pragma unroll
            for (int m = 0; m < 4; ++m) { float s = 0.f;
#pragma unroll
                for (int bj = 0; bj < 2; ++bj) { const size_t off = (size_t)(row0 + ai * HALF + m * 16) * 1024 + col0 + bj * HALF;
                    const f32x4 o0 = pre[m][bj][0] + acc[ai][bj][m][0], o1 = pre[m][bj][1] + acc[ai][bj][m][1];
                    if (outf) { *(f32x4*)(outf + off) = o0; *(f32x4*)(outf + off + 4) = o1; }
                    else { *(u32x4*)(XB + off) = pack8(o0, o1); s += ssq4(o0) + ssq4(o1); } }
                if (!outf) { s = fq_sum(s); if (fq == 0) xw[(ai * HALF + m * 16) * 4] = s; } }
            asm volatile("" ::: "memory"); }
        if (!outf) {
            PG8_EPI_BAR();
            const int t = (wr * 4 + wc) * 64 + fq * 16 + fr;
            if (t < 256) { const f32x4 pz = *(const PG8_LAS f32x4*)(xch + t * 4); ssqx[(size_t)(u.pm * BM + t) * 4 + u.pn] = sum4(pz); }
        }
    }
};
struct EpiIn { static constexpr bool PERM = true, AFTER_DRAIN = false; static constexpr int MIDK = 0;
    const float* ssqx; bf16_t *UT, *CQ, *CKV, *KPER; float *ssqcq, *ssqckv, *ssqpe; const float *gk, *rope;
    __device__ __forceinline__ void operator()(const f32x4 (&acc)[2][2][4][2], const Unit& u, int wr, int wc, int fr, int fq) const {
        const int row0 = u.pm * BM + wr * 64 + fr, c0 = wc * 32 + 8 * fq, pn = u.pn;
        float rs8[2][4]; rstd8(rs8, ssqx, row0, 1.f / 1024.f);
#pragma unroll
        for (int ai = 0; ai < 2; ++ai)
#pragma unroll
            for (int m = 0; m < 4; ++m) { const int row = row0 + ai * HALF + m * 16; const float rs = rs8[ai][m];
                if (pn == 0) { const int b = row >> 11, s = row & 2047; bf16_t* base = UT + ((size_t)(b * 256 + c0)) * 2048 + s;
#pragma unroll
                    for (int bj = 0; bj < 2; ++bj)
#pragma unroll
                        for (int n = 0; n < 2; ++n)
#pragma unroll
                            for (int i = 0; i < 4; ++i) base[(size_t)(bj * HALF + 4 * n + i) * 2048] = (bf16_t)(cvt_pk_bf16(acc[ai][bj][m][n][i] * rs, 0.f) & 0xffffu);
                } else if (pn < 3) { bf16_t* dst = (pn == 1 ? CQ : CKV) + (size_t)row * 256 + c0; float s = 0.f;
#pragma unroll
                    for (int bj = 0; bj < 2; ++bj) { const f32x4 v0 = acc[ai][bj][m][0] * rs, v1 = acc[ai][bj][m][1] * rs; *(u32x4*)(dst + bj * HALF) = pack8(v0, v1); s += ssq4(v0) + ssq4(v1); }
                    s = fq_sum(s); if (fq == 0) (pn == 1 ? ssqcq : ssqckv)[(size_t)row * 4 + wc] = s;
                } else if (wc < 2) { const int j = 16 * wc + 4 * fq; const f32x4 v0 = acc[ai][0][m][0] * rs, v1 = acc[ai][0][m][1] * rs;
                    const f32x4 x1 = v0 * *(const f32x4*)(gk + 128 + j), x2 = v1 * *(const f32x4*)(gk + 160 + j);
                    const f32x4 cs = *(const f32x4*)(rope + (size_t)row * 64 + j), sn = *(const f32x4*)(rope + (size_t)row * 64 + 32 + j);
                    const f32x4 o1 = x1 * cs - x2 * sn, o2 = x2 * cs + x1 * sn;
                    *(u32x2*)(KPER + (size_t)row * 64 + j) = (u32x2){cvt_pk_bf16(o1[0], o1[1]), cvt_pk_bf16(o1[2], o1[3])};
                    *(u32x2*)(KPER + (size_t)row * 64 + 32 + j) = (u32x2){cvt_pk_bf16(o2[0], o2[1]), cvt_pk_bf16(o2[2], o2[3])};
                    float s = fq_sum(ssq4(v0) + ssq4(v1)); if (fq == 0) ssqpe[(size_t)row * 2 + wc] = s; } }
    }
};
struct EpiDft { static constexpr bool PERM = true, AFTER_DRAIN = false; static constexpr int MIDK = 0;
    bf16_t* PQ;
    __device__ __forceinline__ void operator()(const f32x4 (&acc)[2][2][4][2], const Unit& u, int wr, int wc, int fr, int fq) const {
        const int pq = u.pm >> 3, sp0 = (u.pm & 7) * 256 + wr * 64 + fr, b = u.pn;
#pragma unroll
        for (int ai = 0; ai < 2; ++ai)
#pragma unroll
            for (int m = 0; m < 4; ++m) { bf16_t* rowp = PQ + ((size_t)(b * 2048 + sp0 + ai * HALF + m * 16)) * 512 + pq * 256 + wc * 32 + 8 * fq;
#pragma unroll
                for (int bj = 0; bj < 2; ++bj) *(u32x4*)(rowp + bj * HALF) = pack8(acc[ai][bj][m][0], acc[ai][bj][m][1]); }
    }
};
struct EpiQ { static constexpr bool PERM = true, AFTER_DRAIN = false; static constexpr int MIDK = 0;
    const float* ssqcq; bf16_t* Q;
    __device__ __forceinline__ void operator()(const f32x4 (&acc)[2][2][4][2], const Unit& u, int wr, int wc, int fr, int fq) const {
        const int row0 = u.pm * BM + wr * 64 + fr, col0 = u.pn * BM + wc * 32 + 8 * fq;
        float rs[2][4]; rstd8(rs, ssqcq, row0, 1.f / 256.f);
#pragma unroll
        for (int ai = 0; ai < 2; ++ai)
#pragma unroll
            for (int m = 0; m < 4; ++m) { bf16_t* rowp = Q + (size_t)(row0 + ai * HALF + m * 16) * 1152 + col0;
#pragma unroll
                for (int bj = 0; bj < 2; ++bj) if (col0 + bj * HALF < 1152) *(u32x4*)(rowp + bj * HALF) = pack8(acc[ai][bj][m][0] * rs[ai][m], acc[ai][bj][m][1] * rs[ai][m]); }
    }
};
struct EpiKV { static constexpr bool PERM = true, AFTER_DRAIN = false; static constexpr int MIDK = 0;
    const float *ssqckv, *ssqpe, *gk; const bf16_t* KPER; bf16_t *K, *V; PG8_LAS float* xch;
    __device__ __forceinline__ void operator()(const f32x4 (&acc)[2][2][4][2], const Unit& u, int wr, int wc, int fr, int fq) const {
        const int h = u.pn, row0 = u.pm * BM + wr * 64 + fr, c0 = wc * 32 + 8 * fq, j4 = 4 * (4 * wc + fq);
        float rck[2][4]; rstd8(rck, ssqckv, row0, 1.f / 256.f);
        PG8_LAS float* xw = xch + (wr * 64 + fr) * 4 + wc; asm volatile("" : "+v"(xw));
        f32x2 pe2[2][4]; u32x2 kp[2][4];
#pragma unroll
        for (int ai = 0; ai < 2; ++ai)
#pragma unroll
            for (int m = 0; m < 4; ++m) { const int row = row0 + ai * HALF + m * 16; pe2[ai][m] = *(const f32x2*)(ssqpe + (size_t)row * 2); kp[ai][m] = *(const u32x2*)(KPER + (size_t)row * 64 + j4);
                const f32x4 v0 = acc[ai][0][m][0] * rck[ai][m], v1 = acc[ai][0][m][1] * rck[ai][m]; const float s = fq_sum(ssq4(v0) + ssq4(v1));
                if (fq == 0) xw[(ai * HALF + m * 16) * 4] = s; }
        const f32x4 g0 = *(const f32x4*)(gk + c0), g1 = *(const f32x4*)(gk + c0 + 4);
        PG8_EPI_BAR();
        const PG8_LAS float* xr = xw - wc;
#pragma unroll
        for (int ai = 0; ai < 2; ++ai)
#pragma unroll
            for (int m = 0; m < 4; ++m) { const int row = row0 + ai * HALF + m * 16;
                const f32x4 part = *(const PG8_LAS f32x4*)(xr + (ai * HALF + m * 16) * 4);
                const float rc = rck[ai][m], rk = rsqrtf((sum4(part) + (pe2[ai][m][0] + pe2[ai][m][1])) * (1.f / 192.f) + 1e-6f), rr = rc * rk;
                *(u32x4*)(K + (size_t)row * 1152 + h * 192 + c0) = pack8(acc[ai][0][m][0] * rr * g0, acc[ai][0][m][1] * rr * g1);
                *(u32x4*)(V + (size_t)row * 768 + h * 128 + c0) = pack8(acc[ai][1][m][0] * rc, acc[ai][1][m][1] * rc);
                const unsigned a = kp[ai][m][0], b = kp[ai][m][1];
                *(u32x2*)(K + (size_t)row * 1152 + h * 192 + 128 + j4) = (u32x2){cvt_pk_bf16(__builtin_bit_cast(float, a << 16) * rk, __builtin_bit_cast(float, a & 0xffff0000u) * rk),
                                                                               cvt_pk_bf16(__builtin_bit_cast(float, b << 16) * rk, __builtin_bit_cast(float, b & 0xffff0000u) * rk)}; }
    }
};
struct EpiY { static constexpr bool PERM = true, AFTER_DRAIN = false; static constexpr int MIDK = 0;
    bf16_t* MIX; PG8_LAS float* xch;
    __device__ __forceinline__ void operator()(const f32x4 (&acc)[2][2][4][2], const Unit& u, int wr, int wc, int fr, int fq) const {
        const int row0 = u.pm * BM + wr * 64 + fr, c0 = wc * 32 + 8 * fq;
        PG8_LAS float* xw = xch + (wr * 64 + fr) * 4 + wc; asm volatile("" : "+v"(xw));
#pragma unroll
        for (int ai = 0; ai < 2; ++ai)
#pragma unroll
            for (int m = 0; m < 4; ++m) { float s = 0.f;
#pragma unroll
                for (int bj = 0; bj < 2; ++bj) s += ssq4(acc[ai][bj][m][0]) + ssq4(acc[ai][bj][m][1]);
                s = fq_sum(s); if (fq == 0) xw[(ai * HALF + m * 16) * 4] = s; }
        PG8_EPI_BAR();
        const PG8_LAS float* xr = xw - wc;
#pragma unroll
        for (int ai = 0; ai < 2; ++ai)
#pragma unroll
            for (int m = 0; m < 4; ++m) { const int row = row0 + ai * HALF + m * 16;
                const f32x4 part = *(const PG8_LAS f32x4*)(xr + (ai * HALF + m * 16) * 4); const float rf = rsqrtf(sum4(part) * (1.f / 256.f) + 1e-6f);
                bf16_t* rowp = MIX + (size_t)row * 1024 + 768 + c0;
#pragma unroll
                for (int bj = 0; bj < 2; ++bj) *(u32x4*)(rowp + bj * HALF) = pack8(acc[ai][bj][m][0] * rf, acc[ai][bj][m][1] * rf); }
    }
};
}

namespace att {
using f32x16 = __attribute__((ext_vector_type(16))) float;
using s16x4 = __attribute__((ext_vector_type(4))) short;
constexpr int NW = 8, QBLK = 32, KVBLK = 64, LDQ = 1152, LDK = 1152, LDV = 768;
constexpr int SHM_V = KVBLK * 128 * 2, SHM_K = KVBLK * 192 * 2;
constexpr int OFF_V = 0, OFF_K = 2 * SHM_V, OFF_WS = OFF_K + 2 * SHM_K, ATT_LDS = OFF_WS + NW * 64 * 4;
constexpr float THR = 8.f;
__device__ __forceinline__ int k_st(int key, int cc) { const int d0 = cc >> 1, hh = cc & 1; return d0 * 2048 + ((key * 32 + ((hh ^ ((key >> 3) & 1)) * 16)) ^ ((d0 & 1) * 64)); }
#define SBAR() __builtin_amdgcn_sched_barrier(0)
__device__ __forceinline__ int crow(int r, int hi) { return (r & 3) + 8 * (r >> 2) + 4 * hi; }
__device__ __forceinline__ unsigned cvtpk(float lo, float hi) { unsigned r; asm volatile("v_cvt_pk_bf16_f32 %0, %1, %2" : "=v"(r) : "v"(lo), "v"(hi)); return r; }

__device__ __forceinline__ void partialSM(f32x16& p0, f32x16& p1, float& m_reg, float& mn, float& alpha) {
  float pmax = p0[0];
#pragma unroll
  for (int r = 1; r < 16; ++r) pmax = fmaxf(pmax, p0[r]);
#pragma unroll
  for (int r = 0; r < 16; ++r) pmax = fmaxf(pmax, p1[r]);
  { auto rr = __builtin_amdgcn_permlane32_swap(__float_as_uint(pmax), __float_as_uint(pmax), false, false);
    pmax = fmaxf(__uint_as_float(rr[0]), __uint_as_float(rr[1])); }
  if (__builtin_expect(__all(pmax - m_reg <= THR), 1)) { mn = m_reg; alpha = 1.f; }
  else { mn = fmaxf(m_reg, pmax); alpha = __builtin_amdgcn_exp2f(m_reg - mn); m_reg = mn; }
#pragma unroll
  for (int r = 0; r < 16; ++r) p0[r] = p0[r] - mn;
#pragma unroll
  for (int r = 0; r < 16; ++r) p1[r] = p1[r] - mn;
#pragma unroll
  for (int r = 0; r < 16; ++r) p0[r] = __builtin_amdgcn_exp2f(p0[r]);
}
__device__ __forceinline__ void finishSM(f32x16& p0, f32x16& p1, float alpha, float& l_reg, bf16x8& pa0, bf16x8& pa1, bf16x8& pa2, bf16x8& pa3) {
#pragma unroll
  for (int r = 0; r < 16; ++r) p1[r] = __builtin_amdgcn_exp2f(p1[r]);
  float ps = 0;
#pragma unroll
  for (int r = 0; r < 16; ++r) ps += p0[r];
#pragma unroll
  for (int r = 0; r < 16; ++r) ps += p1[r];
  { auto rr = __builtin_amdgcn_permlane32_swap(__float_as_uint(ps), __float_as_uint(ps), false, false);
    ps = __uint_as_float(rr[0]) + __uint_as_float(rr[1]); }
  l_reg = l_reg * alpha + ps;
#define PK4(P, BASE, OUT) do { unsigned a0 = cvtpk(P[BASE + 0], P[BASE + 1]), a1 = cvtpk(P[BASE + 2], P[BASE + 3]);   \
    unsigned b0 = cvtpk(P[BASE + 4], P[BASE + 5]), b1 = cvtpk(P[BASE + 6], P[BASE + 7]);                              \
    auto r0 = __builtin_amdgcn_permlane32_swap(a0, b0, false, false); auto r1 = __builtin_amdgcn_permlane32_swap(a1, b1, false, false); \
    u32x4 w = {r0[0], r1[0], r0[1], r1[1]}; OUT = *reinterpret_cast<bf16x8*>(&w); } while (0)
  PK4(p0, 0, pa0); PK4(p0, 8, pa1); PK4(p1, 0, pa2); PK4(p1, 8, pa3);
#undef PK4
}
__device__ __forceinline__ void qkt(f32x16& p0, f32x16& p1, const LAS char* Ks, const bf16x8* qr, int kb) {
  p0 = f32x16{}; p1 = f32x16{};
  const LAS char* ke = Ks + kb; const LAS char* ko = Ks + (kb ^ 64);
#pragma unroll
  for (int d0 = 0; d0 < 12; ++d0) { const LAS char* a = (d0 & 1) ? ko : ke;
    const bf16x8 b0 = *(const LAS bf16x8*)(a + d0 * 2048);
    const bf16x8 b1 = *(const LAS bf16x8*)(a + d0 * 2048 + 1024);
    p0 = __builtin_amdgcn_mfma_f32_32x32x16_bf16(b0, qr[d0], p0, 0, 0, 0);
    p1 = __builtin_amdgcn_mfma_f32_32x32x16_bf16(b1, qr[d0], p1, 0, 0, 0); }
}
__device__ __forceinline__ int v_st(int k, int c) { const int kk = (k & ~0xC) | ((k & 4) << 1) | ((k & 8) >> 1); return ((kk >> 3) * 4 + (c >> 5)) * 512 + ((kk & 7) * 32 + (c & 31)) * 2; }
__device__ __forceinline__ int v_rd_base(int lane) { return ((lane & 3) << 3) | (((lane >> 2) & 3) << 6) | (((lane >> 4) & 1) << 5) | (((lane >> 5) & 1) << 8); }
constexpr int v_rd_off(int d0, int ks, int half) { return d0 * 512 + ks * 4096 + half * 2048; }
template <int OFF> __device__ __forceinline__ s16x4 tr_read(int vb) {
  s16x4 r; asm volatile("ds_read_b64_tr_b16 %0, %1 offset:%2" : "=&v"(r) : "v"(vb), "i"(OFF) : "memory"); return r;
}
template <int D0> __device__ __forceinline__ void pv_one(f32x16& od, int vb, bf16x8 pa0, bf16x8 pa1, bf16x8 pa2, bf16x8 pa3) {
  const s16x4 l0 = tr_read<v_rd_off(D0, 0, 0)>(vb), h0 = tr_read<v_rd_off(D0, 0, 1)>(vb), l1 = tr_read<v_rd_off(D0, 1, 0)>(vb), h1 = tr_read<v_rd_off(D0, 1, 1)>(vb);
  const s16x4 l2 = tr_read<v_rd_off(D0, 2, 0)>(vb), h2 = tr_read<v_rd_off(D0, 2, 1)>(vb), l3 = tr_read<v_rd_off(D0, 3, 0)>(vb), h3 = tr_read<v_rd_off(D0, 3, 1)>(vb);
  asm volatile("s_waitcnt lgkmcnt(0)" ::: "memory"); SBAR();
#define PK(L, H) (bf16x8){L[0], L[1], L[2], L[3], H[0], H[1], H[2], H[3]}
  od = __builtin_amdgcn_mfma_f32_32x32x16_bf16(pa0, PK(l0, h0), od, 0, 0, 0);
  od = __builtin_amdgcn_mfma_f32_32x32x16_bf16(pa1, PK(l1, h1), od, 0, 0, 0);
  od = __builtin_amdgcn_mfma_f32_32x32x16_bf16(pa2, PK(l2, h2), od, 0, 0, 0);
  od = __builtin_amdgcn_mfma_f32_32x32x16_bf16(pa3, PK(l3, h3), od, 0, 0, 0);
#undef PK
}
__device__ __forceinline__ void pv_d0(f32x16* o, int vb, bf16x8 pa0, bf16x8 pa1, bf16x8 pa2, bf16x8 pa3) {
  pv_one<0>(o[0], vb, pa0, pa1, pa2, pa3); pv_one<1>(o[1], vb, pa0, pa1, pa2, pa3); pv_one<2>(o[2], vb, pa0, pa1, pa2, pa3); pv_one<3>(o[3], vb, pa0, pa1, pa2, pa3);
}

__device__ __forceinline__ void attn_unit(const bf16_t* __restrict__ Qb, const bf16_t* __restrict__ Kh, const bf16_t* __restrict__ Vh, bf16_t* __restrict__ Ob, float* __restrict__ ssq,
                                          const float* __restrict__ gq, const float* __restrict__ rope, LAS char* lds, const int tid) {
  const int wid = tid >> 6, lane = tid & 63, r32 = lane & 31, hi = lane >> 5;
  LAS char* V_lds = lds + OFF_V; LAS char* K_lds = lds + OFF_K;
  LAS float* wsf = (LAS float*)(lds + OFF_WS) + wid * 64; LAS float* li_l = wsf; LAS float* al_l = wsf + 32;
  float m_reg = -1e30f, l_reg = 0; f32x16 o[4] = {}; bf16x8 qr[12];
  {
    const bf16_t* Qw = Qb + (long)(wid * QBLK + r32) * LDQ + hi * 8;
    bf16x8 raw[12]; float ss = 0.f;
#pragma unroll
    for (int d0 = 0; d0 < 12; ++d0) raw[d0] = *reinterpret_cast<const bf16x8*>(Qw + d0 * 16);
#pragma unroll
    for (int d0 = 0; d0 < 12; ++d0)
#pragma unroll
      for (int j = 0; j < 8; ++j) { const float v = bf2f((bf16_t)raw[d0][j]); ss += v * v; }
    ss = add_xor32(ss);
    const float rq = rsqrtf(ss * (1.f / 192.f) + EPS) * QSCALE;
    const float* rp = rope + (long)(wid * QBLK + r32) * 64 + hi * 8;
#pragma unroll
    for (int d0 = 0; d0 < 8; ++d0) { const f32x4 g0 = *(const f32x4*)(gq + d0 * 16 + hi * 8), g1 = *(const f32x4*)(gq + d0 * 16 + hi * 8 + 4); float v[8];
#pragma unroll
      for (int j = 0; j < 8; ++j) v[j] = bf2f((bf16_t)raw[d0][j]) * rq * (j < 4 ? g0[j] : g1[j - 4]);
      u32x4 w = {cvtpk(v[0], v[1]), cvtpk(v[2], v[3]), cvtpk(v[4], v[5]), cvtpk(v[6], v[7])}; qr[d0] = *reinterpret_cast<bf16x8*>(&w);
      if (d0 & 1) asm volatile("" ::: "memory"); }
#pragma unroll
    for (int dd = 0; dd < 2; ++dd) {
      const f32x4 ga0 = *(const f32x4*)(gq + 128 + dd * 16 + hi * 8), ga1 = *(const f32x4*)(gq + 128 + dd * 16 + hi * 8 + 4);
      const f32x4 gb0 = *(const f32x4*)(gq + 160 + dd * 16 + hi * 8), gb1 = *(const f32x4*)(gq + 160 + dd * 16 + hi * 8 + 4);
      const f32x4 c0 = *(const f32x4*)(rp + dd * 16), c1 = *(const f32x4*)(rp + dd * 16 + 4), s0 = *(const f32x4*)(rp + 32 + dd * 16), s1 = *(const f32x4*)(rp + 32 + dd * 16 + 4);
      float o1[8], o2[8];
#pragma unroll
      for (int j = 0; j < 8; ++j) { const float x1 = bf2f((bf16_t)raw[8 + dd][j]) * rq * (j < 4 ? ga0[j] : ga1[j - 4]), x2 = bf2f((bf16_t)raw[10 + dd][j]) * rq * (j < 4 ? gb0[j] : gb1[j - 4]);
        const float c = j < 4 ? c0[j] : c1[j - 4], s = j < 4 ? s0[j] : s1[j - 4]; o1[j] = x1 * c - x2 * s; o2[j] = x2 * c + x1 * s; }
      u32x4 w1 = {cvtpk(o1[0], o1[1]), cvtpk(o1[2], o1[3]), cvtpk(o1[4], o1[5]), cvtpk(o1[6], o1[7])}; qr[8 + dd] = *reinterpret_cast<bf16x8*>(&w1);
      u32x4 w2 = {cvtpk(o2[0], o2[1]), cvtpk(o2[2], o2[3]), cvtpk(o2[4], o2[5]), cvtpk(o2[6], o2[7])}; qr[10 + dd] = *reinterpret_cast<bf16x8*>(&w2);
      asm volatile("" ::: "memory");
    }
  }
  int t1 = tid; asm volatile("" : "+v"(t1));
  const int sr = t1 >> 4, sc = (t1 & 15) * 8, vst0 = v_st(sr, sc), vst1 = v_st(32 + sr, sc);
  int kgo[3], kst[3];
#pragma unroll
  for (int i = 0; i < 3; ++i) { const int c = t1 + 512 * i, rest = c >> 3, key2 = rest / 6, cch = rest - key2 * 6, key = key2 * 2 + ((c >> 2) & 1), cc = cch * 4 + (c & 3); kgo[i] = key * LDK + cc * 8; kst[i] = k_st(key, cc); }
  const int kb = (t1 & 31) * 32 + ((((t1 >> 5) & 1) ^ ((t1 >> 3) & 1)) * 16);
  const int vb0 = (int)(unsigned)(size_t)V_lds + v_rd_base(t1 & 63);
  bf16x8 sv0, sv1, sk0, sk1, sk2;
#define SLOAD(k0) do { sv0 = *reinterpret_cast<const bf16x8*>(&Vh[(long)((k0) + sr) * LDV + sc]); sv1 = *reinterpret_cast<const bf16x8*>(&Vh[(long)((k0) + 32 + sr) * LDV + sc]); \
    sk0 = *reinterpret_cast<const bf16x8*>(&Kh[(long)(k0) * LDK + kgo[0]]); sk1 = *reinterpret_cast<const bf16x8*>(&Kh[(long)(k0) * LDK + kgo[1]]); sk2 = *reinterpret_cast<const bf16x8*>(&Kh[(long)(k0) * LDK + kgo[2]]); } while (0)
#define SWRITE(b) do { *(LAS bf16x8*)(V_lds + (b) * SHM_V + vst0) = sv0; *(LAS bf16x8*)(V_lds + (b) * SHM_V + vst1) = sv1; \
    *(LAS bf16x8*)(K_lds + (b) * SHM_K + kst[0]) = sk0; *(LAS bf16x8*)(K_lds + (b) * SHM_K + kst[1]) = sk1; *(LAS bf16x8*)(K_lds + (b) * SHM_K + kst[2]) = sk2; } while (0)
#define SWAIT() asm volatile("s_waitcnt vmcnt(0)" ::: "memory")
#define RESC(a) do { if (__any((a) < 1.f)) { if (hi == 0) al_l[r32] = (a); asm volatile("s_waitcnt lgkmcnt(0)" ::: "memory"); \
    _Pragma("unroll") for (int d = 0; d < 4; ++d) _Pragma("unroll") for (int r = 0; r < 16; ++r) o[d][r] *= al_l[crow(r, hi)]; } } while (0)
  f32x16 pA0, pA1, pB0, pB1; float mnA, mnB, alA, alB; bf16x8 pa0, pa1, pa2, pa3; constexpr int NT = SEQ / KVBLK;
  SLOAD(0); SWAIT(); SWRITE(0); __syncthreads();
  qkt(pA0, pA1, K_lds, qr, kb); partialSM(pA0, pA1, m_reg, mnA, alA);
  SLOAD(KVBLK); SWAIT(); SWRITE(1); __syncthreads();
  for (int j = 1; j + 1 < NT; j += 2) {
    SBAR(); qkt(pB0, pB1, K_lds + SHM_K, qr, kb);
    finishSM(pA0, pA1, alA, l_reg, pa0, pa1, pa2, pa3); SBAR();
    SLOAD((j + 1) * KVBLK); SBAR();
    pv_d0(o, vb0, pa0, pa1, pa2, pa3); partialSM(pB0, pB1, m_reg, mnB, alB);
    __syncthreads(); SWAIT(); SWRITE(0);
    RESC(alB); __syncthreads();
    SBAR(); qkt(pA0, pA1, K_lds, qr, kb);
    finishSM(pB0, pB1, alB, l_reg, pa0, pa1, pa2, pa3); SBAR();
    SLOAD((j + 2) * KVBLK); SBAR();
    pv_d0(o, vb0 + SHM_V, pa0, pa1, pa2, pa3); partialSM(pA0, pA1, m_reg, mnA, alA);
    __syncthreads(); SWAIT(); SWRITE(1);
    RESC(alA); __syncthreads();
  }
  SBAR(); qkt(pB0, pB1, K_lds + SHM_K, qr, kb);
  finishSM(pA0, pA1, alA, l_reg, pa0, pa1, pa2, pa3); SBAR();
  pv_d0(o, vb0, pa0, pa1, pa2, pa3); partialSM(pB0, pB1, m_reg, mnB, alB);
  __syncthreads(); RESC(alB);
  finishSM(pB0, pB1, alB, l_reg, pa0, pa1, pa2, pa3); SBAR();
  pv_d0(o, vb0 + SHM_V, pa0, pa1, pa2, pa3);
  if (hi == 0) li_l[r32] = l_reg;
  __syncthreads();
  { int t2 = tid; asm volatile("" : "+v"(t2));
  const int wid = t2 >> 6, lane = t2 & 63, r32 = lane & 31, hi = lane >> 5;
  LAS float* li_l = (LAS float*)(lds + OFF_WS) + wid * 64;
  LAS bf16_t* stg = (LAS bf16_t*)(lds + wid * 8192);
#pragma unroll
  for (int r = 0; r < 16; ++r) { const int orow = crow(r, hi); const float rl = __builtin_amdgcn_rcpf(li_l[orow]);
#pragma unroll
    for (int d0 = 0; d0 < 4; ++d0) stg[orow * 128 + d0 * 32 + r32] = (bf16_t)(cvtpk(o[d0][r] * rl, 0.f) & 0xffffu); }
  asm volatile("s_waitcnt lgkmcnt(0)" ::: "memory");
  { const int row = lane >> 1, half = lane & 1; const LAS u32x4* src = (const LAS u32x4*)(stg + row * 128 + half * 64); float s = 0.f;
    bf16_t* orow = Ob + (long)(wid * QBLK + row) * 1024 + half * 64;
#pragma unroll
    for (int i = 0; i < 8; ++i) { const u32x4 v = src[i]; *(u32x4*)(orow + i * 8) = v;
#pragma unroll
      for (int e = 0; e < 4; ++e) { const float a = __builtin_bit_cast(float, v[e] << 16), b = __builtin_bit_cast(float, v[e] & 0xffff0000u); s += a * a + b * b; } }
    s = add_xor1(s);
    if (half == 0) ssq[(long)(wid * QBLK + row) * 8] = s; }
  }
  __syncthreads();
#undef SLOAD
#undef SWRITE
#undef SWAIT
#undef RESC
}
#undef SBAR
}

constexpr int NWAVES = 8, MK_THREADS = NWAVES * 64;
constexpr int MK_LDS = 147456, XCH_OFF = 131072, MISC_OFF = XCH_OFF + 4096, CW_BAR = 4096, CTL_ZERO_BYTES = 65536;

__device__ __forceinline__ void tr_item(const float* W, int K, int N, int koff, const float* g1, const float* g2, int ksplit, bf16_t* WT, LAS float* scr, int item, int lane, int perm_from = 1 << 30) {
    const int nblk = N / 32, kb = item / nblk, nb = item % nblk, k0 = 64 * kb, n0 = 32 * nb;
#pragma unroll 8
    for (int i = 0; i < 32; ++i) {
        const int kk = 2 * i + (lane >> 5), kp = k0 + kk, ks = (kp + koff) & (K - 1);
        const float g = g1 ? (kp < ksplit ? g1[kp] : g2[kp - ksplit]) : 1.f;
        int nc = n0 + (lane & 31); if (nc >= perm_from) { const int c = nc - perm_from; nc = perm_from + ((c >> 2) & 1) * 32 + 16 * (c >> 5) + 4 * ((c >> 3) & 3) + (c & 3); }
        scr[kk * 33 + (lane & 31)] = W[(size_t)ks * N + nc] * g;
    }
    asm volatile("s_waitcnt lgkmcnt(0)" ::: "memory");
    const int c = lane & 7;
#pragma unroll
    for (int j = 0; j < 4; ++j) {
        const int n = (lane >> 3) + 8 * j; const LAS float* s = scr + (8 * c) * 33 + n;
        u32x4 o; o.x = pk2(s[0 * 33], s[1 * 33]); o.y = pk2(s[2 * 33], s[3 * 33]); o.z = pk2(s[4 * 33], s[5 * 33]); o.w = pk2(s[6 * 33], s[7 * 33]);
        *(u32x4*)(WT + (size_t)(n0 + n) * K + k0 + 8 * c) = o;
    }
    asm volatile("s_waitcnt lgkmcnt(0)" ::: "memory");
}

__device__ __forceinline__ void phase_prologue(const Params& p, LAS unsigned char* lds, const int tid) {
    const int lane = tid & 63, wave = tid >> 6;
    const int G = gridDim.x, gw = blockIdx.x * NWAVES + wave, NGW = G * NWAVES;
    const int gt = blockIdx.x * MK_THREADS + tid, NGT = G * MK_THREADS;
    LAS float* tab = (LAS float*)lds;
    LAS float* scr = (LAS float*)(lds + 8192 + wave * 8704);
    for (int j = tid; j < 2048; j += MK_THREADS) tab[j] = cospif((float)j * (1.0f / 1024.0f));
    __syncthreads();
    unsigned char* ws = p.ws;
    {
        constexpr int I_IN = 16 * 26, I_QU = 4 * 36, I_KV = 4 * 48, I_OUT = 16 * 32, I_MI = 16 * 128, I_MO = 64 * 32, I_L = I_IN + I_QU + I_KV + I_OUT + I_MI + I_MO;
        for (int it = gw; it < DEPTH * I_L; it += NGW) {
            const int l = it / I_L; int r = it % I_L; unsigned char* wl = ws + WS_W + (size_t)l * LW;
            if (r < I_IN) { tr_item(p.in[I_WIN] + (size_t)l * DM * INW, DM, INW, 0, p.in[I_ANG] + l * DM, nullptr, DM, (bf16_t*)(wl + OW_IN), scr, r, lane, 768); continue; } r -= I_IN;
            if (r < I_QU) { tr_item(p.in[I_WQUP] + (size_t)l * QL * QUPW, QL, QUPW, 0, p.in[I_QAG] + l * QL, nullptr, QL, (bf16_t*)(wl + OW_QUP), scr, r, lane); continue; } r -= I_QU;
            if (r < I_KV) { tr_item(p.in[I_WKVUP] + (size_t)l * KVL * KVUPW, KVL, KVUPW, 0, p.in[I_KVAG] + l * KVL, nullptr, KVL, (bf16_t*)(wl + OW_KVUP), scr, r, lane); continue; } r -= I_KV;
            if (r < I_OUT) { tr_item(p.in[I_WOUT] + (size_t)l * DM * DM, DM, DM, FW, p.in[I_AOG] + l * AW, p.in[I_FOG] + l * FW, AW, (bf16_t*)(wl + OW_OUT), scr, r, lane); continue; } r -= I_OUT;
            if (r < I_MI) { tr_item(p.in[I_WMI] + (size_t)l * DM * FF, DM, FF, 0, p.in[I_MNG] + l * DM, nullptr, DM, (bf16_t*)(wl + OW_MI), scr, r, lane); continue; } r -= I_MI;
            tr_item(p.in[I_WMO] + (size_t)l * FF * DM, FF, DM, 0, nullptr, nullptr, FF, (bf16_t*)(wl + OW_MO), scr, r, lane);
        }
    }
    {
        constexpr int C_IN = (INWP - INW) * DM / 8, C_QU = (QUPWP - QUPW) * QL / 8, C_L = C_IN + C_QU;
        for (int i = gt; i < DEPTH * C_L; i += NGT) {
            const int l = i / C_L, r = i % C_L; unsigned char* wl = ws + WS_W + (size_t)l * LW;
            u32x4* dst = (r < C_IN) ? (u32x4*)(wl + OW_IN + (size_t)INW * DM * 2) + r : (u32x4*)(wl + OW_QUP + (size_t)QUPW * QL * 2) + (r - C_IN);
            *dst = (u32x4){0u, 0u, 0u, 0u};
        }
    }
    {
        bf16_t* F = (bf16_t*)(ws + WS_F);
        for (int ci = gt; ci < 4096 * 256; ci += NGT) {
            const int r = ci >> 8, s0 = (ci & 255) * 8, pq = r >> 11, sp = r & 2047, sh = pq ? 1536 : 0;
            float v[8];
#pragma unroll
            for (int e = 0; e < 8; ++e) v[e] = tab[(sp * (s0 + e) + sh) & 2047];
            u32x4 o; o.x = pk2(v[0], v[1]); o.y = pk2(v[2], v[3]); o.z = pk2(v[4], v[5]); o.w = pk2(v[6], v[7]);
            *(u32x4*)(F + (size_t)r * 2048 + s0) = o;
        }
    }
    {
        for (int i = gt; i < DEPTH * 256 * 512; i += NGT) {
            const int l = i / (256 * 512), r = i % (256 * 512), n = r >> 9, k = r & 511, g = n >> 6, d = n & 63, pq = k >> 8, g2 = (k >> 6) & 3, c = k & 63;
            float acc = 0.f;
            if (g2 == g) {
                const float* wf = p.in[I_WF] + ((size_t)(l * 4 + g) * 64) * 64 + d;
                const int sh = pq ? 1536 : 0;
                for (int c2 = 0; c2 < 64; ++c2) acc += tab[((((c * c2) & 63) * 32) + sh) & 2047] * wf[(size_t)c2 * 64];
                acc *= pq ? -DFT_NRM : DFT_NRM;
            }
            ((bf16_t*)(ws + WS_W + (size_t)l * LW + OW_Y))[r] = (bf16_t)f2bf(acc);
        }
    }
    {
        bf16_t* XB = (bf16_t*)(ws + WS_XB); float* SSQ = (float*)(ws + WS_SSQX);
        for (int m = gw; m < T; m += NGW) {
            const f32x4* xr = (const f32x4*)(p.x + (size_t)m * DM) + lane; f32x4 v[4]; float s = 0.f;
#pragma unroll
            for (int j = 0; j < 4; ++j) { v[j] = xr[64 * j]; s += (v[j].x * v[j].x + v[j].y * v[j].y) + (v[j].z * v[j].z + v[j].w * v[j].w); }
            s = wave_sum(s);
            u32x2* o8 = (u32x2*)(XB + (size_t)m * DM) + lane;
#pragma unroll
            for (int j = 0; j < 4; ++j) o8[64 * j] = (u32x2){pk2(v[j].x, v[j].y), pk2(v[j].z, v[j].w)};
            if (lane < 4) SSQ[(size_t)m * 4 + lane] = lane == 0 ? s : 0.f;
        }
    }
    {
        float* R = (float*)(ws + WS_ROPE);
        for (int i = gt; i < T * 32; i += NGT) {
            const int row = i >> 5, j = i & 31;
            const float inv = powf(10000.0f, -(float)j * (1.0f / 32.0f));
            const float ang = (float)p.pos[row] * inv;
            R[(size_t)row * 64 + j] = cosf(ang); R[(size_t)row * 64 + 32 + j] = sinf(ang);
        }
    }
}

#define XB_TMO      128
#define XB_XCNT(j)  (256  + 64 * (j))
#define XB_XSUB(j)  (1280 + 64 * (j))
#define XB_XGEN(j)  (2304 + 64 * (j))
#define XB_TOP      3328
#define XB_TOPGEN   3392
#define XCD_BAR_WORDS 3456
#define XB_SPIN_CAP (1u << 18)

__device__ __forceinline__ unsigned xb_ld(unsigned* p)              { return __hip_atomic_load(p, __ATOMIC_RELAXED, __HIP_MEMORY_SCOPE_AGENT); }
__device__ __forceinline__ unsigned xb_add(unsigned* p, unsigned v) { return __hip_atomic_fetch_add(p, v, __ATOMIC_RELAXED, __HIP_MEMORY_SCOPE_AGENT); }
__device__ __forceinline__ unsigned xb_xcc_id() { return (unsigned)__builtin_amdgcn_s_getreg((3 << 11) | 20) & 0xFu; }
#define XB_SPIN(cond, bar) do { unsigned _sp = 0; while (cond) { __builtin_amdgcn_s_sleep(1); \
    if ((++_sp & 255u) == 0u) { if (xb_ld(&(bar)[XB_TMO])) break; if (_sp > XB_SPIN_CAP) { atomicAdd(&(bar)[XB_TMO], 1u); break; } } } } while (0)

struct XcdBarrier {
    unsigned* bar; unsigned x;
    volatile LAS unsigned* st;
};

__device__ __forceinline__ XcdBarrier xcd_barrier_post(unsigned* bar, volatile LAS unsigned* st) {
    XcdBarrier b; b.bar = bar; b.x = xb_xcc_id(); b.st = st;
    if (threadIdx.x == 0) (void)xb_add(&bar[XB_XCNT(b.x)], 1u);
    return b;
}
__device__ __forceinline__ void xcd_barrier_complete(unsigned* bar, unsigned x, unsigned& nloc, unsigned& nx) {
    const unsigned G = gridDim.x * gridDim.y * gridDim.z;
    unsigned sum, cnt, mine, sp = 0u;
    for (;;) {
        sum = 0u; cnt = 0u; mine = 0u;
#pragma unroll
        for (unsigned j = 0; j < 16; ++j) { const unsigned c = xb_ld(&bar[XB_XCNT(j)]); sum += c; cnt += (c > 0u) ? 1u : 0u; mine = (j == x) ? c : mine; }
        if (sum == G) break;
        __builtin_amdgcn_s_sleep(1);
        if ((++sp & 255u) == 0u) { if (xb_ld(&bar[XB_TMO])) break; if (sp > XB_SPIN_CAP) { atomicAdd(&bar[XB_TMO], 1u); break; } }
    }
    nloc = mine > 0u ? mine : 1u; nx = cnt > 0u ? cnt : 1u;
}

__device__ __forceinline__ void xcd_barrier(const XcdBarrier& b) {
    asm volatile("s_waitcnt vmcnt(0)" ::: "memory");
    __syncthreads();
    if (threadIdx.x == 0) {
        unsigned* bar = b.bar;
        __builtin_amdgcn_s_waitcnt(0);
        unsigned nloc = b.st[0], nx = b.st[1];
        if (nloc == 0u) { xcd_barrier_complete(bar, b.x, nloc, nx); b.st[0] = nloc; b.st[1] = nx; }
        const unsigned old = xb_add(&bar[XB_XSUB(b.x)], 1u);
        const unsigned gen = old / nloc;
        if (old + 1u == (gen + 1u) * nloc) {
            __builtin_amdgcn_fence(__ATOMIC_RELEASE, "agent");
            asm volatile("s_waitcnt vmcnt(0)" ::: "memory");
            const unsigned og = xb_add(&bar[XB_TOP], 1u);
            const unsigned tg = og / nx;
            if (og + 1u == (tg + 1u) * nx) xb_add(&bar[XB_TOPGEN], 1u);
            else XB_SPIN(xb_ld(&bar[XB_TOPGEN]) == tg, bar);
            __builtin_amdgcn_fence(__ATOMIC_ACQUIRE, "agent");
            xb_add(&bar[XB_XGEN(b.x)], 1u);
            asm volatile("s_waitcnt vmcnt(0)" ::: "memory");
        } else {
            XB_SPIN(xb_ld(&bar[XB_XGEN(b.x)]) == gen, bar);
            __builtin_amdgcn_fence(__ATOMIC_ACQUIRE, "agent");
            asm volatile("s_waitcnt vmcnt(0)" ::: "memory");
        }
    }
    __syncthreads();
}

constexpr int N_PHASES = 1 + 6 * DEPTH;
#ifndef DUP_PH
#define DUP_PH -1
#define DUP_SUB 7
#endif
#ifndef PHM
#define PHM 0xffff
#endif
__global__ void __launch_bounds__(MK_THREADS, 2) mk(Params p) {
    extern __shared__ __attribute__((aligned(16))) unsigned char lds_raw[];
    LAS unsigned char* lds = (LAS unsigned char*)lds_raw;
    const int G = gridDim.x, bid = blockIdx.x;
#define BP(off) ((bf16_t*)(ws + (off)))
#define FP(off) ((float*)(ws + (off)))
    volatile LAS unsigned* MISC = (volatile LAS unsigned*)(lds + MISC_OFF);
    if (threadIdx.x < 32) MISC[threadIdx.x] = 0u;
    __syncthreads();
    const XcdBarrier bar = xcd_barrier_post((unsigned*)(p.ws + WS_CTL) + CW_BAR, MISC + 8);
    if (p.ph_lo == 0) {
        phase_prologue(p, lds, threadIdx.x);
        if (p.ph_hi > 1) xcd_barrier(bar);
    }
    for (int ph = p.ph_lo < 1 ? 1 : p.ph_lo; ph < p.ph_hi; ++ph) {
        for (int rep = 0; rep < ((ph == DUP_PH) ? 2 : 1); ++rep) {
            const int sub = rep == 0 ? p.sub : DUP_SUB; if (rep) __syncthreads();
        int tid = threadIdx.x; asm volatile("" : "+v"(tid));
        unsigned char* ws; { unsigned long long w_ = (unsigned long long)p.ws; asm volatile("" : "+s"(w_)); ws = (unsigned char*)(__attribute__((address_space(1))) unsigned char*)w_; }
            const int l = (ph - 1) / 6, s = (ph - 1) % 6;
            unsigned char* wl = ws + WS_W + (size_t)l * LW;
            pg8::StaticOrder S;
            if (s == 0 && ((PHM & 1) != 0)) {
                pg8::Gemm g{BP(WS_XB), (const bf16_t*)(wl + OW_IN), T, INWP, DM}; S.init(T, INWP, G, bid);
                pg8::EpiIn E{FP(WS_SSQX), BP(WS_UT), BP(WS_CQ), BP(WS_CKV), BP(WS_KPE), FP(WS_SSQCQ), FP(WS_SSQCKV), FP(WS_SSQPE), p.in[I_KNG] + l * QKD, FP(WS_ROPE)};
                pg8::gemm_phase<pg8::EpiIn, pg8::StaticOrder, true, true>(lds, g, S, E, tid);
            } else if (s == 1 && ((PHM & 2) != 0)) {
                if ((sub & 1) && ((PHM & 64) != 0)) { pg8::Gemm g{BP(WS_F), BP(WS_UT), 4096, 4096, 2048}; S.init(4096, 4096, G, bid); pg8::EpiDft E{BP(WS_PQ)};
                    pg8::gemm_phase<pg8::EpiDft, pg8::StaticOrder, true, true>(lds, g, S, E, tid); }
                if ((sub & 2) && ((PHM & 128) != 0)) { pg8::Gemm g{BP(WS_CQ), (const bf16_t*)(wl + OW_QUP), T, QUPWP, QL}; S.init(T, QUPWP, G, bid); pg8::EpiQ E{FP(WS_SSQCQ), BP(WS_Q)};
                    pg8::gemm_phase<pg8::EpiQ, pg8::StaticOrder, true, true>(lds, g, S, E, tid); }
                if ((sub & 4) && ((PHM & 512) != 0)) { pg8::Gemm g{BP(WS_CKV), (const bf16_t*)(wl + OW_KVUP), T, KVUPW, KVL}; S.init(T, KVUPW, G, bid);
                    pg8::EpiKV E{FP(WS_SSQCKV), FP(WS_SSQPE), p.in[I_KNG] + l * QKD, BP(WS_KPE), BP(WS_K), BP(WS_V), (LAS float*)(lds + XCH_OFF)};
                    pg8::gemm_phase<pg8::EpiKV, pg8::StaticOrder, true, true>(lds, g, S, E, tid); }
            } else if (s == 2 && ((PHM & 4) != 0)) {
                if ((sub & 1) && ((PHM & 1024) != 0)) {
                    const int vcu = (G % 8 == 0) ? (bid % 8) * (G / 8) + bid / 8 : bid;
                    for (int ui = vcu; ui < BATCH * NH * 8; ui += G) { const int bh = ui >> 3, qb = ui & 7, b = bh / NH, h = bh - b * NH; const size_t row0 = (size_t)b * SEQ + qb * 256;
                        att::attn_unit(BP(WS_Q) + row0 * QUPW + h * QKD, BP(WS_K) + (size_t)b * SEQ * QUPW + h * QKD, BP(WS_V) + (size_t)b * SEQ * AW + h * VD, BP(WS_MIX) + row0 * 1024 + h * VD,
                                       FP(WS_SSQA) + row0 * 8 + h, p.in[I_QNG] + l * QKD, FP(WS_ROPE) + row0 * 64, (LAS char*)lds, tid); }
                }
                if ((sub & 2) && ((PHM & 2048) != 0)) { pg8::Gemm g{BP(WS_PQ), (const bf16_t*)(wl + OW_Y), T, 256, 512}; S.init(T, 256, G, bid);
                    pg8::EpiY E{BP(WS_MIX), (LAS float*)(lds + XCH_OFF)};
                    pg8::gemm_phase<pg8::EpiY, pg8::StaticOrder, true, true>(lds, g, S, E, tid); }
            } else if (s == 3 && ((PHM & 8) != 0)) {
                pg8::Gemm g{BP(WS_MIX), (const bf16_t*)(wl + OW_OUT), T, DM, DM}; S.init(T, DM, G, bid);
                pg8::EpiRes<12> E{l == 0 ? p.x : nullptr, nullptr, BP(WS_XB), FP(WS_SSQX), FP(WS_SSQA), (LAS float*)(lds + XCH_OFF)};
                pg8::gemm_phase<pg8::EpiRes<12>, pg8::StaticOrder, true, true>(lds, g, S, E, tid);
            } else if (s == 4 && ((PHM & 16) != 0)) {
                pg8::Gemm g{BP(WS_XB), (const bf16_t*)(wl + OW_MI), T, FF, DM}; S.init(T, FF, G, bid);
                pg8::EpiMlpIn E{FP(WS_SSQX), BP(WS_H)};
                pg8::gemm_phase<pg8::EpiMlpIn, pg8::StaticOrder, true, true>(lds, g, S, E, tid);
            } else if ((PHM & 32) != 0) {
                pg8::Gemm g{BP(WS_H), (const bf16_t*)(wl + OW_MO), T, DM, FF}; S.init(T, DM, G, bid);
                pg8::EpiRes<0> E{nullptr, l == DEPTH - 1 ? p.out : nullptr, BP(WS_XB), FP(WS_SSQX), nullptr, (LAS float*)(lds + XCH_OFF)};
                pg8::gemm_phase<pg8::EpiRes<0>, pg8::StaticOrder, true, true>(lds, g, S, E, tid);
            }
        }
        if (ph + 1 < p.ph_hi) xcd_barrier(bar); else __syncthreads();
    }
}


extern "C" void kernel_launch(void* const* d_in, const int* in_sizes, int n_in, void* d_out, int out_size, void* d_ws, size_t ws_size, hipStream_t stream) {
    static int grid = 0;
    if (grid == 0) {
        if (n_in != 17 || in_sizes[0] != T * DM || out_size != T * DM || ws_size < WS_END) {
            fprintf(stderr, "kernel_launch: shape/workspace mismatch: n_in %d in0 %d out %d ws %zu (need %zu)\n", n_in, n_in > 0 ? in_sizes[0] : -1, out_size, ws_size, (size_t)WS_END);
            grid = -1; return; }
        if (hipFuncSetAttribute((const void*)mk, hipFuncAttributeMaxDynamicSharedMemorySize, MK_LDS) != hipSuccess) { fprintf(stderr, "kernel_launch: hipFuncSetAttribute failed\n"); grid = -1; return; }
        int dev = 0, cus = 0, per_cu = 0;
        if (hipGetDevice(&dev) != hipSuccess || hipDeviceGetAttribute(&cus, hipDeviceAttributeMultiprocessorCount, dev) != hipSuccess) { fprintf(stderr, "kernel_launch: device query failed\n"); grid = -1; return; }
        if (hipOccupancyMaxActiveBlocksPerMultiprocessor(&per_cu, (const void*)mk, MK_THREADS, MK_LDS) != hipSuccess || per_cu < 1) { fprintf(stderr, "kernel_launch: occupancy query says %d blocks per CU\n", per_cu); grid = -1; return; }
        grid = cus;
    }
    if (grid < 0) return;
    Params p{};
    p.x = (const float*)d_in[0]; p.pos = (const int*)d_in[1];
    for (int i = 0; i < 15; ++i) p.in[i] = (const float*)d_in[2 + i];
    p.out = (float*)d_out; p.ws = (unsigned char*)d_ws; p.ph_lo = 0; p.ph_hi = N_PHASES; p.sub = 7; p.pad = 0;
    if (hipMemsetAsync((char*)d_ws + WS_CTL, 0, CTL_ZERO_BYTES, stream) != hipSuccess) { fprintf(stderr, "kernel_launch: hipMemsetAsync failed\n"); return; }
    hipLaunchKernelGGL(mk, dim3(grid), dim3(MK_THREADS), MK_LDS, stream, p);
    const hipError_t le = hipPeekAtLastError();
    if (le != hipSuccess) fprintf(stderr, "kernel_launch: launch failed: %s (grid %d)\n", hipGetErrorName(le), grid);
}
```

```cpp
#include <hip/hip_runtime.h>
#include <cstdio>
#include <cstdint>

typedef unsigned short bf16_t;
typedef short bf16x8 __attribute__((ext_vector_type(8)));
typedef float f32x4 __attribute__((ext_vector_type(4)));
typedef unsigned u32x4 __attribute__((ext_vector_type(4)));
typedef unsigned u32x2 __attribute__((ext_vector_type(2)));
#define LAS __attribute__((address_space(3)))

constexpr int BATCH = 16, SEQ = 2048, DM = 1024, T = BATCH * SEQ, DEPTH = 2;
constexpr int FW = 256, QL = 256, KVL = 256, ROPE_D = 64, NOPE = 128, VD = 128, NH = 6, QKD = 192;
constexpr int INW = 832, INWP = 1024, QUPW = NH * QKD  , QUPWP = 1280, KVUPW = NH * 256  , AW = NH * VD  , FF = 4096;
constexpr float EPS = 1e-6f;
constexpr float QSCALE = 0.07216878364870322f * 1.4426950408889634f;
constexpr float DFT_NRM = 0.0027621358640099515f;

constexpr size_t MiB = 1u << 20;
constexpr size_t WS_CTL = 0;
constexpr size_t WS_W = 1 * MiB, LW = 22 * MiB;
constexpr size_t OW_IN = 0, OW_QUP = 2 * MiB, OW_KVUP = OW_QUP + 640 * 1024, OW_OUT = OW_KVUP + 768 * 1024, OW_MI = OW_OUT + 2 * MiB, OW_MO = OW_MI + 8 * MiB, OW_Y = OW_MO + 8 * MiB;
static_assert(OW_Y + 256 * 1024 <= LW, "layer weight block");
constexpr size_t WS_F = 45 * MiB;
constexpr size_t WS_SSQX = 61 * MiB;
constexpr size_t WS_SSQCQ = 63 * MiB, WS_SSQCKV = WS_SSQCQ + 512 * 1024;
constexpr size_t WS_XB = 64 * MiB;
constexpr size_t WS_MIX = 128 * MiB;
constexpr size_t WS_Q = 192 * MiB;
constexpr size_t WS_K = 264 * MiB;
constexpr size_t WS_V = 336 * MiB;
constexpr size_t WS_PQ = 384 * MiB;
constexpr size_t WS_UT = 416 * MiB;
constexpr size_t WS_H = 192 * MiB;
constexpr size_t WS_CQ = 448 * MiB, WS_CKV = 464 * MiB;
constexpr size_t WS_KPE = 480 * MiB;
constexpr size_t WS_ROPE = 484 * MiB;
constexpr size_t WS_SSQPE = 492 * MiB;
constexpr size_t WS_SSQA = WS_SSQPE + 256 * 1024;
constexpr size_t WS_RSTD = 494 * MiB;
constexpr size_t WS_END = 495 * MiB;
constexpr size_t WS_KRAW = 384 * MiB;
constexpr size_t WS_S = 384 * MiB;

__device__ __forceinline__ unsigned f2bf(float f) { unsigned u = __builtin_bit_cast(unsigned, f); return (u + 0x7fffu + ((u >> 16) & 1u)) >> 16; }
__device__ __forceinline__ unsigned pk2(float lo, float hi) { return f2bf(lo) | (f2bf(hi) << 16); }
__device__ __forceinline__ float bf2f(bf16_t h) { return __builtin_bit_cast(float, (unsigned)h << 16); }
__device__ __forceinline__ float add_xor32(float v) { auto rr = __builtin_amdgcn_permlane32_swap(__float_as_uint(v), __float_as_uint(v), false, false); return __uint_as_float(rr[0]) + __uint_as_float(rr[1]); }
__device__ __forceinline__ float add_xor16(float v) { return v + __uint_as_float(__builtin_amdgcn_ds_swizzle(__float_as_uint(v), 0x401F)); }
__device__ __forceinline__ float add_xor1(float v) { return v + __uint_as_float(__builtin_amdgcn_ds_swizzle(__float_as_uint(v), 0x041F)); }
__device__ __forceinline__ float wave_sum(float v) {
#pragma unroll
    for (int o = 1; o < 64; o <<= 1) v += __shfl_xor(v, o);
    return v;
}

struct Params {
    const float* x; const int* pos; const float* in[15];
    float* out; unsigned char* ws; int ph_lo, ph_hi, sub, pad;
};
enum { I_ANG = 0, I_WIN, I_WF, I_QAG, I_WQUP, I_KVAG, I_WKVUP, I_QNG, I_KNG, I_FOG, I_AOG, I_WOUT, I_MNG, I_WMI, I_WMO };
__device__ __forceinline__ const float* karg_in(int i) {
    const volatile unsigned long long* ka = (const volatile unsigned long long*)__builtin_amdgcn_kernarg_segment_ptr();
    return (const float*)(__attribute__((address_space(1))) const float*)ka[2 + i];
}

namespace pg8 {
#define PG8_LAS __attribute__((address_space(3)))
typedef unsigned short bf16_t;
typedef short bf16x8 __attribute__((ext_vector_type(8)));
typedef float f32x4 __attribute__((ext_vector_type(4)));
typedef unsigned u32x4 __attribute__((ext_vector_type(4)));
constexpr int BM = 256, BK = 64, HALF = 128, HTB = HALF * BK * 2  , STAGE_BYTES = 8 * HTB, NXCD = 8, WGM = 8;

__host__ __device__ __forceinline__ int lds_byte(int r, int c) { const int st = (r >> 4) * 2 + (c >> 5), rr = r & 15, cc = c & 31, ob = rr * 64 + cc * 2; return st * 1024 + (ob ^ (((ob >> 9) & 1) << 5)); }
__host__ __device__ __forceinline__ void stage_rc(int b, int& R, int& C) { const int st = b / 1024, sb = b % 1024, swz = sb ^ (((sb >> 9) & 1) << 5); R = (st >> 1) * 16 + swz / 64; C = (st & 1) * 32 + (swz % 64) / 2; }
__host__ __device__ __forceinline__ int perm32(int rho) { const int n = rho >> 4, i = rho & 15; return 8 * (i >> 2) + 4 * n + (i & 3); }

struct Unit { int pm, pn; };
struct Gemm { const bf16_t* A; const bf16_t* Bt; int M, N, K; };

struct StaticOrder {
    int nM, nN, nwg, G, c;
    __host__ __device__ void init(int M, int N, int G_, int c_) { nM = M / BM; nN = N / BM; nwg = nM * nN; G = G_; c = c_; }
    __host__ __device__ bool next(int i, Unit& u) const {
        const long L = (long)i * G + c; if (L >= nwg) return false;
        int wgid = (int)L; { const int q = nwg / NXCD, r = nwg % NXCD, xcd = wgid % NXCD, off = wgid / NXCD; wgid = (xcd < r ? xcd * (q + 1) : r * (q + 1) + (xcd - r) * q) + off; }
        const int nig = WGM * nN, gid = wgid / nig, fm = gid * WGM, gsz = (nM - fm) < WGM ? (nM - fm) : WGM;
        u.pm = fm + ((wgid % nig) % gsz); u.pn = (wgid % nig) / gsz; return true;
    }
    __device__ __forceinline__ void a_ready(const Unit&) const {}
    __device__ __forceinline__ void done(const Unit&) const {}
};

template <class Epi, class Sched, bool ALIGN_EPI = false, bool SP2 = false>
__device__ __forceinline__ void gemm_phase(PG8_LAS unsigned char* lds, const Gemm g, const Sched& S, const Epi& E, const int tid) {
    const int wid = __builtin_amdgcn_readfirstlane(tid >> 6), lane = tid & 63, wr = wid >> 2, wc = wid & 3, fr = lane & 15, fq = lane >> 4;
    int K_ = g.K; asm volatile("" : "+s"(K_));
    const int K = K_, nt = K / BK;
    unsigned voffA[2], voffB[2];
#pragma unroll
    for (int i = 0; i < 2; ++i) { int R, C; stage_rc(tid * 16 + i * 8192, R, C); const int Rb = Epi::PERM ? ((R & ~31) + perm32(R & 31)) : R;
        voffA[i] = (unsigned)(R * K + C) * 2u; voffB[i] = (unsigned)(Rb * K + C) * 2u; }
    const size_t kstep = (size_t)(BK * 2);
    const size_t hstep = (size_t)HALF * K * 2;
    const size_t tstep = 2 * hstep;
    const unsigned ldsw = (unsigned)wid * 1024u;
    const int aoff = lds_byte(wr * 64 + fr, fq * 8), boff = lds_byte(wc * 32 + fr, fq * 8);
#define PG8_SA(b, h) (((b) * 2 + (h)) * HTB)
#define PG8_SB(b, h) ((4 + (b) * 2 + (h)) * HTB)
#define PG8_STAGE(bufoff, gbase, voff) do { _Pragma("unroll") for (int _i = 0; _i < 2; ++_i) \
        __builtin_amdgcn_global_load_lds((const unsigned*)((const char*)(gbase) + (voff)[_i]), (PG8_LAS unsigned*)(lds + (bufoff) + ldsw + _i * 8192), 16, 0, 0); } while (0)
#define PG8_LDA(dst, b, h) do { _Pragma("unroll") for (int m = 0; m < 4; ++m) _Pragma("unroll") for (int k = 0; k < 2; ++k) dst[m][k] = *(const PG8_LAS bf16x8*)(lds + PG8_SA(b, h) + aoff + m * 2048 + k * 1024); } while (0)
#define PG8_LDB(dst, b, h) do { _Pragma("unroll") for (int n = 0; n < 2; ++n) _Pragma("unroll") for (int k = 0; k < 2; ++k) dst[n][k] = *(const PG8_LAS bf16x8*)(lds + PG8_SB(b, h) + boff + n * 2048 + k * 1024); } while (0)
#define PG8_MMA(ai, bj, At, Bt) do { __builtin_amdgcn_s_setprio(1); _Pragma("unroll") for (int m = 0; m < 4; ++m) _Pragma("unroll") for (int n = 0; n < 2; ++n) _Pragma("unroll") for (int k = 0; k < 2; ++k) \
        acc[ai][bj][m][n] = __builtin_amdgcn_mfma_f32_16x16x32_bf16(Bt[n][k], At[m][k], acc[ai][bj][m][n], 0, 0, 0); __builtin_amdgcn_s_setprio(0); } while (0)
#define PG8_WAIT_V(n) asm volatile("s_waitcnt vmcnt(" #n ")" ::: "memory")
#define PG8_WAIT_L(n) asm volatile("s_waitcnt lgkmcnt(" #n ")" ::: "memory")
#define PG8_BAR __builtin_amdgcn_s_barrier()
#define PG8_SCHED __builtin_amdgcn_sched_barrier(0)
    Unit cur, nxt; int ui = 0;
    if (!S.next(0, cur)) return;
    f32x4 acc[2][2][4][2];
#pragma unroll
    for (int a = 0; a < 2; ++a)
#pragma unroll
        for (int b = 0; b < 2; ++b)
#pragma unroll
            for (int m = 0; m < 4; ++m)
#pragma unroll
                for (int n = 0; n < 2; ++n) acc[a][b][m][n] = (f32x4){0.f, 0.f, 0.f, 0.f};
    bf16x8 At[4][2], B0[2][2], B1[2][2];
    const char* cA = (const char*)g.A + (size_t)cur.pm * tstep; const char* cB = (const char*)g.Bt + (size_t)cur.pn * tstep;
    S.a_ready(cur);
    if constexpr (SP2) {
        PG8_STAGE(PG8_SB(0, 0), cB, voffB); PG8_STAGE(PG8_SB(0, 1), cB + hstep, voffB); PG8_STAGE(PG8_SA(0, 0), cA, voffA); PG8_STAGE(PG8_SA(0, 1), cA + hstep, voffA);
        if (wr == 1) PG8_BAR;
        PG8_WAIT_V(2); PG8_BAR;
        PG8_STAGE(PG8_SB(1, 0), cB + kstep, voffB); PG8_STAGE(PG8_SA(1, 0), cA + kstep, voffA); PG8_STAGE(PG8_SB(1, 1), cB + hstep + kstep, voffB);
        PG8_WAIT_V(6); PG8_BAR;
    } else {
        PG8_STAGE(PG8_SB(0, 0), cB, voffB); PG8_STAGE(PG8_SA(0, 0), cA, voffA); PG8_STAGE(PG8_SB(0, 1), cB + hstep, voffB); PG8_STAGE(PG8_SA(0, 1), cA + hstep, voffA);
        if (wr == 1) PG8_BAR;
        PG8_WAIT_V(4); PG8_BAR;
        PG8_STAGE(PG8_SB(1, 0), cB + kstep, voffB); PG8_STAGE(PG8_SA(1, 0), cA + kstep, voffA); PG8_STAGE(PG8_SB(1, 1), cB + hstep + kstep, voffB);
        PG8_WAIT_V(6); PG8_BAR;
    }
    for (;;) {
        const bool has_next = S.next(ui + 1, nxt);
        const char* nA = has_next ? (const char*)g.A + (size_t)nxt.pm * tstep : cA; const char* nB = has_next ? (const char*)g.Bt + (size_t)nxt.pn * tstep : cB;
        for (int t = 0; t < nt; t += 2) {
            const bool last = (t == nt - 2);
            const char* a1 = cA + (size_t)(t + 1) * kstep;
            const char* a2 = last ? nA : cA + (size_t)(t + 2) * kstep; const char* b2 = last ? nB : cB + (size_t)(t + 2) * kstep;
            const char* a3 = a2 + kstep; const char* b3 = b2 + kstep;
            if (last && has_next) S.a_ready(nxt);
            if constexpr (SP2) {
            PG8_LDB(B0, 0, 0); PG8_LDB(B1, 0, 1); PG8_SCHED; PG8_LDA(At, 0, 0); PG8_STAGE(PG8_SA(1, 1), a1 + hstep, voffA);
            PG8_WAIT_V(8); PG8_WAIT_L(0); PG8_BAR; PG8_MMA(0, 0, At, B0); PG8_MMA(0, 1, At, B1); PG8_BAR; PG8_SCHED;
            PG8_LDA(At, 0, 1); PG8_STAGE(PG8_SB(0, 0), b2, voffB); PG8_STAGE(PG8_SB(0, 1), b2 + hstep, voffB); PG8_STAGE(PG8_SA(0, 0), a2, voffA);
            PG8_WAIT_V(8); PG8_WAIT_L(0); PG8_BAR; PG8_MMA(1, 0, At, B0); PG8_MMA(1, 1, At, B1); PG8_BAR; PG8_SCHED;
            PG8_LDB(B0, 1, 0); PG8_LDB(B1, 1, 1); PG8_SCHED; PG8_LDA(At, 1, 0); PG8_STAGE(PG8_SA(0, 1), a2 + hstep, voffA);
            PG8_WAIT_V(8); PG8_WAIT_L(0); PG8_BAR; PG8_MMA(0, 0, At, B0); PG8_MMA(0, 1, At, B1); PG8_BAR; PG8_SCHED;
            PG8_LDA(At, 1, 1); PG8_STAGE(PG8_SB(1, 0), b3, voffB); PG8_STAGE(PG8_SB(1, 1), b3 + hstep, voffB); PG8_STAGE(PG8_SA(1, 0), a3, voffA);
            PG8_WAIT_V(8); PG8_WAIT_L(0); PG8_BAR; PG8_MMA(1, 0, At, B0); PG8_MMA(1, 1, At, B1); PG8_BAR; PG8_SCHED;
            } else {
            PG8_LDB(B0, 0, 0); PG8_SCHED; PG8_LDA(At, 0, 0); PG8_STAGE(PG8_SA(1, 1), a1 + hstep, voffA);
            PG8_WAIT_L(8); PG8_BAR; PG8_WAIT_L(0); PG8_MMA(0, 0, At, B0); PG8_BAR; PG8_SCHED;
            PG8_LDB(B1, 0, 1); PG8_STAGE(PG8_SB(0, 0), b2, voffB);
            PG8_BAR; PG8_WAIT_L(0); PG8_MMA(0, 1, At, B1); PG8_BAR;
            PG8_LDA(At, 0, 1); PG8_STAGE(PG8_SA(0, 0), a2, voffA);
            PG8_BAR; PG8_WAIT_L(0); PG8_MMA(1, 0, At, B0); PG8_BAR; PG8_SCHED;
            PG8_STAGE(PG8_SB(0, 1), b2 + hstep, voffB);
            PG8_WAIT_V(6); PG8_BAR; PG8_MMA(1, 1, At, B1); PG8_BAR;
            PG8_LDB(B0, 1, 0); PG8_SCHED; PG8_LDA(At, 1, 0); PG8_STAGE(PG8_SA(0, 1), a2 + hstep, voffA);
            PG8_WAIT_L(8); PG8_BAR; PG8_WAIT_L(0); PG8_MMA(0, 0, At, B0); PG8_BAR; PG8_SCHED;
            PG8_LDB(B1, 1, 1); PG8_STAGE(PG8_SB(1, 0), b3, voffB);
            PG8_BAR; PG8_WAIT_L(0); PG8_MMA(0, 1, At, B1); PG8_BAR;
            PG8_LDA(At, 1, 1); PG8_STAGE(PG8_SA(1, 0), a3, voffA);
            PG8_BAR; PG8_WAIT_L(0); PG8_MMA(1, 0, At, B0); PG8_BAR; PG8_SCHED;
            PG8_STAGE(PG8_SB(1, 1), b3 + hstep, voffB);
            PG8_WAIT_V(6); PG8_BAR; PG8_MMA(1, 1, At, B1); PG8_BAR;
            }
            if constexpr (Epi::MIDK > 0) { if (t + 2 == Epi::MIDK) E.midk(acc, cur, wr, fr); }
        }
        if constexpr (ALIGN_EPI) { if (wr == 0) PG8_BAR; }
        if constexpr (!Epi::AFTER_DRAIN) { E(acc, cur, wr, wc, fr, fq); S.done(cur); }
        if (!has_next) break;
#pragma unroll
        for (int a = 0; a < 2; ++a)
#pragma unroll
            for (int b = 0; b < 2; ++b)
#pragma unroll
                for (int m = 0; m < 4; ++m)
#pragma unroll
                    for (int n = 0; n < 2; ++n) acc[a][b][m][n] = (f32x4){0.f, 0.f, 0.f, 0.f};
        cur = nxt; cA = nA; cB = nB; ++ui;
        if constexpr (ALIGN_EPI) { if (wr == 1) PG8_BAR; }
    }
    PG8_WAIT_V(0);
    if constexpr (!ALIGN_EPI) { if (wr == 0) PG8_BAR; }
    PG8_BAR;
    if constexpr (Epi::AFTER_DRAIN) { E.fused(acc, cur, wr, wc, fr, fq, lds, wid, lane); S.done(cur); }
#undef PG8_SA
#undef PG8_SB
#undef PG8_STAGE
#undef PG8_LDA
#undef PG8_LDB
#undef PG8_MMA
#undef PG8_WAIT_V
#undef PG8_WAIT_L
#undef PG8_BAR
#undef PG8_SCHED
}
}

namespace pg8 {
__device__ __forceinline__ unsigned cvt_pk_bf16(float lo, float hi) { unsigned r; asm volatile("v_cvt_pk_bf16_f32 %0, %1, %2" : "=v"(r) : "v"(lo), "v"(hi)); return r; }
__device__ __forceinline__ u32x4 pack8(const f32x4 a, const f32x4 b) { u32x4 w; w.x = cvt_pk_bf16(a[0], a[1]); w.y = cvt_pk_bf16(a[2], a[3]); w.z = cvt_pk_bf16(b[0], b[1]); w.w = cvt_pk_bf16(b[2], b[3]); return w; }
__device__ __forceinline__ float sum4(const f32x4 a) { return (a[0] + a[1]) + (a[2] + a[3]); }
__device__ __forceinline__ float ssq4(const f32x4 a) { return (a[0] * a[0] + a[1] * a[1]) + (a[2] * a[2] + a[3] * a[3]); }
__device__ __forceinline__ float rstd16(const float* p, float invn) { const f32x4* q = (const f32x4*)p; const f32x4 a = q[0], b = q[1], c = q[2], d = q[3]; return rsqrtf(((sum4(a) + sum4(b)) + (sum4(c) + sum4(d))) * invn + 1e-6f); }
__device__ __forceinline__ float rstd4(const float* p, float invn) { const f32x4 a = *(const f32x4*)p; return rsqrtf(sum4(a) * invn + 1e-6f); }
__device__ __forceinline__ float fq_sum(float s) { return add_xor32(add_xor16(s)); }

#define PG8_EPI_BAR() do { asm volatile("s_waitcnt lgkmcnt(0)" ::: "memory"); __builtin_amdgcn_s_barrier(); asm volatile("" ::: "memory"); } while (0)
typedef float f32x2 __attribute__((ext_vector_type(2)));
typedef unsigned u32x2 __attribute__((ext_vector_type(2)));
__device__ __forceinline__ void rstd8(float (&rs)[2][4], const float* part, int row0, float invn) {
    f32x4 t[2][4];
#pragma unroll
    for (int ai = 0; ai < 2; ++ai)
#pragma unroll
        for (int m = 0; m < 4; ++m) t[ai][m] = *(const f32x4*)(part + (size_t)(row0 + ai * HALF + m * 16) * 4);
#pragma unroll
    for (int ai = 0; ai < 2; ++ai)
#pragma unroll
        for (int m = 0; m < 4; ++m) rs[ai][m] = rsqrtf(sum4(t[ai][m]) * invn + 1e-6f);
}
struct EpiMlpIn { static constexpr bool PERM = true, AFTER_DRAIN = false; static constexpr int MIDK = 0;
    unsigned char* ws;
    __device__ __forceinline__ void operator()(const f32x4 (&acc)[2][2][4][2], const Unit& u, int wr, int wc, int fr, int fq) const {
        unsigned char* wsl; { unsigned long long w_ = (unsigned long long)ws; asm volatile("" : "+s"(w_)); wsl = (unsigned char*)(__attribute__((address_space(1))) unsigned char*)w_; }
        const float* ssqx = (const float*)(wsl + WS_SSQX); bf16_t* H = (bf16_t*)(wsl + WS_H);
        const int row0 = u.pm * BM + wr * 64 + fr, col0 = u.pn * BM + wc * 32 + 8 * fq;
        float rs[2][4]; rstd8(rs, ssqx, row0, 1.f / 1024.f);
#pragma unroll
        for (int ai = 0; ai < 2; ++ai)
#pragma unroll
            for (int m = 0; m < 4; ++m) { bf16_t* rowp = H + (size_t)(row0 + ai * HALF + m * 16) * 4096 + col0;
#pragma unroll
                for (int bj = 0; bj < 2; ++bj) { f32x4 v0 = acc[ai][bj][m][0] * rs[ai][m], v1 = acc[ai][bj][m][1] * rs[ai][m];
#pragma unroll
                    for (int i = 0; i < 4; ++i) { const float a = fmaxf(v0[i], 0.f), b = fmaxf(v1[i], 0.f); v0[i] = a * a; v1[i] = b * b; }
                    *(u32x4*)(rowp + bj * HALF) = pack8(v0, v1); } }
    }
};
template <int MIDK_> struct EpiRes { static constexpr bool PERM = true, AFTER_DRAIN = false; static constexpr int MIDK = MIDK_;
    unsigned char* ws; const float* xf; float* outf; PG8_LAS float* xch;
    __device__ __forceinline__ void midk(f32x4 (&acc)[2][2][4][2], const Unit& u, int wr, int fr) const {
        unsigned char* wsl; { unsigned long long w_ = (unsigned long long)ws; asm volatile("" : "+s"(w_)); wsl = (unsigned char*)(__attribute__((address_space(1))) unsigned char*)w_; }
        const float* ssqa = (const float*)(wsl + WS_SSQA);
#pragma unroll
        for (int ai = 0; ai < 2; ++ai)
#pragma unroll
            for (int mp = 0; mp < 2; ++mp) { f32x4 a[2], b[2];
#pragma unroll
                for (int k = 0; k < 2; ++k) { const float* q = ssqa + (size_t)(u.pm * BM + ai * HALF + wr * 64 + (2 * mp + k) * 16 + fr) * 8; a[k] = *(const f32x4*)q; b[k] = *(const f32x4*)(q + 4); }
#pragma unroll
                for (int k = 0; k < 2; ++k) { const float rs = rsqrtf((sum4(a[k]) + (b[k][0] + b[k][1])) * (1.f / 768.f) + 1e-6f);
#pragma unroll
                    for (int bj = 0; bj < 2; ++bj)
#pragma unroll
                        for (int n = 0; n < 2; ++n) acc[ai][bj][2 * mp + k][n] *= rs; }
                asm volatile("" ::: "memory"); }
    }
    __device__ __forceinline__ void operator()(const f32x4 (&acc)[2][2][4][2], const Unit& u, int wr, int wc, int fr, int fq) const {
        const int row0 = u.pm * BM + wr * 64 + fr, col0 = u.pn * BM + wc * 32 + 8 * fq;
        unsigned char* wsl; { unsigned long long w_ = (unsigned long long)ws; asm volatile("" : "+s"(w_)); wsl = (unsigned char*)(__attribute__((address_space(1))) unsigned char*)w_; }
        bf16_t* XB = (bf16_t*)(wsl + WS_XB); float* ssqx = (float*)(wsl + WS_SSQX);
        PG8_LAS float* xw = xch + (wr * 64 + fr) * 4 + wc; asm volatile("" : "+v"(xw));
#pragma unroll
        for (int ai = 0; ai < 2; ++ai) { f32x4 pre[4][2][2];
            if (xf) {
#pragma unroll
                for (int m = 0; m < 4; ++m)
#pragma unroll
                    for (int bj = 0; bj < 2; ++bj) { const float* q = xf + (size_t)(row0 + ai * HALF + m * 16) * 1024 + col0 + bj * HALF; pre[m][bj][0] = *(const f32x4*)q; pre[m][bj][1] = *(const f32x4*)(q + 4); }
            } else { u32x4 pb[4][2];
#pragma unroll
                for (int m = 0; m < 4; ++m)
#pragma unroll
                    for (int bj = 0; bj < 2; ++bj) pb[m][bj] = *(const u32x4*)(XB + (size_t)(row0 + ai * HALF + m * 16) * 1024 + col0 + bj * HALF);
#pragma unroll
                for (int m = 0; m < 4; ++m)
#pragma unroll
                    for (int bj = 0; bj < 2; ++bj) { const u32x4 w = pb[m][bj];
                        pre[m][bj][0] = (f32x4){__builtin_bit_cast(float, w.x << 16), __builtin_bit_cast(float, w.x & 0xffff0000u), __builtin_bit_cast(float, w.y << 16), __builtin_bit_cast(float, w.y & 0xffff0000u)};
                        pre[m][bj][1] = (f32x4){__builtin_bit_cast(float, w.z << 16), __builtin_bit_cast(float, w.z & 0xffff0000u), __builtin_bit_cast(float, w.w << 16), __builtin_bit_cast(float, w.w & 0xffff0000u)}; }
            }
#pragma unroll
            for (int m = 0; m < 4; ++m) { float s = 0.f;
#pragma unroll
                for (int bj = 0; bj < 2; ++bj) { const size_t off = (size_t)(row0 + ai * HALF + m * 16) * 1024 + col0 + bj * HALF;
                    const f32x4 o0 = pre[m][bj][0] + acc[ai][bj][m][0], o1 = pre[m][bj][1] + acc[ai][bj][m][1];
                    if (outf) { *(f32x4*)(outf + off) = o0; *(f32x4*)(outf + off + 4) = o1; }
                    else { *(u32x4*)(XB + off) = pack8(o0, o1); s += ssq4(o0) + ssq4(o1); } }
                if (!outf) { s = fq_sum(s); if (fq == 0) xw[(ai * HALF + m * 16) * 4] = s; } }
            asm volatile("" ::: "memory"); }
        if (!outf) {
            PG8_EPI_BAR();
            const int t = (wr * 4 + wc) * 64 + fq * 16 + fr;
            if (t < 256) { const f32x4 pz = *(const PG8_LAS f32x4*)(xch + t * 4); ssqx[(size_t)(u.pm * BM + t) * 4 + u.pn] = sum4(pz); }
        }
    }
};
struct EpiIn { static constexpr bool PERM = true, AFTER_DRAIN = false; static constexpr int MIDK = 0;
    unsigned char* ws; const float* gk;
    __device__ __forceinline__ void operator()(const f32x4 (&acc)[2][2][4][2], const Unit& u, int wr, int wc, int fr, int fq) const {
        unsigned char* wsl; { unsigned long long w_ = (unsigned long long)ws; asm volatile("" : "+s"(w_)); wsl = (unsigned char*)(__attribute__((address_space(1))) unsigned char*)w_; }
        const float* ssqx = (const float*)(wsl + WS_SSQX); bf16_t *UT = (bf16_t*)(wsl + WS_UT), *CQ = (bf16_t*)(wsl + WS_CQ), *CKV = (bf16_t*)(wsl + WS_CKV), *KPER = (bf16_t*)(wsl + WS_KPE);
        float *ssqcq = (float*)(wsl + WS_SSQCQ), *ssqckv = (float*)(wsl + WS_SSQCKV), *ssqpe = (float*)(wsl + WS_SSQPE); const float* rope = (const float*)(wsl + WS_ROPE);
        const int row0 = u.pm * BM + wr * 64 + fr, c0 = wc * 32 + 8 * fq, pn = u.pn;
        float rs8[2][4]; rstd8(rs8, ssqx, row0, 1.f / 1024.f);
#pragma unroll
        for (int ai = 0; ai < 2; ++ai)
#pragma unroll
            for (int m = 0; m < 4; ++m) { const int row = row0 + ai * HALF + m * 16; const float rs = rs8[ai][m];
                if (pn == 0) { const int b = row >> 11, s = row & 2047; bf16_t* base = UT + ((size_t)(b * 256 + c0)) * 2048 + s;
#pragma unroll
                    for (int bj = 0; bj < 2; ++bj)
#pragma unroll
                        for (int n = 0; n < 2; ++n)
#pragma unroll
                            for (int i = 0; i < 4; ++i) base[(size_t)(bj * HALF + 4 * n + i) * 2048] = (bf16_t)(cvt_pk_bf16(acc[ai][bj][m][n][i] * rs, 0.f) & 0xffffu);
                } else if (pn < 3) { bf16_t* dst = (pn == 1 ? CQ : CKV) + (size_t)row * 256 + c0; float s = 0.f;
#pragma unroll
                    for (int bj = 0; bj < 2; ++bj) { const f32x4 v0 = acc[ai][bj][m][0] * rs, v1 = acc[ai][bj][m][1] * rs; *(u32x4*)(dst + bj * HALF) = pack8(v0, v1); s += ssq4(v0) + ssq4(v1); }
                    s = fq_sum(s); if (fq == 0) (pn == 1 ? ssqcq : ssqckv)[(size_t)row * 4 + wc] = s;
                } else if (wc < 2) { const int j = 16 * wc + 4 * fq; const f32x4 v0 = acc[ai][0][m][0] * rs, v1 = acc[ai][0][m][1] * rs;
                    const f32x4 x1 = v0 * *(const f32x4*)(gk + 128 + j), x2 = v1 * *(const f32x4*)(gk + 160 + j);
                    const f32x4 cs = *(const f32x4*)(rope + (size_t)row * 64 + j), sn = *(const f32x4*)(rope + (size_t)row * 64 + 32 + j);
                    const f32x4 o1 = x1 * cs - x2 * sn, o2 = x2 * cs + x1 * sn;
                    *(u32x2*)(KPER + (size_t)row * 64 + j) = (u32x2){cvt_pk_bf16(o1[0], o1[1]), cvt_pk_bf16(o1[2], o1[3])};
                    *(u32x2*)(KPER + (size_t)row * 64 + 32 + j) = (u32x2){cvt_pk_bf16(o2[0], o2[1]), cvt_pk_bf16(o2[2], o2[3])};
                    float s = fq_sum(ssq4(v0) + ssq4(v1)); if (fq == 0) ssqpe[(size_t)row * 2 + wc] = s; } }
    }
};
struct EpiDft { static constexpr bool PERM = true, AFTER_DRAIN = false; static constexpr int MIDK = 0;
    unsigned char* ws;
    __device__ __forceinline__ void operator()(const f32x4 (&acc)[2][2][4][2], const Unit& u, int wr, int wc, int fr, int fq) const {
        unsigned char* wsl; { unsigned long long w_ = (unsigned long long)ws; asm volatile("" : "+s"(w_)); wsl = (unsigned char*)(__attribute__((address_space(1))) unsigned char*)w_; }
        bf16_t* PQ = (bf16_t*)(wsl + WS_PQ);
        const int pq = u.pm >> 3, sp0 = (u.pm & 7) * 256 + wr * 64 + fr, b = u.pn;
#pragma unroll
        for (int ai = 0; ai < 2; ++ai)
#pragma unroll
            for (int m = 0; m < 4; ++m) { bf16_t* rowp = PQ + ((size_t)(b * 2048 + sp0 + ai * HALF + m * 16)) * 512 + pq * 256 + wc * 32 + 8 * fq;
#pragma unroll
                for (int bj = 0; bj < 2; ++bj) *(u32x4*)(rowp + bj * HALF) = pack8(acc[ai][bj][m][0], acc[ai][bj][m][1]); }
    }
};
struct EpiQ { static constexpr bool PERM = true, AFTER_DRAIN = false; static constexpr int MIDK = 0;
    unsigned char* ws;
    __device__ __forceinline__ void operator()(const f32x4 (&acc)[2][2][4][2], const Unit& u, int wr, int wc, int fr, int fq) const {
        unsigned char* wsl; { unsigned long long w_ = (unsigned long long)ws; asm volatile("" : "+s"(w_)); wsl = (unsigned char*)(__attribute__((address_space(1))) unsigned char*)w_; }
        const float* ssqcq = (const float*)(wsl + WS_SSQCQ); bf16_t* Q = (bf16_t*)(wsl + WS_Q);
        const int row0 = u.pm * BM + wr * 64 + fr, col0 = u.pn * BM + wc * 32 + 8 * fq;
        float rs[2][4]; rstd8(rs, ssqcq, row0, 1.f / 256.f);
#pragma unroll
        for (int ai = 0; ai < 2; ++ai)
#pragma unroll
            for (int m = 0; m < 4; ++m) { bf16_t* rowp = Q + (size_t)(row0 + ai * HALF + m * 16) * 1152 + col0;
#pragma unroll
                for (int bj = 0; bj < 2; ++bj) if (col0 + bj * HALF < 1152) *(u32x4*)(rowp + bj * HALF) = pack8(acc[ai][bj][m][0] * rs[ai][m], acc[ai][bj][m][1] * rs[ai][m]); }
    }
};
struct EpiKV { static constexpr bool PERM = true, AFTER_DRAIN = false; static constexpr int MIDK = 0;
    unsigned char* ws; const float* gk; PG8_LAS float* xch;
    __device__ __forceinline__ void operator()(const f32x4 (&acc)[2][2][4][2], const Unit& u, int wr, int wc, int fr, int fq) const {
        unsigned char* wsl; { unsigned long long w_ = (unsigned long long)ws; asm volatile("" : "+s"(w_)); wsl = (unsigned char*)(__attribute__((address_space(1))) unsigned char*)w_; }
        const float *ssqckv = (const float*)(wsl + WS_SSQCKV), *ssqpe = (const float*)(wsl + WS_SSQPE); const bf16_t* KPER = (const bf16_t*)(wsl + WS_KPE); bf16_t *K = (bf16_t*)(wsl + WS_K), *V = (bf16_t*)(wsl + WS_V);
        const int h = u.pn, row0 = u.pm * BM + wr * 64 + fr, c0 = wc * 32 + 8 * fq, j4 = 4 * (4 * wc + fq);
        float rck[2][4]; rstd8(rck, ssqckv, row0, 1.f / 256.f);
        PG8_LAS float* xw = xch + (wr * 64 + fr) * 4 + wc; asm volatile("" : "+v"(xw));
        f32x2 pe2[2][4]; u32x2 kp[2][4];
#pragma unroll
        for (int ai = 0; ai < 2; ++ai)
#pragma unroll
            for (int m = 0; m < 4; ++m) { const int row = row0 + ai * HALF + m * 16; pe2[ai][m] = *(const f32x2*)(ssqpe + (size_t)row * 2); kp[ai][m] = *(const u32x2*)(KPER + (size_t)row * 64 + j4);
                const f32x4 v0 = acc[ai][0][m][0] * rck[ai][m], v1 = acc[ai][0][m][1] * rck[ai][m]; const float s = fq_sum(ssq4(v0) + ssq4(v1));
                if (fq == 0) xw[(ai * HALF + m * 16) * 4] = s; }
        const f32x4 g0 = *(const f32x4*)(gk + c0), g1 = *(const f32x4*)(gk + c0 + 4);
        PG8_EPI_BAR();
        const PG8_LAS float* xr = xw - wc;
#pragma unroll
        for (int ai = 0; ai < 2; ++ai)
#pragma unroll
            for (int m = 0; m < 4; ++m) { const int row = row0 + ai * HALF + m * 16;
                const f32x4 part = *(const PG8_LAS f32x4*)(xr + (ai * HALF + m * 16) * 4);
                const float rc = rck[ai][m], rk = rsqrtf((sum4(part) + (pe2[ai][m][0] + pe2[ai][m][1])) * (1.f / 192.f) + 1e-6f), rr = rc * rk;
                *(u32x4*)(K + (size_t)row * 1152 + h * 192 + c0) = pack8(acc[ai][0][m][0] * rr * g0, acc[ai][0][m][1] * rr * g1);
                *(u32x4*)(V + (size_t)row * 768 + h * 128 + c0) = pack8(acc[ai][1][m][0] * rc, acc[ai][1][m][1] * rc);
                const unsigned a = kp[ai][m][0], b = kp[ai][m][1];
                *(u32x2*)(K + (size_t)row * 1152 + h * 192 + 128 + j4) = (u32x2){cvt_pk_bf16(__builtin_bit_cast(float, a << 16) * rk, __builtin_bit_cast(float, a & 0xffff0000u) * rk),
                                                                               cvt_pk_bf16(__builtin_bit_cast(float, b << 16) * rk, __builtin_bit_cast(float, b & 0xffff0000u) * rk)}; }
    }
};
struct EpiY { static constexpr bool PERM = true, AFTER_DRAIN = false; static constexpr int MIDK = 0;
    unsigned char* ws; PG8_LAS float* xch;
    __device__ __forceinline__ void operator()(const f32x4 (&acc)[2][2][4][2], const Unit& u, int wr, int wc, int fr, int fq) const {
        unsigned char* wsl; { unsigned long long w_ = (unsigned long long)ws; asm volatile("" : "+s"(w_)); wsl = (unsigned char*)(__attribute__((address_space(1))) unsigned char*)w_; }
        bf16_t* MIX = (bf16_t*)(wsl + WS_MIX);
        const int row0 = u.pm * BM + wr * 64 + fr, c0 = wc * 32 + 8 * fq;
        PG8_LAS float* xw = xch + (wr * 64 + fr) * 4 + wc; asm volatile("" : "+v"(xw));
#pragma unroll
        for (int ai = 0; ai < 2; ++ai)
#pragma unroll
            for (int m = 0; m < 4; ++m) { float s = 0.f;
#pragma unroll
                for (int bj = 0; bj < 2; ++bj) s += ssq4(acc[ai][bj][m][0]) + ssq4(acc[ai][bj][m][1]);
                s = fq_sum(s); if (fq == 0) xw[(ai * HALF + m * 16) * 4] = s; }
        PG8_EPI_BAR();
        const PG8_LAS float* xr = xw - wc;
#pragma unroll
        for (int ai = 0; ai < 2; ++ai)
#pragma unroll
            for (int m = 0; m < 4; ++m) { const int row = row0 + ai * HALF + m * 16;
                const f32x4 part = *(const PG8_LAS f32x4*)(xr + (ai * HALF + m * 16) * 4); const float rf = rsqrtf(sum4(part) * (1.f / 256.f) + 1e-6f);
                bf16_t* rowp = MIX + (size_t)row * 1024 + 768 + c0;
#pragma unroll
                for (int bj = 0; bj < 2; ++bj) *(u32x4*)(rowp + bj * HALF) = pack8(acc[ai][bj][m][0] * rf, acc[ai][bj][m][1] * rf); }
    }
};
}

namespace att {
using f32x16 = __attribute__((ext_vector_type(16))) float;
using s16x4 = __attribute__((ext_vector_type(4))) short;
constexpr int NW = 8, QBLK = 32, KVBLK = 64, LDQ = 1152, LDK = 1152, LDV = 768;
constexpr int SHM_V = KVBLK * 128 * 2, SHM_K = KVBLK * 192 * 2;
constexpr int OFF_K = 0, OFF_V = 3 * SHM_K, OFF_WS = OFF_V + 3 * SHM_V, ATT_LDS = OFF_WS + NW * 64 * 4;
constexpr float THR = 8.f;
#define SBAR() __builtin_amdgcn_sched_barrier(0)
__device__ __forceinline__ int crow(int r, int hi) { return (r & 3) + 8 * (r >> 2) + 4 * hi; }
__device__ __forceinline__ unsigned cvtpk(float lo, float hi) { unsigned r; asm volatile("v_cvt_pk_bf16_f32 %0, %1, %2" : "=v"(r) : "v"(lo), "v"(hi)); return r; }

__device__ __forceinline__ void partialSM(f32x16& p0, f32x16& p1, float& m_reg, float& mn, float& alpha) {
  float pmax = p0[0];
#pragma unroll
  for (int r = 1; r < 16; ++r) pmax = fmaxf(pmax, p0[r]);
#pragma unroll
  for (int r = 0; r < 16; ++r) pmax = fmaxf(pmax, p1[r]);
  { auto rr = __builtin_amdgcn_permlane32_swap(__float_as_uint(pmax), __float_as_uint(pmax), false, false);
    pmax = fmaxf(__uint_as_float(rr[0]), __uint_as_float(rr[1])); }
  if (__builtin_expect(__all(pmax - m_reg <= THR), 1)) { mn = m_reg; alpha = 1.f; }
  else { mn = fmaxf(m_reg, pmax); alpha = __builtin_amdgcn_exp2f(m_reg - mn); m_reg = mn; }
#pragma unroll
  for (int r = 0; r < 16; ++r) p0[r] = p0[r] - mn;
#pragma unroll
  for (int r = 0; r < 16; ++r) p1[r] = p1[r] - mn;
#pragma unroll
  for (int r = 0; r < 16; ++r) p0[r] = __builtin_amdgcn_exp2f(p0[r]);
}
__device__ __forceinline__ void finishSM(f32x16& p0, f32x16& p1, float alpha, float& l_reg, bf16x8& pa0, bf16x8& pa1, bf16x8& pa2, bf16x8& pa3) {
#pragma unroll
  for (int r = 0; r < 16; ++r) p1[r] = __builtin_amdgcn_exp2f(p1[r]);
  float ps = 0;
#pragma unroll
  for (int r = 0; r < 16; ++r) ps += p0[r];
#pragma unroll
  for (int r = 0; r < 16; ++r) ps += p1[r];
  { auto rr = __builtin_amdgcn_permlane32_swap(__float_as_uint(ps), __float_as_uint(ps), false, false);
    ps = __uint_as_float(rr[0]) + __uint_as_float(rr[1]); }
  l_reg = l_reg * alpha + ps;
#define PK4(P, BASE, OUT) do { unsigned a0 = cvtpk(P[BASE + 0], P[BASE + 1]), a1 = cvtpk(P[BASE + 2], P[BASE + 3]);   \
    unsigned b0 = cvtpk(P[BASE + 4], P[BASE + 5]), b1 = cvtpk(P[BASE + 6], P[BASE + 7]);                              \
    auto r0 = __builtin_amdgcn_permlane32_swap(a0, b0, false, false); auto r1 = __builtin_amdgcn_permlane32_swap(a1, b1, false, false); \
    u32x4 w = {r0[0], r1[0], r0[1], r1[1]}; OUT = *reinterpret_cast<bf16x8*>(&w); } while (0)
  PK4(p0, 0, pa0); PK4(p0, 8, pa1); PK4(p1, 0, pa2); PK4(p1, 8, pa3);
#undef PK4
}
__device__ __forceinline__ void qkt(f32x16& p0, f32x16& p1, const LAS char* Ks, const bf16x8* qr, int kb0, int kb1, int kb2, int kb3) {
  p0 = f32x16{}; p1 = f32x16{};
  const LAS char* k0 = Ks + kb0; const LAS char* k1 = Ks + kb1; const LAS char* k2 = Ks + kb2; const LAS char* k3 = Ks + kb3;
  bf16x8 fa[4], fb[4];
#define QK_LD(F, g) do { F[0] = *(const LAS bf16x8*)((((2 * (g)) & 3) == 0 ? k0 : k2) + ((2 * (g)) >> 2) * 8192); F[1] = *(const LAS bf16x8*)((((2 * (g)) & 3) == 0 ? k0 : k2) + ((2 * (g)) >> 2) * 8192 + 4096); \
    F[2] = *(const LAS bf16x8*)((((2 * (g)) & 3) == 0 ? k1 : k3) + ((2 * (g)) >> 2) * 8192); F[3] = *(const LAS bf16x8*)((((2 * (g)) & 3) == 0 ? k1 : k3) + ((2 * (g)) >> 2) * 8192 + 4096); } while (0)
#define QK_MM(F, g) do { p0 = __builtin_amdgcn_mfma_f32_32x32x16_bf16(F[0], qr[2 * (g)], p0, 0, 0, 0); p1 = __builtin_amdgcn_mfma_f32_32x32x16_bf16(F[1], qr[2 * (g)], p1, 0, 0, 0); \
    p0 = __builtin_amdgcn_mfma_f32_32x32x16_bf16(F[2], qr[2 * (g) + 1], p0, 0, 0, 0); p1 = __builtin_amdgcn_mfma_f32_32x32x16_bf16(F[3], qr[2 * (g) + 1], p1, 0, 0, 0); } while (0)
  QK_LD(fa, 0); SBAR();
  QK_LD(fb, 1); SBAR(); QK_MM(fa, 0); SBAR();
  QK_LD(fa, 2); SBAR(); QK_MM(fb, 1); SBAR();
  QK_LD(fb, 3); SBAR(); QK_MM(fa, 2); SBAR();
  QK_LD(fa, 4); SBAR(); QK_MM(fb, 3); SBAR();
  QK_LD(fb, 5); SBAR(); QK_MM(fa, 4); SBAR();
  QK_MM(fb, 5);
#undef QK_LD
#undef QK_MM
}
__device__ __forceinline__ int v_rd_base(int lane) { return ((lane & 3) << 3) | (((lane >> 2) & 3) << 6) | (((lane >> 4) & 1) << 5) | (((lane >> 5) & 1) << 8); }
constexpr int v_rd_off(int d0, int ks, int half) { return d0 * 512 + ks * 4096 + half * 2048; }
template <int OFF> __device__ __forceinline__ s16x4 tr_read(int vb) {
  s16x4 r; asm volatile("ds_read_b64_tr_b16 %0, %1 offset:%2" : "=&v"(r) : "v"(vb), "i"(OFF) : "memory"); return r;
}
template <int D0> __device__ __forceinline__ void pv_one(f32x16& od, int vb, bf16x8 pa0, bf16x8 pa1, bf16x8 pa2, bf16x8 pa3) {
  const s16x4 l0 = tr_read<v_rd_off(D0, 0, 0)>(vb), h0 = tr_read<v_rd_off(D0, 0, 1)>(vb), l1 = tr_read<v_rd_off(D0, 1, 0)>(vb), h1 = tr_read<v_rd_off(D0, 1, 1)>(vb);
  const s16x4 l2 = tr_read<v_rd_off(D0, 2, 0)>(vb), h2 = tr_read<v_rd_off(D0, 2, 1)>(vb), l3 = tr_read<v_rd_off(D0, 3, 0)>(vb), h3 = tr_read<v_rd_off(D0, 3, 1)>(vb);
  asm volatile("s_waitcnt lgkmcnt(0)" ::: "memory"); SBAR();
#define PK(L, H) (bf16x8){L[0], L[1], L[2], L[3], H[0], H[1], H[2], H[3]}
  od = __builtin_amdgcn_mfma_f32_32x32x16_bf16(pa0, PK(l0, h0), od, 0, 0, 0);
  od = __builtin_amdgcn_mfma_f32_32x32x16_bf16(pa1, PK(l1, h1), od, 0, 0, 0);
  od = __builtin_amdgcn_mfma_f32_32x32x16_bf16(pa2, PK(l2, h2), od, 0, 0, 0);
  od = __builtin_amdgcn_mfma_f32_32x32x16_bf16(pa3, PK(l3, h3), od, 0, 0, 0);
#undef PK
}
__device__ __forceinline__ void pv_d0(f32x16* o, int vb, bf16x8 pa0, bf16x8 pa1, bf16x8 pa2, bf16x8 pa3) {
  pv_one<0>(o[0], vb, pa0, pa1, pa2, pa3); pv_one<1>(o[1], vb, pa0, pa1, pa2, pa3); pv_one<2>(o[2], vb, pa0, pa1, pa2, pa3); pv_one<3>(o[3], vb, pa0, pa1, pa2, pa3);
}

template <int VAR> __device__ __forceinline__ void attn_unit(const bf16_t* __restrict__ Qb, const bf16_t* __restrict__ Kh, const bf16_t* __restrict__ Vh, bf16_t* __restrict__ Ob, float* __restrict__ ssq,
                                          const float* __restrict__ gq, const float* __restrict__ rope, LAS char* lds, const int tid) {
  const int wid = __builtin_amdgcn_readfirstlane(tid >> 6), lane = tid & 63, r32 = lane & 31, hi = lane >> 5;
  LAS char* V_lds = lds + OFF_V; LAS char* K_lds = lds + OFF_K;
  LAS float* wsf = (LAS float*)(lds + OFF_WS) + wid * 64; LAS float* li_l = wsf; LAS float* al_l = wsf + 32;
  float m_reg = -1e30f, l_reg = 0; f32x16 o[4] = {}; bf16x8 qr[12];
  const bf16_t* ksrc; const bf16_t* vsrc0; const bf16_t* vsrc1;
  { const int key = wid * 8 + (lane >> 3), c3 = (lane & 7) ^ ((key >> 1) & 7); ksrc = Kh + (long)key * LDK + c3 * 8;
    const int q4 = (lane & 31) >> 2, cc = 32 * (lane >> 5) + 8 * (lane & 3);
    { const int p = wid, kk = 8 * (p >> 1) + q4, key2 = (kk & ~0xC) | ((kk & 4) << 1) | ((kk & 8) >> 1); vsrc0 = Vh + (long)key2 * LDV + 64 * (p & 1) + cc; }
    { const int p = wid + 8, kk = 8 * (p >> 1) + q4, key2 = (kk & ~0xC) | ((kk & 4) << 1) | ((kk & 8) >> 1); vsrc1 = Vh + (long)key2 * LDV + 64 * (p & 1) + cc; } }
#define GLDS(gp, ldsoff) __builtin_amdgcn_global_load_lds((const unsigned*)(gp), (LAS unsigned*)(lds + (ldsoff)), 16, 0, 0)
#define DMA_K(t, slot) do { const bf16_t* g_ = ksrc + (long)(t) * (KVBLK * LDK); const int o_ = OFF_K + (slot) * SHM_K + wid * 1024; \
    GLDS(g_, o_); GLDS(g_ + 64, o_ + 8192); GLDS(g_ + 128, o_ + 16384); } while (0)
#define DMA_V(t, slot) do { const int o_ = OFF_V + (slot) * SHM_V + wid * 1024; GLDS(vsrc0 + (long)(t) * (KVBLK * LDV), o_); GLDS(vsrc1 + (long)(t) * (KVBLK * LDV), o_ + 8192); } while (0)
#define WAIT_BAR(N) asm volatile("s_waitcnt vmcnt(" #N ") lgkmcnt(0)\n\ts_barrier" ::: "memory")
  DMA_K(0, 0); DMA_V(0, 0); DMA_K(1, 1);
  {
    const bf16_t* Qw = Qb + (long)(wid * QBLK + r32) * LDQ + hi * 8;
    bf16x8 raw[12]; float ss = 0.f;
#pragma unroll
    for (int d0 = 0; d0 < 12; ++d0) raw[d0] = *reinterpret_cast<const bf16x8*>(Qw + d0 * 16);
#pragma unroll
    for (int d0 = 0; d0 < 12; ++d0)
#pragma unroll
      for (int j = 0; j < 8; ++j) { const float v = bf2f((bf16_t)raw[d0][j]); ss += v * v; }
    ss = add_xor32(ss);
    const float rq = rsqrtf(ss * (1.f / 192.f) + EPS) * QSCALE;
    const float* rp = rope + (long)(wid * QBLK + r32) * 64 + hi * 8;
#pragma unroll
    for (int d0 = 0; d0 < 8; ++d0) { const f32x4 g0 = *(const f32x4*)(gq + d0 * 16 + hi * 8), g1 = *(const f32x4*)(gq + d0 * 16 + hi * 8 + 4); float v[8];
#pragma unroll
      for (int j = 0; j < 8; ++j) v[j] = bf2f((bf16_t)raw[d0][j]) * rq * (j < 4 ? g0[j] : g1[j - 4]);
      u32x4 w = {cvtpk(v[0], v[1]), cvtpk(v[2], v[3]), cvtpk(v[4], v[5]), cvtpk(v[6], v[7])}; qr[d0] = *reinterpret_cast<bf16x8*>(&w);
      if (d0 & 1) asm volatile("" ::: "memory"); }
#pragma unroll
    for (int dd = 0; dd < 2; ++dd) {
      const f32x4 ga0 = *(const f32x4*)(gq + 128 + dd * 16 + hi * 8), ga1 = *(const f32x4*)(gq + 128 + dd * 16 + hi * 8 + 4);
      const f32x4 gb0 = *(const f32x4*)(gq + 160 + dd * 16 + hi * 8), gb1 = *(const f32x4*)(gq + 160 + dd * 16 + hi * 8 + 4);
      const f32x4 c0 = *(const f32x4*)(rp + dd * 16), c1 = *(const f32x4*)(rp + dd * 16 + 4), s0 = *(const f32x4*)(rp + 32 + dd * 16), s1 = *(const f32x4*)(rp + 32 + dd * 16 + 4);
      float o1[8], o2[8];
#pragma unroll
      for (int j = 0; j < 8; ++j) { const float x1 = bf2f((bf16_t)raw[8 + dd][j]) * rq * (j < 4 ? ga0[j] : ga1[j - 4]), x2 = bf2f((bf16_t)raw[10 + dd][j]) * rq * (j < 4 ? gb0[j] : gb1[j - 4]);
        const float c = j < 4 ? c0[j] : c1[j - 4], s = j < 4 ? s0[j] : s1[j - 4]; o1[j] = x1 * c - x2 * s; o2[j] = x2 * c + x1 * s; }
      u32x4 w1 = {cvtpk(o1[0], o1[1]), cvtpk(o1[2], o1[3]), cvtpk(o1[4], o1[5]), cvtpk(o1[6], o1[7])}; qr[8 + dd] = *reinterpret_cast<bf16x8*>(&w1);
      u32x4 w2 = {cvtpk(o2[0], o2[1]), cvtpk(o2[2], o2[3]), cvtpk(o2[4], o2[5]), cvtpk(o2[6], o2[7])}; qr[10 + dd] = *reinterpret_cast<bf16x8*>(&w2);
      asm volatile("" ::: "memory");
    }
  }
  int t1 = tid; asm volatile("" : "+v"(t1));
  const int vb0 = (int)(unsigned)(size_t)V_lds + v_rd_base(t1 & 63);
  const int kg_ = ((t1 & 31) >> 1) & 7, kr_ = (t1 & 31) * 128, kh_ = (t1 >> 5) & 1;
  const int kb0 = kr_ + (((0 + kh_) ^ kg_) << 4), kb1 = kr_ + (((2 + kh_) ^ kg_) << 4), kb2 = kr_ + (((4 + kh_) ^ kg_) << 4), kb3 = kr_ + (((6 + kh_) ^ kg_) << 4);
#define RESC(a) do { if (__any((a) < 1.f)) { if (hi == 0) al_l[r32] = (a); asm volatile("s_waitcnt lgkmcnt(0)" ::: "memory"); \
    _Pragma("unroll") for (int d = 0; d < 4; ++d) _Pragma("unroll") for (int r = 0; r < 16; ++r) o[d][r] *= al_l[crow(r, hi)]; } } while (0)
  f32x16 p0, p1; float mn, al; bf16x8 pa0, pa1, pa2, pa3; constexpr int NT = SEQ / KVBLK;
  const int grp = wid >> 2;
#define BAR_ONLY() asm volatile("s_waitcnt lgkmcnt(0)\n\ts_barrier" ::: "memory")
  WAIT_BAR(0);
  if (grp == 1) BAR_ONLY();
  __builtin_amdgcn_s_setprio(1); qkt(p0, p1, K_lds, qr, kb0, kb1, kb2, kb3); __builtin_amdgcn_s_setprio(0);
#define KEEP16(x) asm volatile("" : "+v"(x))
  BAR_ONLY();
  DMA_K(2, 2); DMA_V(1, 1);
  partialSM(p0, p1, m_reg, mn, al); finishSM(p0, p1, al, l_reg, pa0, pa1, pa2, pa3);
  int sk = 1, sv = 0;
#define NEXT3(x) ((x) == 2 ? 0 : (x) + 1)
#define PREV3(x) ((x) == 0 ? 2 : (x) - 1)
  for (int j = 0; j < NT - 1; ++j) {
    BAR_ONLY();
    SBAR(); __builtin_amdgcn_s_setprio(1);
    if (VAR != 2 && VAR != 3 && VAR != 5) qkt(p0, p1, K_lds + sk * SHM_K, qr, kb0, kb1, kb2, kb3); else { KEEP16(p0); KEEP16(p1); }
    if (VAR != 2 && VAR != 3 && VAR != 4) pv_d0(o, vb0 + sv * SHM_V, pa0, pa1, pa2, pa3); else { KEEP16(o[0]); KEEP16(o[1]); KEEP16(o[2]); KEEP16(o[3]); }
    __builtin_amdgcn_s_setprio(0); SBAR();
    WAIT_BAR(0);
    if (j + 3 < NT) DMA_K(j + 3, PREV3(sk));
    if (j + 2 < NT) DMA_V(j + 2, PREV3(sv));
    if (VAR != 1 && VAR != 3) { partialSM(p0, p1, m_reg, mn, al); RESC(al); finishSM(p0, p1, al, l_reg, pa0, pa1, pa2, pa3); } else { KEEP16(p0); KEEP16(p1); asm volatile("" : "+v"(pa0), "+v"(pa1), "+v"(pa2), "+v"(pa3)); }
    sk = NEXT3(sk); sv = NEXT3(sv);
  }
  BAR_ONLY();
  SBAR(); pv_d0(o, vb0 + sv * SHM_V, pa0, pa1, pa2, pa3);
  if (grp == 0) BAR_ONLY();
  if (hi == 0) li_l[r32] = l_reg;
  asm volatile("s_waitcnt lgkmcnt(0)\n\ts_barrier" ::: "memory");
  { int t2 = tid; asm volatile("" : "+v"(t2));
  const int wid = t2 >> 6, lane = t2 & 63, r32 = lane & 31, hi = lane >> 5;
  LAS float* li_l = (LAS float*)(lds + OFF_WS) + wid * 64;
  LAS bf16_t* stg = (LAS bf16_t*)(lds + wid * 8192);
#pragma unroll
  for (int r = 0; r < 16; ++r) { const int orow = crow(r, hi); const float rl = __builtin_amdgcn_rcpf(li_l[orow]);
#pragma unroll
    for (int d0 = 0; d0 < 4; ++d0) stg[orow * 128 + d0 * 32 + r32] = (bf16_t)(cvtpk(o[d0][r] * rl, 0.f) & 0xffffu); }
  asm volatile("s_waitcnt lgkmcnt(0)" ::: "memory");
  { const int row = lane >> 1, half = lane & 1; const LAS u32x4* src = (const LAS u32x4*)(stg + row * 128 + half * 64); float s = 0.f;
    bf16_t* orow = Ob + (long)(wid * QBLK + row) * 1024 + half * 64;
#pragma unroll
    for (int i = 0; i < 8; ++i) { const u32x4 v = src[i]; if (VAR == 0) *(u32x4*)(orow + i * 8) = v; else asm volatile("" :: "v"(v));
#pragma unroll
      for (int e = 0; e < 4; ++e) { const float a = __builtin_bit_cast(float, v[e] << 16), b = __builtin_bit_cast(float, v[e] & 0xffff0000u); s += a * a + b * b; } }
    s = add_xor1(s);
    if (half == 0 && VAR == 0) ssq[(long)(wid * QBLK + row) * 8] = s; if (VAR != 0) asm volatile("" :: "v"(s)); }
  }
  asm volatile("s_waitcnt lgkmcnt(0)\n\ts_barrier" ::: "memory");
#undef GLDS
#undef DMA_K
#undef DMA_V
#undef WAIT_BAR
#undef RESC
#undef BAR_ONLY
#undef KEEP16
#undef NEXT3
#undef PREV3
}
#undef SBAR
}

constexpr int NWAVES = 8, MK_THREADS = NWAVES * 64;
constexpr int MK_LDS = 147456, XCH_OFF = 131072, MISC_OFF = XCH_OFF + 4096, CW_BAR = 4096, CTL_ZERO_BYTES = 65536;

__device__ __forceinline__ void tr_item(const float* W, int K, int N, int koff, const float* g1, const float* g2, int ksplit, bf16_t* WT, LAS float* scr, int item, int lane, int perm_from = 1 << 30) {
    const int nblk = N / 32, kb = item / nblk, nb = item % nblk, k0 = 64 * kb, n0 = 32 * nb;
#pragma unroll 8
    for (int i = 0; i < 32; ++i) {
        const int kk = 2 * i + (lane >> 5), kp = k0 + kk, ks = (kp + koff) & (K - 1);
        const float g = g1 ? (kp < ksplit ? g1[kp] : g2[kp - ksplit]) : 1.f;
        int nc = n0 + (lane & 31); if (nc >= perm_from) { const int c = nc - perm_from; nc = perm_from + ((c >> 2) & 1) * 32 + 16 * (c >> 5) + 4 * ((c >> 3) & 3) + (c & 3); }
        scr[kk * 33 + (lane & 31)] = W[(size_t)ks * N + nc] * g;
    }
    asm volatile("s_waitcnt lgkmcnt(0)" ::: "memory");
    const int c = lane & 7;
#pragma unroll
    for (int j = 0; j < 4; ++j) {
        const int n = (lane >> 3) + 8 * j; const LAS float* s = scr + (8 * c) * 33 + n;
        u32x4 o; o.x = pk2(s[0 * 33], s[1 * 33]); o.y = pk2(s[2 * 33], s[3 * 33]); o.z = pk2(s[4 * 33], s[5 * 33]); o.w = pk2(s[6 * 33], s[7 * 33]);
        *(u32x4*)(WT + (size_t)(n0 + n) * K + k0 + 8 * c) = o;
    }
    asm volatile("s_waitcnt lgkmcnt(0)" ::: "memory");
}

__device__ __forceinline__ void phase_prologue(const Params& p, LAS unsigned char* lds, const int tid) {
    const int lane = tid & 63, wave = tid >> 6;
    const int G = gridDim.x, gw = blockIdx.x * NWAVES + wave, NGW = G * NWAVES;
    const int gt = blockIdx.x * MK_THREADS + tid, NGT = G * MK_THREADS;
    LAS float* tab = (LAS float*)lds;
    LAS float* scr = (LAS float*)(lds + 8192 + wave * 8704);
    for (int j = tid; j < 2048; j += MK_THREADS) tab[j] = cospif((float)j * (1.0f / 1024.0f));
    __syncthreads();
    unsigned char* ws = p.ws;
    {
        constexpr int I_IN = 16 * 26, I_QU = 4 * 36, I_KV = 4 * 48, I_OUT = 16 * 32, I_MI = 16 * 128, I_MO = 64 * 32, I_L = I_IN + I_QU + I_KV + I_OUT + I_MI + I_MO;
        for (int it = gw; it < DEPTH * I_L; it += NGW) {
            const int l = it / I_L; int r = it % I_L; unsigned char* wl = ws + WS_W + (size_t)l * LW;
            if (r < I_IN) { tr_item(karg_in(I_WIN) + (size_t)l * DM * INW, DM, INW, 0, karg_in(I_ANG) + l * DM, nullptr, DM, (bf16_t*)(wl + OW_IN), scr, r, lane, 768); continue; } r -= I_IN;
            if (r < I_QU) { tr_item(karg_in(I_WQUP) + (size_t)l * QL * QUPW, QL, QUPW, 0, karg_in(I_QAG) + l * QL, nullptr, QL, (bf16_t*)(wl + OW_QUP), scr, r, lane); continue; } r -= I_QU;
            if (r < I_KV) { tr_item(karg_in(I_WKVUP) + (size_t)l * KVL * KVUPW, KVL, KVUPW, 0, karg_in(I_KVAG) + l * KVL, nullptr, KVL, (bf16_t*)(wl + OW_KVUP), scr, r, lane); continue; } r -= I_KV;
            if (r < I_OUT) { tr_item(karg_in(I_WOUT) + (size_t)l * DM * DM, DM, DM, FW, karg_in(I_AOG) + l * AW, karg_in(I_FOG) + l * FW, AW, (bf16_t*)(wl + OW_OUT), scr, r, lane); continue; } r -= I_OUT;
            if (r < I_MI) { tr_item(karg_in(I_WMI) + (size_t)l * DM * FF, DM, FF, 0, karg_in(I_MNG) + l * DM, nullptr, DM, (bf16_t*)(wl + OW_MI), scr, r, lane); continue; } r -= I_MI;
            tr_item(karg_in(I_WMO) + (size_t)l * FF * DM, FF, DM, 0, nullptr, nullptr, FF, (bf16_t*)(wl + OW_MO), scr, r, lane);
        }
    }
    {
        constexpr int C_IN = (INWP - INW) * DM / 8, C_QU = (QUPWP - QUPW) * QL / 8, C_L = C_IN + C_QU;
        for (int i = gt; i < DEPTH * C_L; i += NGT) {
            const int l = i / C_L, r = i % C_L; unsigned char* wl = ws + WS_W + (size_t)l * LW;
            u32x4* dst = (r < C_IN) ? (u32x4*)(wl + OW_IN + (size_t)INW * DM * 2) + r : (u32x4*)(wl + OW_QUP + (size_t)QUPW * QL * 2) + (r - C_IN);
            *dst = (u32x4){0u, 0u, 0u, 0u};
        }
    }
    {
        bf16_t* F = (bf16_t*)(ws + WS_F);
        for (int ci = gt; ci < 4096 * 256; ci += NGT) {
            const int r = ci >> 8, s0 = (ci & 255) * 8, pq = r >> 11, sp = r & 2047, sh = pq ? 1536 : 0;
            float v[8];
#pragma unroll
            for (int e = 0; e < 8; ++e) v[e] = tab[(sp * (s0 + e) + sh) & 2047];
            u32x4 o; o.x = pk2(v[0], v[1]); o.y = pk2(v[2], v[3]); o.z = pk2(v[4], v[5]); o.w = pk2(v[6], v[7]);
            *(u32x4*)(F + (size_t)r * 2048 + s0) = o;
        }
    }
    {
        for (int i = gt; i < DEPTH * 256 * 512; i += NGT) {
            const int l = i / (256 * 512), r = i % (256 * 512), n = r >> 9, k = r & 511, g = n >> 6, d = n & 63, pq = k >> 8, g2 = (k >> 6) & 3, c = k & 63;
            float acc = 0.f;
            if (g2 == g) {
                const float* wf = karg_in(I_WF) + ((size_t)(l * 4 + g) * 64) * 64 + d;
                const int sh = pq ? 1536 : 0;
                for (int c2 = 0; c2 < 64; ++c2) acc += tab[((((c * c2) & 63) * 32) + sh) & 2047] * wf[(size_t)c2 * 64];
                acc *= pq ? -DFT_NRM : DFT_NRM;
            }
            ((bf16_t*)(ws + WS_W + (size_t)l * LW + OW_Y))[r] = (bf16_t)f2bf(acc);
        }
    }
    {
        bf16_t* XB = (bf16_t*)(ws + WS_XB); float* SSQ = (float*)(ws + WS_SSQX);
        for (int m = gw; m < T; m += NGW) {
            const f32x4* xr = (const f32x4*)(p.x + (size_t)m * DM) + lane; f32x4 v[4]; float s = 0.f;
#pragma unroll
            for (int j = 0; j < 4; ++j) { v[j] = xr[64 * j]; s += (v[j].x * v[j].x + v[j].y * v[j].y) + (v[j].z * v[j].z + v[j].w * v[j].w); }
            s = wave_sum(s);
            u32x2* o8 = (u32x2*)(XB + (size_t)m * DM) + lane;
#pragma unroll
            for (int j = 0; j < 4; ++j) o8[64 * j] = (u32x2){pk2(v[j].x, v[j].y), pk2(v[j].z, v[j].w)};
            if (lane < 4) SSQ[(size_t)m * 4 + lane] = lane == 0 ? s : 0.f;
        }
    }
    {
        float* R = (float*)(ws + WS_ROPE);
        for (int i = gt; i < T * 32; i += NGT) {
            const int row = i >> 5, j = i & 31;
            const float inv = powf(10000.0f, -(float)j * (1.0f / 32.0f));
            const float ang = (float)p.pos[row] * inv;
            R[(size_t)row * 64 + j] = cosf(ang); R[(size_t)row * 64 + 32 + j] = sinf(ang);
        }
    }
}

#define XB_TMO      128
#define XB_XCNT(j)  (256  + 64 * (j))
#define XB_XSUB(j)  (1280 + 64 * (j))
#define XB_XGEN(j)  (2304 + 64 * (j))
#define XB_TOP      3328
#define XB_TOPGEN   3392
#define XCD_BAR_WORDS 3456
#define XB_SPIN_CAP (1u << 18)

__device__ __forceinline__ unsigned xb_ld(unsigned* p)              { return __hip_atomic_load(p, __ATOMIC_RELAXED, __HIP_MEMORY_SCOPE_AGENT); }
__device__ __forceinline__ unsigned xb_add(unsigned* p, unsigned v) { return __hip_atomic_fetch_add(p, v, __ATOMIC_RELAXED, __HIP_MEMORY_SCOPE_AGENT); }
__device__ __forceinline__ unsigned xb_xcc_id() { return (unsigned)__builtin_amdgcn_s_getreg((3 << 11) | 20) & 0xFu; }
#define XB_SPIN(cond, bar) do { unsigned _sp = 0; while (cond) { __builtin_amdgcn_s_sleep(1); \
    if ((++_sp & 255u) == 0u) { if (xb_ld(&(bar)[XB_TMO])) break; if (_sp > XB_SPIN_CAP) { atomicAdd(&(bar)[XB_TMO], 1u); break; } } } } while (0)

struct XcdBarrier {
    unsigned* bar; unsigned x;
    volatile LAS unsigned* st;
};

__device__ __forceinline__ XcdBarrier xcd_barrier_post(unsigned* bar, volatile LAS unsigned* st) {
    XcdBarrier b; b.bar = bar; b.x = xb_xcc_id(); b.st = st;
    if (threadIdx.x == 0) (void)xb_add(&bar[XB_XCNT(b.x)], 1u);
    return b;
}
__device__ __forceinline__ void xcd_barrier_complete(unsigned* bar, unsigned x, unsigned& nloc, unsigned& nx) {
    const unsigned G = gridDim.x * gridDim.y * gridDim.z;
    unsigned sum, cnt, mine, sp = 0u;
    for (;;) {
        sum = 0u; cnt = 0u; mine = 0u;
#pragma unroll 1
        for (unsigned j = 0; j < 16; ++j) { const unsigned c = xb_ld(&bar[XB_XCNT(j)]); sum += c; cnt += (c > 0u) ? 1u : 0u; mine = (j == x) ? c : mine; }
        if (sum == G) break;
        __builtin_amdgcn_s_sleep(1);
        if ((++sp & 255u) == 0u) { if (xb_ld(&bar[XB_TMO])) break; if (sp > XB_SPIN_CAP) { atomicAdd(&bar[XB_TMO], 1u); break; } }
    }
    nloc = mine > 0u ? mine : 1u; nx = cnt > 0u ? cnt : 1u;
}

__device__ __forceinline__ void xcd_barrier(const XcdBarrier& b) {
    asm volatile("s_waitcnt vmcnt(0)" ::: "memory");
    __syncthreads();
    if (threadIdx.x == 0) {
        unsigned* bar = b.bar;
        __builtin_amdgcn_s_waitcnt(0);
        unsigned nloc = b.st[0], nx = b.st[1];
        if (nloc == 0u) { xcd_barrier_complete(bar, b.x, nloc, nx); b.st[0] = nloc; b.st[1] = nx; }
        const unsigned old = xb_add(&bar[XB_XSUB(b.x)], 1u);
        const unsigned gen = old / nloc;
        if (old + 1u == (gen + 1u) * nloc) {
            __builtin_amdgcn_fence(__ATOMIC_RELEASE, "agent");
            asm volatile("s_waitcnt vmcnt(0)" ::: "memory");
            const unsigned og = xb_add(&bar[XB_TOP], 1u);
            const unsigned tg = og / nx;
            if (og + 1u == (tg + 1u) * nx) xb_add(&bar[XB_TOPGEN], 1u);
            else XB_SPIN(xb_ld(&bar[XB_TOPGEN]) == tg, bar);
            __builtin_amdgcn_fence(__ATOMIC_ACQUIRE, "agent");
            xb_add(&bar[XB_XGEN(b.x)], 1u);
            asm volatile("s_waitcnt vmcnt(0)" ::: "memory");
        } else {
            XB_SPIN(xb_ld(&bar[XB_XGEN(b.x)]) == gen, bar);
            __builtin_amdgcn_fence(__ATOMIC_ACQUIRE, "agent");
            asm volatile("s_waitcnt vmcnt(0)" ::: "memory");
        }
    }
    __syncthreads();
}

constexpr int N_PHASES = 1 + 6 * DEPTH;
#ifndef DUP_PH
#define DUP_PH -1
#define DUP_SUB 7
#endif
#ifndef PHM
#define PHM 0xffff
#endif
__global__ void __launch_bounds__(MK_THREADS, 2) mk(Params p) {
    extern __shared__ __attribute__((aligned(16))) unsigned char lds_raw[];
    LAS unsigned char* lds = (LAS unsigned char*)lds_raw;
    const int G = gridDim.x, bid = blockIdx.x;
#define BP(off) ((bf16_t*)(ws + (off)))
#define FP(off) ((float*)(ws + (off)))
    volatile LAS unsigned* MISC = (volatile LAS unsigned*)(lds + MISC_OFF);
    if (threadIdx.x < 32) MISC[threadIdx.x] = 0u;
    __syncthreads();
    const XcdBarrier bar = xcd_barrier_post((unsigned*)(p.ws + WS_CTL) + CW_BAR, MISC + 8);
    if (p.ph_lo == 0) {
        phase_prologue(p, lds, threadIdx.x);
        if (p.ph_hi > 1) xcd_barrier(bar);
    }
    for (int ph = p.ph_lo < 1 ? 1 : p.ph_lo; ph < p.ph_hi; ++ph) {
        for (int rep = 0; rep < ((ph == DUP_PH) ? 2 : 1); ++rep) {
            const int sub = rep == 0 ? p.sub : DUP_SUB; if (rep) __syncthreads();
        int tid = threadIdx.x; asm volatile("" : "+v"(tid));
        unsigned char* ws; { unsigned long long w_ = (unsigned long long)p.ws; asm volatile("" : "+s"(w_)); ws = (unsigned char*)(__attribute__((address_space(1))) unsigned char*)w_; }
            const int l = (ph - 1) / 6, s = (ph - 1) % 6;
            unsigned char* wl = ws + WS_W + (size_t)l * LW;
            pg8::StaticOrder S;
            if (s == 0 && ((PHM & 1) != 0)) {
                pg8::Gemm g{BP(WS_XB), (const bf16_t*)(wl + OW_IN), T, INWP, DM}; S.init(T, INWP, G, bid);
                pg8::EpiIn E{ws, karg_in(I_KNG) + l * QKD};
                pg8::gemm_phase<pg8::EpiIn, pg8::StaticOrder, true, true>(lds, g, S, E, tid);
            } else if (s == 1 && ((PHM & 2) != 0)) {
                if ((sub & 1) && ((PHM & 64) != 0)) { pg8::Gemm g{BP(WS_F), BP(WS_UT), 4096, 4096, 2048}; S.init(4096, 4096, G, bid); pg8::EpiDft E{ws};
                    pg8::gemm_phase<pg8::EpiDft, pg8::StaticOrder, true, true>(lds, g, S, E, tid); }
                if ((sub & 2) && ((PHM & 128) != 0)) { pg8::Gemm g{BP(WS_CQ), (const bf16_t*)(wl + OW_QUP), T, QUPWP, QL}; S.init(T, QUPWP, G, bid); pg8::EpiQ E{ws};
                    pg8::gemm_phase<pg8::EpiQ, pg8::StaticOrder, true, true>(lds, g, S, E, tid); }
                if ((sub & 4) && ((PHM & 512) != 0)) { pg8::Gemm g{BP(WS_CKV), (const bf16_t*)(wl + OW_KVUP), T, KVUPW, KVL}; S.init(T, KVUPW, G, bid);
                    pg8::EpiKV E{ws, karg_in(I_KNG) + l * QKD, (LAS float*)(lds + XCH_OFF)};
                    pg8::gemm_phase<pg8::EpiKV, pg8::StaticOrder, true, true>(lds, g, S, E, tid); }
            } else if (s == 2 && ((PHM & 4) != 0)) {
                if ((sub & 1) && ((PHM & 1024) != 0)) {
                    const int vcu = (G % 8 == 0) ? (bid % 8) * (G / 8) + bid / 8 : bid;
                    for (int ui = vcu; ui < BATCH * NH * 8; ui += G) { const int bh = ui >> 3, qb = ui & 7, b = bh / NH, h = bh - b * NH; const size_t row0 = (size_t)b * SEQ + qb * 256;
                        att::attn_unit<0>(BP(WS_Q) + row0 * QUPW + h * QKD, BP(WS_K) + (size_t)b * SEQ * QUPW + h * QKD, BP(WS_V) + (size_t)b * SEQ * AW + h * VD, BP(WS_MIX) + row0 * 1024 + h * VD,
                                       FP(WS_SSQA) + row0 * 8 + h, karg_in(I_QNG) + l * QKD, FP(WS_ROPE) + row0 * 64, (LAS char*)lds, tid); }
                }
                if ((sub & 2) && ((PHM & 2048) != 0)) { pg8::Gemm g{BP(WS_PQ), (const bf16_t*)(wl + OW_Y), T, 256, 512}; S.init(T, 256, G, bid);
                    pg8::EpiY E{ws, (LAS float*)(lds + XCH_OFF)};
                    pg8::gemm_phase<pg8::EpiY, pg8::StaticOrder, true, true>(lds, g, S, E, tid); }
            } else if (s == 3 && ((PHM & 8) != 0)) {
                pg8::Gemm g{BP(WS_MIX), (const bf16_t*)(wl + OW_OUT), T, DM, DM}; S.init(T, DM, G, bid);
                pg8::EpiRes<12> E{ws, l == 0 ? p.x : nullptr, nullptr, (LAS float*)(lds + XCH_OFF)};
                pg8::gemm_phase<pg8::EpiRes<12>, pg8::StaticOrder, true, true>(lds, g, S, E, tid);
            } else if (s == 4 && ((PHM & 16) != 0)) {
                pg8::Gemm g{BP(WS_XB), (const bf16_t*)(wl + OW_MI), T, FF, DM}; S.init(T, FF, G, bid);
                pg8::EpiMlpIn E{ws};
                pg8::gemm_phase<pg8::EpiMlpIn, pg8::StaticOrder, true, true>(lds, g, S, E, tid);
            } else if ((PHM & 32) != 0) {
                pg8::Gemm g{BP(WS_H), (const bf16_t*)(wl + OW_MO), T, DM, FF}; S.init(T, DM, G, bid);
                pg8::EpiRes<0> E{ws, nullptr, l == DEPTH - 1 ? p.out : nullptr, (LAS float*)(lds + XCH_OFF)};
                pg8::gemm_phase<pg8::EpiRes<0>, pg8::StaticOrder, true, true>(lds, g, S, E, tid);
            }
        }
        if (ph + 1 < p.ph_hi) xcd_barrier(bar); else __syncthreads();
    }
}


#ifdef ATTN_PROBE
__global__ void __launch_bounds__(MK_THREADS, 2) attn_probe(Params p) {
    extern __shared__ __attribute__((aligned(16))) unsigned char lds_raw[];
    LAS unsigned char* lds = (LAS unsigned char*)lds_raw;
    unsigned char* ws = p.ws; const int G = gridDim.x, bid = blockIdx.x, tid = threadIdx.x, l = 1;
    const int vcu = (G % 8 == 0) ? (bid % 8) * (G / 8) + bid / 8 : bid;
    for (int ui = vcu; ui < BATCH * NH * 8; ui += G) { const int bh = ui >> 3, qb = ui & 7, b = bh / NH, h = bh - b * NH; const size_t row0 = (size_t)b * SEQ + qb * 256;
        att::attn_unit<ATTN_PROBE>(BP(WS_Q) + row0 * QUPW + h * QKD, BP(WS_K) + (size_t)b * SEQ * QUPW + h * QKD, BP(WS_V) + (size_t)b * SEQ * AW + h * VD, BP(WS_MIX) + row0 * 1024 + h * VD,
                       FP(WS_SSQA) + row0 * 8 + h, karg_in(I_QNG) + l * QKD, FP(WS_ROPE) + row0 * 64, (LAS char*)lds, tid); }
}
#endif

extern "C" void kernel_launch(void* const* d_in, const int* in_sizes, int n_in, void* d_out, int out_size, void* d_ws, size_t ws_size, hipStream_t stream) {
    static int grid = 0;
    if (grid == 0) {
        if (n_in != 17 || in_sizes[0] != T * DM || out_size != T * DM || ws_size < WS_END) {
            fprintf(stderr, "kernel_launch: shape/workspace mismatch: n_in %d in0 %d out %d ws %zu (need %zu)\n", n_in, n_in > 0 ? in_sizes[0] : -1, out_size, ws_size, (size_t)WS_END);
            grid = -1; return; }
#ifdef ATTN_PROBE
        (void)hipFuncSetAttribute((const void*)attn_probe, hipFuncAttributeMaxDynamicSharedMemorySize, MK_LDS);
#endif
        if (hipFuncSetAttribute((const void*)mk, hipFuncAttributeMaxDynamicSharedMemorySize, MK_LDS) != hipSuccess) { fprintf(stderr, "kernel_launch: hipFuncSetAttribute failed\n"); grid = -1; return; }
        int dev = 0, cus = 0, per_cu = 0;
        if (hipGetDevice(&dev) != hipSuccess || hipDeviceGetAttribute(&cus, hipDeviceAttributeMultiprocessorCount, dev) != hipSuccess) { fprintf(stderr, "kernel_launch: device query failed\n"); grid = -1; return; }
        if (hipOccupancyMaxActiveBlocksPerMultiprocessor(&per_cu, (const void*)mk, MK_THREADS, MK_LDS) != hipSuccess || per_cu < 1) { fprintf(stderr, "kernel_launch: occupancy query says %d blocks per CU\n", per_cu); grid = -1; return; }
        grid = cus;
    }
    if (grid < 0) return;
    Params p{};
    p.x = (const float*)d_in[0]; p.pos = (const int*)d_in[1];
    for (int i = 0; i < 15; ++i) p.in[i] = (const float*)d_in[2 + i];
    p.out = (float*)d_out; p.ws = (unsigned char*)d_ws; p.ph_lo = 0; p.ph_hi = N_PHASES; p.sub = 7; p.pad = 0;
    if (hipMemsetAsync((char*)d_ws + WS_CTL, 0, CTL_ZERO_BYTES, stream) != hipSuccess) { fprintf(stderr, "kernel_launch: hipMemsetAsync failed\n"); return; }
    hipLaunchKernelGGL(mk, dim3(grid), dim3(MK_THREADS), MK_LDS, stream, p);
#ifdef ATTN_PROBE
    hipLaunchKernelGGL(attn_probe, dim3(grid), dim3(MK_THREADS), MK_LDS, stream, p);
#endif
#ifdef PHASE_PROBE
    { Params q = p; q.ph_lo = PHASE_PROBE; q.ph_hi = PHASE_PROBE + 1; q.sub = PHASE_PROBE_SUB; hipLaunchKernelGGL(mk, dim3(grid), dim3(MK_THREADS), MK_LDS, stream, q); }
#endif
    const hipError_t le = hipPeekAtLastError();
    if (le != hipSuccess) fprintf(stderr, "kernel_launch: launch failed: %s (grid %d)\n", hipGetErrorName(le), grid);
}
```

```cpp
#include <hip/hip_runtime.h>
#include <cstdio>
#include <cstdint>

typedef unsigned short bf16_t;
typedef short bf16x8 __attribute__((ext_vector_type(8)));
typedef float f32x4 __attribute__((ext_vector_type(4)));
typedef unsigned u32x4 __attribute__((ext_vector_type(4)));
typedef unsigned u32x2 __attribute__((ext_vector_type(2)));
#define LAS __attribute__((address_space(3)))

constexpr int BATCH = 16, SEQ = 2048, DM = 1024, T = BATCH * SEQ, DEPTH = 2;
constexpr int FW = 256, QL = 256, KVL = 256, ROPE_D = 64, NOPE = 128, VD = 128, NH = 6, QKD = 192;
constexpr int INW = 832, INWP = 1024, QUPW = NH * QKD  , QUPWP = 1280, KVUPW = NH * 256  , AW = NH * VD  , FF = 4096;
constexpr float EPS = 1e-6f;
constexpr float QSCALE = 0.07216878364870322f * 1.4426950408889634f;
constexpr float DFT_NRM = 0.0027621358640099515f;

constexpr size_t MiB = 1u << 20;
constexpr size_t WS_CTL = 0;
constexpr size_t WS_W = 1 * MiB, LW = 22 * MiB;
constexpr size_t OW_IN = 0, OW_QUP = 2 * MiB, OW_KVUP = OW_QUP + 640 * 1024, OW_OUT = OW_KVUP + 768 * 1024, OW_MI = OW_OUT + 2 * MiB, OW_MO = OW_MI + 8 * MiB, OW_Y = OW_MO + 8 * MiB;
static_assert(OW_Y + 256 * 1024 <= LW, "layer weight block");
constexpr size_t WS_F = 45 * MiB;
constexpr size_t WS_SSQX = 61 * MiB;
constexpr size_t WS_SSQCQ = 63 * MiB, WS_SSQCKV = WS_SSQCQ + 512 * 1024;
constexpr size_t WS_XB = 64 * MiB;
constexpr size_t WS_MIX = 128 * MiB;
constexpr size_t WS_Q = 192 * MiB;
constexpr size_t WS_K = 264 * MiB;
constexpr size_t WS_V = 336 * MiB;
constexpr size_t WS_PQ = 384 * MiB;
constexpr size_t WS_UT = 416 * MiB;
constexpr size_t WS_H = 192 * MiB;
constexpr size_t WS_CQ = 448 * MiB, WS_CKV = 464 * MiB;
constexpr size_t WS_KPE = 480 * MiB;
constexpr size_t WS_ROPE = 484 * MiB;
constexpr size_t WS_SSQPE = 492 * MiB;
constexpr size_t WS_SSQA = WS_SSQPE + 256 * 1024;
constexpr size_t WS_RSTD = 494 * MiB;
constexpr size_t WS_END = 495 * MiB;
constexpr size_t WS_KRAW = 384 * MiB;
constexpr size_t WS_S = 384 * MiB;

__device__ __forceinline__ unsigned f2bf(float f) { unsigned u = __builtin_bit_cast(unsigned, f); return (u + 0x7fffu + ((u >> 16) & 1u)) >> 16; }
__device__ __forceinline__ unsigned pk2(float lo, float hi) { return f2bf(lo) | (f2bf(hi) << 16); }
__device__ __forceinline__ float bf2f(bf16_t h) { return __builtin_bit_cast(float, (unsigned)h << 16); }
__device__ __forceinline__ float add_xor32(float v) { auto rr = __builtin_amdgcn_permlane32_swap(__float_as_uint(v), __float_as_uint(v), false, false); return __uint_as_float(rr[0]) + __uint_as_float(rr[1]); }
__device__ __forceinline__ float add_xor16(float v) { return v + __uint_as_float(__builtin_amdgcn_ds_swizzle(__float_as_uint(v), 0x401F)); }
__device__ __forceinline__ float add_xor1(float v) { return v + __uint_as_float(__builtin_amdgcn_ds_swizzle(__float_as_uint(v), 0x041F)); }
__device__ __forceinline__ float wave_sum(float v) {
#pragma unroll
    for (int o = 1; o < 64; o <<= 1) v += __shfl_xor(v, o);
    return v;
}

struct Params {
    const float* x; const int* pos; const float* in[15];
    float* out; unsigned char* ws; int ph_lo, ph_hi, sub, pad;
};
enum { I_ANG = 0, I_WIN, I_WF, I_QAG, I_WQUP, I_KVAG, I_WKVUP, I_QNG, I_KNG, I_FOG, I_AOG, I_WOUT, I_MNG, I_WMI, I_WMO };
__device__ __forceinline__ const float* karg_in(int i) {
    const volatile unsigned long long* ka = (const volatile unsigned long long*)__builtin_amdgcn_kernarg_segment_ptr();
    return (const float*)(__attribute__((address_space(1))) const float*)ka[2 + i];
}

namespace pg8 {
#define PG8_LAS __attribute__((address_space(3)))
typedef unsigned short bf16_t;
typedef short bf16x8 __attribute__((ext_vector_type(8)));
typedef float f32x4 __attribute__((ext_vector_type(4)));
typedef unsigned u32x4 __attribute__((ext_vector_type(4)));
constexpr int BM = 256, BK = 64, HALF = 128, HTB = HALF * BK * 2  , STAGE_BYTES = 8 * HTB, NXCD = 8, WGM = 8;

__host__ __device__ __forceinline__ int lds_byte(int r, int c) { const int st = (r >> 4) * 2 + (c >> 5), rr = r & 15, cc = c & 31, ob = rr * 64 + cc * 2; return st * 1024 + (ob ^ (((ob >> 9) & 1) << 5)); }
__host__ __device__ __forceinline__ void stage_rc(int b, int& R, int& C) { const int st = b / 1024, sb = b % 1024, swz = sb ^ (((sb >> 9) & 1) << 5); R = (st >> 1) * 16 + swz / 64; C = (st & 1) * 32 + (swz % 64) / 2; }
__host__ __device__ __forceinline__ int perm32(int rho) { const int n = rho >> 4, i = rho & 15; return 8 * (i >> 2) + 4 * n + (i & 3); }

struct Unit { int pm, pn; };
struct Gemm { const bf16_t* A; const bf16_t* Bt; int M, N, K; };

struct StaticOrder {
    int nM, nN, nwg, G, c;
    __host__ __device__ void init(int M, int N, int G_, int c_) { nM = M / BM; nN = N / BM; nwg = nM * nN; G = G_; c = c_; }
    __host__ __device__ bool next(int i, Unit& u) const {
        const long L = (long)i * G + c; if (L >= nwg) return false;
        int wgid = (int)L; { const int q = nwg / NXCD, r = nwg % NXCD, xcd = wgid % NXCD, off = wgid / NXCD; wgid = (xcd < r ? xcd * (q + 1) : r * (q + 1) + (xcd - r) * q) + off; }
        const int nig = WGM * nN, gid = wgid / nig, fm = gid * WGM, gsz = (nM - fm) < WGM ? (nM - fm) : WGM;
        u.pm = fm + ((wgid % nig) % gsz); u.pn = (wgid % nig) / gsz; return true;
    }
    __device__ __forceinline__ void a_ready(const Unit&) const {}
    __device__ __forceinline__ void done(const Unit&) const {}
};

template <class Epi, class Sched, bool ALIGN_EPI = false, bool SP2 = false>
__device__ __forceinline__ void gemm_phase(PG8_LAS unsigned char* lds, const Gemm g, const Sched& S, const Epi& E, const int tid) {
    const int wid = __builtin_amdgcn_readfirstlane(tid >> 6), lane = tid & 63, wr = wid >> 2, wc = wid & 3, fr = lane & 15, fq = lane >> 4;
    int K_ = g.K; asm volatile("" : "+s"(K_));
    const int K = K_, nt = K / BK;
    unsigned voffA[2], voffB[2];
#pragma unroll
    for (int i = 0; i < 2; ++i) { int R, C; stage_rc(tid * 16 + i * 8192, R, C); const int Rb = Epi::PERM ? ((R & ~31) + perm32(R & 31)) : R;
        voffA[i] = (unsigned)(R * K + C) * 2u; voffB[i] = (unsigned)(Rb * K + C) * 2u; }
    const size_t kstep = (size_t)(BK * 2);
    const size_t hstep = (size_t)HALF * K * 2;
    const size_t tstep = 2 * hstep;
    const unsigned ldsw = (unsigned)wid * 1024u;
    const int aoff = lds_byte(wr * 64 + fr, fq * 8), boff = lds_byte(wc * 32 + fr, fq * 8);
#define PG8_SA(b, h) (((b) * 2 + (h)) * HTB)
#define PG8_SB(b, h) ((4 + (b) * 2 + (h)) * HTB)
#define PG8_STAGE(bufoff, gbase, voff) do { _Pragma("unroll") for (int _i = 0; _i < 2; ++_i) \
        __builtin_amdgcn_global_load_lds((const unsigned*)((const char*)(gbase) + (voff)[_i]), (PG8_LAS unsigned*)(lds + (bufoff) + ldsw + _i * 8192), 16, 0, 0); } while (0)
#define PG8_LDA(dst, b, h) do { _Pragma("unroll") for (int m = 0; m < 4; ++m) _Pragma("unroll") for (int k = 0; k < 2; ++k) dst[m][k] = *(const PG8_LAS bf16x8*)(lds + PG8_SA(b, h) + aoff + m * 2048 + k * 1024); } while (0)
#define PG8_LDB(dst, b, h) do { _Pragma("unroll") for (int n = 0; n < 2; ++n) _Pragma("unroll") for (int k = 0; k < 2; ++k) dst[n][k] = *(const PG8_LAS bf16x8*)(lds + PG8_SB(b, h) + boff + n * 2048 + k * 1024); } while (0)
#define PG8_MMA(ai, bj, At, Bt) do { __builtin_amdgcn_s_setprio(1); _Pragma("unroll") for (int m = 0; m < 4; ++m) _Pragma("unroll") for (int n = 0; n < 2; ++n) _Pragma("unroll") for (int k = 0; k < 2; ++k) \
        acc[ai][bj][m][n] = __builtin_amdgcn_mfma_f32_16x16x32_bf16(Bt[n][k], At[m][k], acc[ai][bj][m][n], 0, 0, 0); __builtin_amdgcn_s_setprio(0); } while (0)
#define PG8_WAIT_V(n) asm volatile("s_waitcnt vmcnt(" #n ")" ::: "memory")
#define PG8_WAIT_L(n) asm volatile("s_waitcnt lgkmcnt(" #n ")" ::: "memory")
#define PG8_BAR __builtin_amdgcn_s_barrier()
#define PG8_SCHED __builtin_amdgcn_sched_barrier(0)
    Unit cur, nxt; int ui = 0;
    if (!S.next(0, cur)) return;
    f32x4 acc[2][2][4][2];
#pragma unroll
    for (int a = 0; a < 2; ++a)
#pragma unroll
        for (int b = 0; b < 2; ++b)
#pragma unroll
            for (int m = 0; m < 4; ++m)
#pragma unroll
                for (int n = 0; n < 2; ++n) acc[a][b][m][n] = (f32x4){0.f, 0.f, 0.f, 0.f};
    bf16x8 At[4][2], B0[2][2], B1[2][2];
    const char* cA = (const char*)g.A + (size_t)cur.pm * tstep; const char* cB = (const char*)g.Bt + (size_t)cur.pn * tstep;
    S.a_ready(cur);
    if constexpr (SP2) {
        PG8_STAGE(PG8_SB(0, 0), cB, voffB); PG8_STAGE(PG8_SB(0, 1), cB + hstep, voffB); PG8_STAGE(PG8_SA(0, 0), cA, voffA); PG8_STAGE(PG8_SA(0, 1), cA + hstep, voffA);
        if (wr == 1) PG8_BAR;
        PG8_WAIT_V(2); PG8_BAR;
        PG8_STAGE(PG8_SB(1, 0), cB + kstep, voffB); PG8_STAGE(PG8_SA(1, 0), cA + kstep, voffA); PG8_STAGE(PG8_SB(1, 1), cB + hstep + kstep, voffB);
        PG8_WAIT_V(6); PG8_BAR;
    } else {
        PG8_STAGE(PG8_SB(0, 0), cB, voffB); PG8_STAGE(PG8_SA(0, 0), cA, voffA); PG8_STAGE(PG8_SB(0, 1), cB + hstep, voffB); PG8_STAGE(PG8_SA(0, 1), cA + hstep, voffA);
        if (wr == 1) PG8_BAR;
        PG8_WAIT_V(4); PG8_BAR;
        PG8_STAGE(PG8_SB(1, 0), cB + kstep, voffB); PG8_STAGE(PG8_SA(1, 0), cA + kstep, voffA); PG8_STAGE(PG8_SB(1, 1), cB + hstep + kstep, voffB);
        PG8_WAIT_V(6); PG8_BAR;
    }
    for (;;) {
        const bool has_next = S.next(ui + 1, nxt);
        const char* nA = has_next ? (const char*)g.A + (size_t)nxt.pm * tstep : cA; const char* nB = has_next ? (const char*)g.Bt + (size_t)nxt.pn * tstep : cB;
        for (int t = 0; t < nt; t += 2) {
            const bool last = (t == nt - 2);
            const char* a1 = cA + (size_t)(t + 1) * kstep;
            const char* a2 = last ? nA : cA + (size_t)(t + 2) * kstep; const char* b2 = last ? nB : cB + (size_t)(t + 2) * kstep;
            const char* a3 = a2 + kstep; const char* b3 = b2 + kstep;
            if (last && has_next) S.a_ready(nxt);
            if constexpr (SP2) {
            PG8_LDB(B0, 0, 0); PG8_LDB(B1, 0, 1); PG8_SCHED; PG8_LDA(At, 0, 0); PG8_STAGE(PG8_SA(1, 1), a1 + hstep, voffA);
            PG8_WAIT_V(8); PG8_WAIT_L(0); PG8_BAR; PG8_MMA(0, 0, At, B0); PG8_MMA(0, 1, At, B1); PG8_BAR; PG8_SCHED;
            PG8_LDA(At, 0, 1); PG8_STAGE(PG8_SB(0, 0), b2, voffB); PG8_STAGE(PG8_SB(0, 1), b2 + hstep, voffB); PG8_STAGE(PG8_SA(0, 0), a2, voffA);
            PG8_WAIT_V(8); PG8_WAIT_L(0); PG8_BAR; PG8_MMA(1, 0, At, B0); PG8_MMA(1, 1, At, B1); PG8_BAR; PG8_SCHED;
            PG8_LDB(B0, 1, 0); PG8_LDB(B1, 1, 1); PG8_SCHED; PG8_LDA(At, 1, 0); PG8_STAGE(PG8_SA(0, 1), a2 + hstep, voffA);
            PG8_WAIT_V(8); PG8_WAIT_L(0); PG8_BAR; PG8_MMA(0, 0, At, B0); PG8_MMA(0, 1, At, B1); PG8_BAR; PG8_SCHED;
            PG8_LDA(At, 1, 1); PG8_STAGE(PG8_SB(1, 0), b3, voffB); PG8_STAGE(PG8_SB(1, 1), b3 + hstep, voffB); PG8_STAGE(PG8_SA(1, 0), a3, voffA);
            PG8_WAIT_V(8); PG8_WAIT_L(0); PG8_BAR; PG8_MMA(1, 0, At, B0); PG8_MMA(1, 1, At, B1); PG8_BAR; PG8_SCHED;
            } else {
            PG8_LDB(B0, 0, 0); PG8_SCHED; PG8_LDA(At, 0, 0); PG8_STAGE(PG8_SA(1, 1), a1 + hstep, voffA);
            PG8_WAIT_L(8); PG8_BAR; PG8_WAIT_L(0); PG8_MMA(0, 0, At, B0); PG8_BAR; PG8_SCHED;
            PG8_LDB(B1, 0, 1); PG8_STAGE(PG8_SB(0, 0), b2, voffB);
            PG8_BAR; PG8_WAIT_L(0); PG8_MMA(0, 1, At, B1); PG8_BAR;
            PG8_LDA(At, 0, 1); PG8_STAGE(PG8_SA(0, 0), a2, voffA);
            PG8_BAR; PG8_WAIT_L(0); PG8_MMA(1, 0, At, B0); PG8_BAR; PG8_SCHED;
            PG8_STAGE(PG8_SB(0, 1), b2 + hstep, voffB);
            PG8_WAIT_V(6); PG8_BAR; PG8_MMA(1, 1, At, B1); PG8_BAR;
            PG8_LDB(B0, 1, 0); PG8_SCHED; PG8_LDA(At, 1, 0); PG8_STAGE(PG8_SA(0, 1), a2 + hstep, voffA);
            PG8_WAIT_L(8); PG8_BAR; PG8_WAIT_L(0); PG8_MMA(0, 0, At, B0); PG8_BAR; PG8_SCHED;
            PG8_LDB(B1, 1, 1); PG8_STAGE(PG8_SB(1, 0), b3, voffB);
            PG8_BAR; PG8_WAIT_L(0); PG8_MMA(0, 1, At, B1); PG8_BAR;
            PG8_LDA(At, 1, 1); PG8_STAGE(PG8_SA(1, 0), a3, voffA);
            PG8_BAR; PG8_WAIT_L(0); PG8_MMA(1, 0, At, B0); PG8_BAR; PG8_SCHED;
            PG8_STAGE(PG8_SB(1, 1), b3 + hstep, voffB);
            PG8_WAIT_V(6); PG8_BAR; PG8_MMA(1, 1, At, B1); PG8_BAR;
            }
            if constexpr (Epi::MIDK > 0) { if (t + 2 == Epi::MIDK) E.midk(acc, cur, wr, fr); }
        }
        if constexpr (ALIGN_EPI) { if (wr == 0) PG8_BAR; }
        if constexpr (!Epi::AFTER_DRAIN) { E(acc, cur, wr, wc, fr, fq); S.done(cur); }
        if (!has_next) break;
#pragma unroll
        for (int a = 0; a < 2; ++a)
#pragma unroll
            for (int b = 0; b < 2; ++b)
#pragma unroll
                for (int m = 0; m < 4; ++m)
#pragma unroll
                    for (int n = 0; n < 2; ++n) acc[a][b][m][n] = (f32x4){0.f, 0.f, 0.f, 0.f};
        cur = nxt; cA = nA; cB = nB; ++ui;
        if constexpr (ALIGN_EPI) { if (wr == 1) PG8_BAR; }
    }
    PG8_WAIT_V(0);
    if constexpr (!ALIGN_EPI) { if (wr == 0) PG8_BAR; }
    PG8_BAR;
    if constexpr (Epi::AFTER_DRAIN) { E.fused(acc, cur, wr, wc, fr, fq, lds, wid, lane); S.done(cur); }
#undef PG8_SA
#undef PG8_SB
#undef PG8_STAGE
#undef PG8_LDA
#undef PG8_LDB
#undef PG8_MMA
#undef PG8_WAIT_V
#undef PG8_WAIT_L
#undef PG8_BAR
#undef PG8_SCHED
}
}

namespace pg8 {
__device__ __forceinline__ unsigned cvt_pk_bf16(float lo, float hi) { unsigned r; asm volatile("v_cvt_pk_bf16_f32 %0, %1, %2" : "=v"(r) : "v"(lo), "v"(hi)); return r; }
__device__ __forceinline__ u32x4 pack8(const f32x4 a, const f32x4 b) { u32x4 w; w.x = cvt_pk_bf16(a[0], a[1]); w.y = cvt_pk_bf16(a[2], a[3]); w.z = cvt_pk_bf16(b[0], b[1]); w.w = cvt_pk_bf16(b[2], b[3]); return w; }
__device__ __forceinline__ float sum4(const f32x4 a) { return (a[0] + a[1]) + (a[2] + a[3]); }
__device__ __forceinline__ float ssq4(const f32x4 a) { return (a[0] * a[0] + a[1] * a[1]) + (a[2] * a[2] + a[3] * a[3]); }
__device__ __forceinline__ float rstd16(const float* p, float invn) { const f32x4* q = (const f32x4*)p; const f32x4 a = q[0], b = q[1], c = q[2], d = q[3]; return rsqrtf(((sum4(a) + sum4(b)) + (sum4(c) + sum4(d))) * invn + 1e-6f); }
__device__ __forceinline__ float rstd4(const float* p, float invn) { const f32x4 a = *(const f32x4*)p; return rsqrtf(sum4(a) * invn + 1e-6f); }
__device__ __forceinline__ float fq_sum(float s) { return add_xor32(add_xor16(s)); }

#define PG8_EPI_BAR() do { asm volatile("s_waitcnt lgkmcnt(0)" ::: "memory"); __builtin_amdgcn_s_barrier(); asm volatile("" ::: "memory"); } while (0)
typedef float f32x2 __attribute__((ext_vector_type(2)));
typedef unsigned u32x2 __attribute__((ext_vector_type(2)));
__device__ __forceinline__ void rstd8(float (&rs)[2][4], const float* part, int row0, float invn) {
    f32x4 t[2][4];
#pragma unroll
    for (int ai = 0; ai < 2; ++ai)
#pragma unroll
        for (int m = 0; m < 4; ++m) t[ai][m] = *(const f32x4*)(part + (size_t)(row0 + ai * HALF + m * 16) * 4);
#pragma unroll
    for (int ai = 0; ai < 2; ++ai)
#pragma unroll
        for (int m = 0; m < 4; ++m) rs[ai][m] = rsqrtf(sum4(t[ai][m]) * invn + 1e-6f);
}
struct EpiMlpIn { static constexpr bool PERM = true, AFTER_DRAIN = false; static constexpr int MIDK = 0;
    unsigned char* ws; int dbg;
    __device__ __forceinline__ void operator()(const f32x4 (&acc)[2][2][4][2], const Unit& u, int wr, int wc, int fr, int fq) const {
        unsigned char* wsl; { unsigned long long w_ = (unsigned long long)ws; asm volatile("" : "+s"(w_)); wsl = (unsigned char*)(__attribute__((address_space(1))) unsigned char*)w_; }
        const float* ssqx = (const float*)(wsl + WS_SSQX); bf16_t* H = (bf16_t*)(wsl + WS_H);
        const int row0 = u.pm * BM + wr * 64 + fr, col0 = u.pn * BM + wc * 32 + 8 * fq;
        if (dbg & 4) { asm volatile("" :: "v"(acc[0][0][0][0]), "v"(acc[1][1][3][1])); return; }
        float rs[2][4]; if (!(dbg & 2)) rstd8(rs, ssqx, row0, 1.f / 1024.f); else { for (int a_ = 0; a_ < 2; ++a_) for (int m_ = 0; m_ < 4; ++m_) rs[a_][m_] = 1.f; }
#pragma unroll
        for (int ai = 0; ai < 2; ++ai)
#pragma unroll
            for (int m = 0; m < 4; ++m) { bf16_t* rowp = H + (size_t)(row0 + ai * HALF + m * 16) * 4096 + col0;
#pragma unroll
                for (int bj = 0; bj < 2; ++bj) { f32x4 v0 = acc[ai][bj][m][0] * rs[ai][m], v1 = acc[ai][bj][m][1] * rs[ai][m];
#pragma unroll
                    for (int i = 0; i < 4; ++i) { const float a = fmaxf(v0[i], 0.f), b = fmaxf(v1[i], 0.f); v0[i] = a * a; v1[i] = b * b; }
                    const u32x4 pk_ = pack8(v0, v1); if (!(dbg & 1)) *(u32x4*)(rowp + bj * HALF) = pk_; else asm volatile("" :: "v"(pk_)); } }
    }
};
template <int MIDK_> struct EpiRes { static constexpr bool PERM = true, AFTER_DRAIN = false; static constexpr int MIDK = MIDK_;
    unsigned char* ws; const float* xf; float* outf; PG8_LAS float* xch;
    __device__ __forceinline__ void midk(f32x4 (&acc)[2][2][4][2], const Unit& u, int wr, int fr) const {
        unsigned char* wsl; { unsigned long long w_ = (unsigned long long)ws; asm volatile("" : "+s"(w_)); wsl = (unsigned char*)(__attribute__((address_space(1))) unsigned char*)w_; }
        const float* ssqa = (const float*)(wsl + WS_SSQA);
#pragma unroll
        for (int ai = 0; ai < 2; ++ai)
#pragma unroll
            for (int mp = 0; mp < 2; ++mp) { f32x4 a[2], b[2];
#pragma unroll
                for (int k = 0; k < 2; ++k) { const float* q = ssqa + (size_t)(u.pm * BM + ai * HALF + wr * 64 + (2 * mp + k) * 16 + fr) * 8; a[k] = *(const f32x4*)q; b[k] = *(const f32x4*)(q + 4); }
#pragma unroll
                for (int k = 0; k < 2; ++k) { const float rs = rsqrtf((sum4(a[k]) + (b[k][0] + b[k][1])) * (1.f / 768.f) + 1e-6f);
#pragma unroll
                    for (int bj = 0; bj < 2; ++bj)
#pragma unroll
                        for (int n = 0; n < 2; ++n) acc[ai][bj][2 * mp + k][n] *= rs; }
                asm volatile("" ::: "memory"); }
    }
    __device__ __forceinline__ void operator()(const f32x4 (&acc)[2][2][4][2], const Unit& u, int wr, int wc, int fr, int fq) const {
        const int row0 = u.pm * BM + wr * 64 + fr, col0 = u.pn * BM + wc * 32 + 8 * fq;
        unsigned char* wsl; { unsigned long long w_ = (unsigned long long)ws; asm volatile("" : "+s"(w_)); wsl = (unsigned char*)(__attribute__((address_space(1))) unsigned char*)w_; }
        bf16_t* XB = (bf16_t*)(wsl + WS_XB); float* ssqx = (float*)(wsl + WS_SSQX);
        PG8_LAS float* xw = xch + (wr * 64 + fr) * 4 + wc; asm volatile("" : "+v"(xw));
#pragma unroll
        for (int ai = 0; ai < 2; ++ai) { f32x4 pre[4][2][2];
            if (xf) {
#pragma unroll
                for (int m = 0; m < 4; ++m)
#pragma unroll
                    for (int bj = 0; bj < 2; ++bj) { const float* q = xf + (size_t)(row0 + ai * HALF + m * 16) * 1024 + col0 + bj * HALF; pre[m][bj][0] = *(const f32x4*)q; pre[m][bj][1] = *(const f32x4*)(q + 4); }
            } else { u32x4 pb[4][2];
#pragma unroll
                for (int m = 0; m < 4; ++m)
#pragma unroll
                    for (int bj = 0; bj < 2; ++bj) pb[m][bj] = *(const u32x4*)(XB + (size_t)(row0 + ai * HALF + m * 16) * 1024 + col0 + bj * HALF);
#pragma unroll
                for (int m = 0; m < 4; ++m)
#pragma unroll
                    for (int bj = 0; bj < 2; ++bj) { const u32x4 w = pb[m][bj];
                        pre[m][bj][0] = (f32x4){__builtin_bit_cast(float, w.x << 16), __builtin_bit_cast(float, w.x & 0xffff0000u), __builtin_bit_cast(float, w.y << 16), __builtin_bit_cast(float, w.y & 0xffff0000u)};
                        pre[m][bj][1] = (f32x4){__builtin_bit_cast(float, w.z << 16), __builtin_bit_cast(float, w.z & 0xffff0000u), __builtin_bit_cast(float, w.w << 16), __builtin_bit_cast(float, w.w & 0xffff0000u)}; }
            }
#pragma unroll
            for (int m = 0; m < 4; ++m) { float s = 0.f;
#pragma unroll
                for (int bj = 0; bj < 2; ++bj) { const size_t off = (size_t)(row0 + ai * HALF + m * 16) * 1024 + col0 + bj * HALF;
                    const f32x4 o0 = pre[m][bj][0] + acc[ai][bj][m][0], o1 = pre[m][bj][1] + acc[ai][bj][m][1];
                    if (outf) { *(f32x4*)(outf + off) = o0; *(f32x4*)(outf + off + 4) = o1; }
                    else { *(u32x4*)(XB + off) = pack8(o0, o1); s += ssq4(o0) + ssq4(o1); } }
                if (!outf) { s = fq_sum(s); if (fq == 0) xw[(ai * HALF + m * 16) * 4] = s; } }
            asm volatile("" ::: "memory"); }
        if (!outf) {
            PG8_EPI_BAR();
            const int t = (wr * 4 + wc) * 64 + fq * 16 + fr;
            if (t < 256) { const f32x4 pz = *(const PG8_LAS f32x4*)(xch + t * 4); ssqx[(size_t)(u.pm * BM + t) * 4 + u.pn] = sum4(pz); }
        }
    }
};
struct EpiIn { static constexpr bool PERM = true, AFTER_DRAIN = false; static constexpr int MIDK = 0;
    unsigned char* ws; const float* gk;
    __device__ __forceinline__ void operator()(const f32x4 (&acc)[2][2][4][2], const Unit& u, int wr, int wc, int fr, int fq) const {
        unsigned char* wsl; { unsigned long long w_ = (unsigned long long)ws; asm volatile("" : "+s"(w_)); wsl = (unsigned char*)(__attribute__((address_space(1))) unsigned char*)w_; }
        const float* ssqx = (const float*)(wsl + WS_SSQX); bf16_t *UT = (bf16_t*)(wsl + WS_UT), *CQ = (bf16_t*)(wsl + WS_CQ), *CKV = (bf16_t*)(wsl + WS_CKV), *KPER = (bf16_t*)(wsl + WS_KPE);
        float *ssqcq = (float*)(wsl + WS_SSQCQ), *ssqckv = (float*)(wsl + WS_SSQCKV), *ssqpe = (float*)(wsl + WS_SSQPE); const float* rope = (const float*)(wsl + WS_ROPE);
        const int row0 = u.pm * BM + wr * 64 + fr, c0 = wc * 32 + 8 * fq, pn = u.pn;
        float rs8[2][4]; rstd8(rs8, ssqx, row0, 1.f / 1024.f);
#pragma unroll
        for (int ai = 0; ai < 2; ++ai)
#pragma unroll
            for (int m = 0; m < 4; ++m) { const int row = row0 + ai * HALF + m * 16; const float rs = rs8[ai][m];
                if (pn == 0) { const int b = row >> 11, s = row & 2047; bf16_t* base = UT + ((size_t)(b * 256 + c0)) * 2048 + s;
#pragma unroll
                    for (int bj = 0; bj < 2; ++bj)
#pragma unroll
                        for (int n = 0; n < 2; ++n)
#pragma unroll
                            for (int i = 0; i < 4; ++i) base[(size_t)(bj * HALF + 4 * n + i) * 2048] = (bf16_t)(cvt_pk_bf16(acc[ai][bj][m][n][i] * rs, 0.f) & 0xffffu);
                } else if (pn < 3) { bf16_t* dst = (pn == 1 ? CQ : CKV) + (size_t)row * 256 + c0; float s = 0.f;
#pragma unroll
                    for (int bj = 0; bj < 2; ++bj) { const f32x4 v0 = acc[ai][bj][m][0] * rs, v1 = acc[ai][bj][m][1] * rs; *(u32x4*)(dst + bj * HALF) = pack8(v0, v1); s += ssq4(v0) + ssq4(v1); }
                    s = fq_sum(s); if (fq == 0) (pn == 1 ? ssqcq : ssqckv)[(size_t)row * 4 + wc] = s;
                } else if (wc < 2) { const int j = 16 * wc + 4 * fq; const f32x4 v0 = acc[ai][0][m][0] * rs, v1 = acc[ai][0][m][1] * rs;
                    const f32x4 x1 = v0 * *(const f32x4*)(gk + 128 + j), x2 = v1 * *(const f32x4*)(gk + 160 + j);
                    const f32x4 cs = *(const f32x4*)(rope + (size_t)row * 64 + j), sn = *(const f32x4*)(rope + (size_t)row * 64 + 32 + j);
                    const f32x4 o1 = x1 * cs - x2 * sn, o2 = x2 * cs + x1 * sn;
                    *(u32x2*)(KPER + (size_t)row * 64 + j) = (u32x2){cvt_pk_bf16(o1[0], o1[1]), cvt_pk_bf16(o1[2], o1[3])};
                    *(u32x2*)(KPER + (size_t)row * 64 + 32 + j) = (u32x2){cvt_pk_bf16(o2[0], o2[1]), cvt_pk_bf16(o2[2], o2[3])};
                    float s = fq_sum(ssq4(v0) + ssq4(v1)); if (fq == 0) ssqpe[(size_t)row * 2 + wc] = s; } }
    }
};
struct EpiDft { static constexpr bool PERM = true, AFTER_DRAIN = false; static constexpr int MIDK = 0;
    unsigned char* ws;
    __device__ __forceinline__ void operator()(const f32x4 (&acc)[2][2][4][2], const Unit& u, int wr, int wc, int fr, int fq) const {
        unsigned char* wsl; { unsigned long long w_ = (unsigned long long)ws; asm volatile("" : "+s"(w_)); wsl = (unsigned char*)(__attribute__((address_space(1))) unsigned char*)w_; }
        bf16_t* PQb = (bf16_t*)(wsl + WS_PQ) + (size_t)u.pn * 2048 * 512 + wc * 32 + 8 * fq;
        const bool qpart = u.pm >= 4;
#pragma unroll
        for (int ai = 0; ai < 2; ++ai)
#pragma unroll
            for (int m = 0; m < 4; ++m) { const int r = u.pm * BM + ai * HALF + wr * 64 + m * 16 + fr, j = qpart ? r - 1024 : r;
#pragma unroll
                for (int bj = 0; bj < 2; ++bj) { const u32x4 v = pack8(acc[ai][bj][m][0], acc[ai][bj][m][1]);
                    if (!qpart) { *(u32x4*)(PQb + (size_t)j * 512 + bj * HALF) = v; if (j > 0) *(u32x4*)(PQb + (size_t)(2048 - j) * 512 + bj * HALF) = v; }
                    else if (j == 0) { *(u32x4*)(PQb + (size_t)1024 * 512 + bj * HALF) = v;
                        *(u32x4*)(PQb + 256 + bj * HALF) = (u32x4){0u, 0u, 0u, 0u}; *(u32x4*)(PQb + (size_t)1024 * 512 + 256 + bj * HALF) = (u32x4){0u, 0u, 0u, 0u}; }
                    else { *(u32x4*)(PQb + (size_t)j * 512 + 256 + bj * HALF) = v; *(u32x4*)(PQb + (size_t)(2048 - j) * 512 + 256 + bj * HALF) = v ^ 0x80008000u; } } }
    }
};
struct EpiQ { static constexpr bool PERM = true, AFTER_DRAIN = false; static constexpr int MIDK = 0;
    unsigned char* ws;
    __device__ __forceinline__ void operator()(const f32x4 (&acc)[2][2][4][2], const Unit& u, int wr, int wc, int fr, int fq) const {
        unsigned char* wsl; { unsigned long long w_ = (unsigned long long)ws; asm volatile("" : "+s"(w_)); wsl = (unsigned char*)(__attribute__((address_space(1))) unsigned char*)w_; }
        const float* ssqcq = (const float*)(wsl + WS_SSQCQ); bf16_t* Q = (bf16_t*)(wsl + WS_Q);
        const int row0 = u.pm * BM + wr * 64 + fr, col0 = u.pn * BM + wc * 32 + 8 * fq;
        float rs[2][4]; rstd8(rs, ssqcq, row0, 1.f / 256.f);
#pragma unroll
        for (int ai = 0; ai < 2; ++ai)
#pragma unroll
            for (int m = 0; m < 4; ++m) { bf16_t* rowp = Q + (size_t)(row0 + ai * HALF + m * 16) * 1152 + col0;
#pragma unroll
                for (int bj = 0; bj < 2; ++bj) if (col0 + bj * HALF < 1152) *(u32x4*)(rowp + bj * HALF) = pack8(acc[ai][bj][m][0] * rs[ai][m], acc[ai][bj][m][1] * rs[ai][m]); }
    }
};
struct EpiKV { static constexpr bool PERM = true, AFTER_DRAIN = false; static constexpr int MIDK = 0;
    unsigned char* ws; const float* gk; PG8_LAS float* xch;
    __device__ __forceinline__ void operator()(const f32x4 (&acc)[2][2][4][2], const Unit& u, int wr, int wc, int fr, int fq) const {
        unsigned char* wsl; { unsigned long long w_ = (unsigned long long)ws; asm volatile("" : "+s"(w_)); wsl = (unsigned char*)(__attribute__((address_space(1))) unsigned char*)w_; }
        const float *ssqckv = (const float*)(wsl + WS_SSQCKV), *ssqpe = (const float*)(wsl + WS_SSQPE); const bf16_t* KPER = (const bf16_t*)(wsl + WS_KPE); bf16_t *K = (bf16_t*)(wsl + WS_K), *V = (bf16_t*)(wsl + WS_V);
        const int h = u.pn, row0 = u.pm * BM + wr * 64 + fr, c0 = wc * 32 + 8 * fq, j4 = 4 * (4 * wc + fq);
        float rck[2][4]; rstd8(rck, ssqckv, row0, 1.f / 256.f);
        PG8_LAS float* xw = xch + (wr * 64 + fr) * 4 + wc; asm volatile("" : "+v"(xw));
        f32x2 pe2[2][4]; u32x2 kp[2][4];
#pragma unroll
        for (int ai = 0; ai < 2; ++ai)
#pragma unroll
            for (int m = 0; m < 4; ++m) { const int row = row0 + ai * HALF + m * 16; pe2[ai][m] = *(const f32x2*)(ssqpe + (size_t)row * 2); kp[ai][m] = *(const u32x2*)(KPER + (size_t)row * 64 + j4);
                const f32x4 v0 = acc[ai][0][m][0] * rck[ai][m], v1 = acc[ai][0][m][1] * rck[ai][m]; const float s = fq_sum(ssq4(v0) + ssq4(v1));
                if (fq == 0) xw[(ai * HALF + m * 16) * 4] = s; }
        const f32x4 g0 = *(const f32x4*)(gk + c0), g1 = *(const f32x4*)(gk + c0 + 4);
        PG8_EPI_BAR();
        const PG8_LAS float* xr = xw - wc;
#pragma unroll
        for (int ai = 0; ai < 2; ++ai)
#pragma unroll
            for (int m = 0; m < 4; ++m) { const int row = row0 + ai * HALF + m * 16;
                const f32x4 part = *(const PG8_LAS f32x4*)(xr + (ai * HALF + m * 16) * 4);
                const float rc = rck[ai][m], rk = rsqrtf((sum4(part) + (pe2[ai][m][0] + pe2[ai][m][1])) * (1.f / 192.f) + 1e-6f), rr = rc * rk;
                *(u32x4*)(K + (size_t)row * 1152 + h * 192 + c0) = pack8(acc[ai][0][m][0] * rr * g0, acc[ai][0][m][1] * rr * g1);
                *(u32x4*)(V + (size_t)row * 768 + h * 128 + c0) = pack8(acc[ai][1][m][0] * rc, acc[ai][1][m][1] * rc);
                const unsigned a = kp[ai][m][0], b = kp[ai][m][1];
                *(u32x2*)(K + (size_t)row * 1152 + h * 192 + 128 + j4) = (u32x2){cvt_pk_bf16(__builtin_bit_cast(float, a << 16) * rk, __builtin_bit_cast(float, a & 0xffff0000u) * rk),
                                                                               cvt_pk_bf16(__builtin_bit_cast(float, b << 16) * rk, __builtin_bit_cast(float, b & 0xffff0000u) * rk)}; }
    }
};
struct EpiY { static constexpr bool PERM = true, AFTER_DRAIN = false; static constexpr int MIDK = 0;
    unsigned char* ws; PG8_LAS float* xch;
    __device__ __forceinline__ void operator()(const f32x4 (&acc)[2][2][4][2], const Unit& u, int wr, int wc, int fr, int fq) const {
        unsigned char* wsl; { unsigned long long w_ = (unsigned long long)ws; asm volatile("" : "+s"(w_)); wsl = (unsigned char*)(__attribute__((address_space(1))) unsigned char*)w_; }
        bf16_t* MIX = (bf16_t*)(wsl + WS_MIX);
        const int row0 = u.pm * BM + wr * 64 + fr, c0 = wc * 32 + 8 * fq;
        PG8_LAS float* xw = xch + (wr * 64 + fr) * 4 + wc; asm volatile("" : "+v"(xw));
#pragma unroll
        for (int ai = 0; ai < 2; ++ai)
#pragma unroll
            for (int m = 0; m < 4; ++m) { float s = 0.f;
#pragma unroll
                for (int bj = 0; bj < 2; ++bj) s += ssq4(acc[ai][bj][m][0]) + ssq4(acc[ai][bj][m][1]);
                s = fq_sum(s); if (fq == 0) xw[(ai * HALF + m * 16) * 4] = s; }
        PG8_EPI_BAR();
        const PG8_LAS float* xr = xw - wc;
#pragma unroll
        for (int ai = 0; ai < 2; ++ai)
#pragma unroll
            for (int m = 0; m < 4; ++m) { const int row = row0 + ai * HALF + m * 16;
                const f32x4 part = *(const PG8_LAS f32x4*)(xr + (ai * HALF + m * 16) * 4); const float rf = rsqrtf(sum4(part) * (1.f / 256.f) + 1e-6f);
                bf16_t* rowp = MIX + (size_t)row * 1024 + 768 + c0;
#pragma unroll
                for (int bj = 0; bj < 2; ++bj) *(u32x4*)(rowp + bj * HALF) = pack8(acc[ai][bj][m][0] * rf, acc[ai][bj][m][1] * rf); }
    }
};
}

namespace att {
using f32x16 = __attribute__((ext_vector_type(16))) float;
using s16x4 = __attribute__((ext_vector_type(4))) short;
constexpr int NW = 8, QBLK = 32, KVBLK = 64, LDQ = 1152, LDK = 1152, LDV = 768;
constexpr int SHM_V = KVBLK * 128 * 2, SHM_K = KVBLK * 192 * 2;
constexpr int OFF_K = 0, OFF_V = 3 * SHM_K, OFF_WS = OFF_V + 3 * SHM_V, ATT_LDS = OFF_WS + NW * 64 * 4;
constexpr float THR = 8.f;
#define SBAR() __builtin_amdgcn_sched_barrier(0)
__device__ __forceinline__ int crow(int r, int hi) { return (r & 3) + 8 * (r >> 2) + 4 * hi; }
__device__ __forceinline__ unsigned cvtpk(float lo, float hi) { unsigned r; asm volatile("v_cvt_pk_bf16_f32 %0, %1, %2" : "=v"(r) : "v"(lo), "v"(hi)); return r; }

__device__ __forceinline__ void partialSM(f32x16& p0, f32x16& p1, float& m_reg, float& mn, float& alpha) {
  float pmax = p0[0];
#pragma unroll
  for (int r = 1; r < 16; ++r) pmax = fmaxf(pmax, p0[r]);
#pragma unroll
  for (int r = 0; r < 16; ++r) pmax = fmaxf(pmax, p1[r]);
  { auto rr = __builtin_amdgcn_permlane32_swap(__float_as_uint(pmax), __float_as_uint(pmax), false, false);
    pmax = fmaxf(__uint_as_float(rr[0]), __uint_as_float(rr[1])); }
  if (__builtin_expect(__all(pmax - m_reg <= THR), 1)) { mn = m_reg; alpha = 1.f; }
  else { mn = fmaxf(m_reg, pmax); alpha = __builtin_amdgcn_exp2f(m_reg - mn); m_reg = mn; }
#pragma unroll
  for (int r = 0; r < 16; ++r) p0[r] = p0[r] - mn;
#pragma unroll
  for (int r = 0; r < 16; ++r) p1[r] = p1[r] - mn;
#pragma unroll
  for (int r = 0; r < 16; ++r) p0[r] = __builtin_amdgcn_exp2f(p0[r]);
}
__device__ __forceinline__ void finishSM(f32x16& p0, f32x16& p1, float alpha, float& l_reg, bf16x8& pa0, bf16x8& pa1, bf16x8& pa2, bf16x8& pa3) {
#pragma unroll
  for (int r = 0; r < 16; ++r) p1[r] = __builtin_amdgcn_exp2f(p1[r]);
  float ps = 0;
#pragma unroll
  for (int r = 0; r < 16; ++r) ps += p0[r];
#pragma unroll
  for (int r = 0; r < 16; ++r) ps += p1[r];
  { auto rr = __builtin_amdgcn_permlane32_swap(__float_as_uint(ps), __float_as_uint(ps), false, false);
    ps = __uint_as_float(rr[0]) + __uint_as_float(rr[1]); }
  l_reg = l_reg * alpha + ps;
#define PK4(P, BASE, OUT) do { unsigned a0 = cvtpk(P[BASE + 0], P[BASE + 1]), a1 = cvtpk(P[BASE + 2], P[BASE + 3]);   \
    unsigned b0 = cvtpk(P[BASE + 4], P[BASE + 5]), b1 = cvtpk(P[BASE + 6], P[BASE + 7]);                              \
    auto r0 = __builtin_amdgcn_permlane32_swap(a0, b0, false, false); auto r1 = __builtin_amdgcn_permlane32_swap(a1, b1, false, false); \
    u32x4 w = {r0[0], r1[0], r0[1], r1[1]}; OUT = *reinterpret_cast<bf16x8*>(&w); } while (0)
  PK4(p0, 0, pa0); PK4(p0, 8, pa1); PK4(p1, 0, pa2); PK4(p1, 8, pa3);
#undef PK4
}
__device__ __forceinline__ void qkt(f32x16& p0, f32x16& p1, const LAS char* Ks, const bf16x8* qr, int kb0, int kb1, int kb2, int kb3) {
  p0 = f32x16{}; p1 = f32x16{};
  const LAS char* k0 = Ks + kb0; const LAS char* k1 = Ks + kb1; const LAS char* k2 = Ks + kb2; const LAS char* k3 = Ks + kb3;
  bf16x8 fa[4], fb[4];
#define QK_LD(F, g) do { F[0] = *(const LAS bf16x8*)((((2 * (g)) & 3) == 0 ? k0 : k2) + ((2 * (g)) >> 2) * 8192); F[1] = *(const LAS bf16x8*)((((2 * (g)) & 3) == 0 ? k0 : k2) + ((2 * (g)) >> 2) * 8192 + 4096); \
    F[2] = *(const LAS bf16x8*)((((2 * (g)) & 3) == 0 ? k1 : k3) + ((2 * (g)) >> 2) * 8192); F[3] = *(const LAS bf16x8*)((((2 * (g)) & 3) == 0 ? k1 : k3) + ((2 * (g)) >> 2) * 8192 + 4096); } while (0)
#define QK_MM(F, g) do { p0 = __builtin_amdgcn_mfma_f32_32x32x16_bf16(F[0], qr[2 * (g)], p0, 0, 0, 0); p1 = __builtin_amdgcn_mfma_f32_32x32x16_bf16(F[1], qr[2 * (g)], p1, 0, 0, 0); \
    p0 = __builtin_amdgcn_mfma_f32_32x32x16_bf16(F[2], qr[2 * (g) + 1], p0, 0, 0, 0); p1 = __builtin_amdgcn_mfma_f32_32x32x16_bf16(F[3], qr[2 * (g) + 1], p1, 0, 0, 0); } while (0)
  QK_LD(fa, 0); SBAR();
  QK_LD(fb, 1); SBAR(); QK_MM(fa, 0); SBAR();
  QK_LD(fa, 2); SBAR(); QK_MM(fb, 1); SBAR();
  QK_LD(fb, 3); SBAR(); QK_MM(fa, 2); SBAR();
  QK_LD(fa, 4); SBAR(); QK_MM(fb, 3); SBAR();
  QK_LD(fb, 5); SBAR(); QK_MM(fa, 4); SBAR();
  QK_MM(fb, 5);
#undef QK_LD
#undef QK_MM
}
__device__ __forceinline__ int v_rd_base(int lane) { return ((lane & 3) << 3) | (((lane >> 2) & 3) << 6) | (((lane >> 4) & 1) << 5) | (((lane >> 5) & 1) << 8); }
constexpr int v_rd_off(int d0, int ks, int half) { return d0 * 512 + ks * 4096 + half * 2048; }
template <int OFF> __device__ __forceinline__ s16x4 tr_read(int vb) {
  s16x4 r; asm volatile("ds_read_b64_tr_b16 %0, %1 offset:%2" : "=&v"(r) : "v"(vb), "i"(OFF) : "memory"); return r;
}
template <int D0> __device__ __forceinline__ void pv_one(f32x16& od, int vb, bf16x8 pa0, bf16x8 pa1, bf16x8 pa2, bf16x8 pa3) {
  const s16x4 l0 = tr_read<v_rd_off(D0, 0, 0)>(vb), h0 = tr_read<v_rd_off(D0, 0, 1)>(vb), l1 = tr_read<v_rd_off(D0, 1, 0)>(vb), h1 = tr_read<v_rd_off(D0, 1, 1)>(vb);
  const s16x4 l2 = tr_read<v_rd_off(D0, 2, 0)>(vb), h2 = tr_read<v_rd_off(D0, 2, 1)>(vb), l3 = tr_read<v_rd_off(D0, 3, 0)>(vb), h3 = tr_read<v_rd_off(D0, 3, 1)>(vb);
  asm volatile("s_waitcnt lgkmcnt(0)" ::: "memory"); SBAR();
#define PK(L, H) (bf16x8){L[0], L[1], L[2], L[3], H[0], H[1], H[2], H[3]}
  od = __builtin_amdgcn_mfma_f32_32x32x16_bf16(pa0, PK(l0, h0), od, 0, 0, 0);
  od = __builtin_amdgcn_mfma_f32_32x32x16_bf16(pa1, PK(l1, h1), od, 0, 0, 0);
  od = __builtin_amdgcn_mfma_f32_32x32x16_bf16(pa2, PK(l2, h2), od, 0, 0, 0);
  od = __builtin_amdgcn_mfma_f32_32x32x16_bf16(pa3, PK(l3, h3), od, 0, 0, 0);
#undef PK
}
__device__ __forceinline__ void pv_d0(f32x16* o, int vb, bf16x8 pa0, bf16x8 pa1, bf16x8 pa2, bf16x8 pa3) {
  pv_one<0>(o[0], vb, pa0, pa1, pa2, pa3); pv_one<1>(o[1], vb, pa0, pa1, pa2, pa3); pv_one<2>(o[2], vb, pa0, pa1, pa2, pa3); pv_one<3>(o[3], vb, pa0, pa1, pa2, pa3);
}

template <int VAR> __device__ __forceinline__ void attn_unit(const bf16_t* __restrict__ Qb, const bf16_t* __restrict__ Kh, const bf16_t* __restrict__ Vh, bf16_t* __restrict__ Ob, float* __restrict__ ssq,
                                          const float* __restrict__ gq, const float* __restrict__ rope, LAS char* lds, const int tid) {
  const int wid = __builtin_amdgcn_readfirstlane(tid >> 6), lane = tid & 63, r32 = lane & 31, hi = lane >> 5;
  LAS char* V_lds = lds + OFF_V; LAS char* K_lds = lds + OFF_K;
  LAS float* wsf = (LAS float*)(lds + OFF_WS) + wid * 64; LAS float* li_l = wsf; LAS float* al_l = wsf + 32;
  float m_reg = -1e30f, l_reg = 0; f32x16 o[4] = {}; bf16x8 qr[12];
  const bf16_t* ksrc; const bf16_t* vsrc0; const bf16_t* vsrc1;
  { const int key = wid * 8 + (lane >> 3), c3 = (lane & 7) ^ ((key >> 1) & 7); ksrc = Kh + (long)key * LDK + c3 * 8;
    const int q4 = (lane & 31) >> 2, cc = 32 * (lane >> 5) + 8 * (lane & 3);
    { const int p = wid, kk = 8 * (p >> 1) + q4, key2 = (kk & ~0xC) | ((kk & 4) << 1) | ((kk & 8) >> 1); vsrc0 = Vh + (long)key2 * LDV + 64 * (p & 1) + cc; }
    { const int p = wid + 8, kk = 8 * (p >> 1) + q4, key2 = (kk & ~0xC) | ((kk & 4) << 1) | ((kk & 8) >> 1); vsrc1 = Vh + (long)key2 * LDV + 64 * (p & 1) + cc; } }
#define GLDS(gp, ldsoff) __builtin_amdgcn_global_load_lds((const unsigned*)(gp), (LAS unsigned*)(lds + (ldsoff)), 16, 0, 0)
#define DMA_K(t, slot) do { const bf16_t* g_ = ksrc + (long)(t) * (KVBLK * LDK); const int o_ = OFF_K + (slot) * SHM_K + wid * 1024; \
    GLDS(g_, o_); GLDS(g_ + 64, o_ + 8192); GLDS(g_ + 128, o_ + 16384); } while (0)
#define DMA_V(t, slot) do { const int o_ = OFF_V + (slot) * SHM_V + wid * 1024; GLDS(vsrc0 + (long)(t) * (KVBLK * LDV), o_); GLDS(vsrc1 + (long)(t) * (KVBLK * LDV), o_ + 8192); } while (0)
#define WAIT_BAR(N) asm volatile("s_waitcnt vmcnt(" #N ") lgkmcnt(0)\n\ts_barrier" ::: "memory")
  DMA_K(0, 0); DMA_V(0, 0); DMA_K(1, 1);
  {
    const bf16_t* Qw = Qb + (long)(wid * QBLK + r32) * LDQ + hi * 8;
    bf16x8 raw[12]; float ss = 0.f;
#pragma unroll
    for (int d0 = 0; d0 < 12; ++d0) raw[d0] = *reinterpret_cast<const bf16x8*>(Qw + d0 * 16);
#pragma unroll
    for (int d0 = 0; d0 < 12; ++d0)
#pragma unroll
      for (int j = 0; j < 8; ++j) { const float v = bf2f((bf16_t)raw[d0][j]); ss += v * v; }
    ss = add_xor32(ss);
    const float rq = rsqrtf(ss * (1.f / 192.f) + EPS) * QSCALE;
    const float* rp = rope + (long)(wid * QBLK + r32) * 64 + hi * 8;
#pragma unroll
    for (int d0 = 0; d0 < 8; ++d0) { const f32x4 g0 = *(const f32x4*)(gq + d0 * 16 + hi * 8), g1 = *(const f32x4*)(gq + d0 * 16 + hi * 8 + 4); float v[8];
#pragma unroll
      for (int j = 0; j < 8; ++j) v[j] = bf2f((bf16_t)raw[d0][j]) * rq * (j < 4 ? g0[j] : g1[j - 4]);
      u32x4 w = {cvtpk(v[0], v[1]), cvtpk(v[2], v[3]), cvtpk(v[4], v[5]), cvtpk(v[6], v[7])}; qr[d0] = *reinterpret_cast<bf16x8*>(&w);
      if (d0 & 1) asm volatile("" ::: "memory"); }
#pragma unroll
    for (int dd = 0; dd < 2; ++dd) {
      const f32x4 ga0 = *(const f32x4*)(gq + 128 + dd * 16 + hi * 8), ga1 = *(const f32x4*)(gq + 128 + dd * 16 + hi * 8 + 4);
      const f32x4 gb0 = *(const f32x4*)(gq + 160 + dd * 16 + hi * 8), gb1 = *(const f32x4*)(gq + 160 + dd * 16 + hi * 8 + 4);
      const f32x4 c0 = *(const f32x4*)(rp + dd * 16), c1 = *(const f32x4*)(rp + dd * 16 + 4), s0 = *(const f32x4*)(rp + 32 + dd * 16), s1 = *(const f32x4*)(rp + 32 + dd * 16 + 4);
      float o1[8], o2[8];
#pragma unroll
      for (int j = 0; j < 8; ++j) { const float x1 = bf2f((bf16_t)raw[8 + dd][j]) * rq * (j < 4 ? ga0[j] : ga1[j - 4]), x2 = bf2f((bf16_t)raw[10 + dd][j]) * rq * (j < 4 ? gb0[j] : gb1[j - 4]);
        const float c = j < 4 ? c0[j] : c1[j - 4], s = j < 4 ? s0[j] : s1[j - 4]; o1[j] = x1 * c - x2 * s; o2[j] = x2 * c + x1 * s; }
      u32x4 w1 = {cvtpk(o1[0], o1[1]), cvtpk(o1[2], o1[3]), cvtpk(o1[4], o1[5]), cvtpk(o1[6], o1[7])}; qr[8 + dd] = *reinterpret_cast<bf16x8*>(&w1);
      u32x4 w2 = {cvtpk(o2[0], o2[1]), cvtpk(o2[2], o2[3]), cvtpk(o2[4], o2[5]), cvtpk(o2[6], o2[7])}; qr[10 + dd] = *reinterpret_cast<bf16x8*>(&w2);
      asm volatile("" ::: "memory");
    }
  }
  int t1 = tid; asm volatile("" : "+v"(t1));
  const int vb0 = (int)(unsigned)(size_t)V_lds + v_rd_base(t1 & 63);
  const int kg_ = ((t1 & 31) >> 1) & 7, kr_ = (t1 & 31) * 128, kh_ = (t1 >> 5) & 1;
  const int kb0 = kr_ + (((0 + kh_) ^ kg_) << 4), kb1 = kr_ + (((2 + kh_) ^ kg_) << 4), kb2 = kr_ + (((4 + kh_) ^ kg_) << 4), kb3 = kr_ + (((6 + kh_) ^ kg_) << 4);
#define RESC(a) do { if (__any((a) < 1.f)) { if (hi == 0) al_l[r32] = (a); asm volatile("s_waitcnt lgkmcnt(0)" ::: "memory"); \
    _Pragma("unroll") for (int d = 0; d < 4; ++d) _Pragma("unroll") for (int r = 0; r < 16; ++r) o[d][r] *= al_l[crow(r, hi)]; } } while (0)
  f32x16 p0, p1; float mn, al; bf16x8 pa0, pa1, pa2, pa3; constexpr int NT = SEQ / KVBLK;
  const int grp = wid >> 2;
#define BAR_ONLY() asm volatile("s_waitcnt lgkmcnt(0)\n\ts_barrier" ::: "memory")
  WAIT_BAR(0);
  if (grp == 1) BAR_ONLY();
  __builtin_amdgcn_s_setprio(1); qkt(p0, p1, K_lds, qr, kb0, kb1, kb2, kb3); __builtin_amdgcn_s_setprio(0);
#define KEEP16(x) asm volatile("" : "+v"(x))
  BAR_ONLY();
  DMA_K(2, 2); DMA_V(1, 1);
  partialSM(p0, p1, m_reg, mn, al); finishSM(p0, p1, al, l_reg, pa0, pa1, pa2, pa3);
  int sk = 1, sv = 0;
#define NEXT3(x) ((x) == 2 ? 0 : (x) + 1)
#define PREV3(x) ((x) == 0 ? 2 : (x) - 1)
  for (int j = 0; j < NT - 1; ++j) {
    BAR_ONLY();
    SBAR(); __builtin_amdgcn_s_setprio(1);
    if (VAR != 2 && VAR != 3 && VAR != 5) qkt(p0, p1, K_lds + sk * SHM_K, qr, kb0, kb1, kb2, kb3); else { KEEP16(p0); KEEP16(p1); }
    if (VAR != 2 && VAR != 3 && VAR != 4) pv_d0(o, vb0 + sv * SHM_V, pa0, pa1, pa2, pa3); else { KEEP16(o[0]); KEEP16(o[1]); KEEP16(o[2]); KEEP16(o[3]); }
    __builtin_amdgcn_s_setprio(0); SBAR();
    WAIT_BAR(0);
    if (j + 3 < NT) DMA_K(j + 3, PREV3(sk));
    if (j + 2 < NT) DMA_V(j + 2, PREV3(sv));
    if (VAR != 1 && VAR != 3) { partialSM(p0, p1, m_reg, mn, al); RESC(al); finishSM(p0, p1, al, l_reg, pa0, pa1, pa2, pa3); } else { KEEP16(p0); KEEP16(p1); asm volatile("" : "+v"(pa0), "+v"(pa1), "+v"(pa2), "+v"(pa3)); }
    sk = NEXT3(sk); sv = NEXT3(sv);
  }
  BAR_ONLY();
  SBAR(); pv_d0(o, vb0 + sv * SHM_V, pa0, pa1, pa2, pa3);
  if (grp == 0) BAR_ONLY();
  if (hi == 0) li_l[r32] = l_reg;
  asm volatile("s_waitcnt lgkmcnt(0)\n\ts_barrier" ::: "memory");
  { int t2 = tid; asm volatile("" : "+v"(t2));
  const int wid = t2 >> 6, lane = t2 & 63, r32 = lane & 31, hi = lane >> 5;
  LAS float* li_l = (LAS float*)(lds + OFF_WS) + wid * 64;
  LAS bf16_t* stg = (LAS bf16_t*)(lds + wid * 8192);
#pragma unroll
  for (int r = 0; r < 16; ++r) { const int orow = crow(r, hi); const float rl = __builtin_amdgcn_rcpf(li_l[orow]);
#pragma unroll
    for (int d0 = 0; d0 < 4; ++d0) stg[orow * 128 + d0 * 32 + r32] = (bf16_t)(cvtpk(o[d0][r] * rl, 0.f) & 0xffffu); }
  asm volatile("s_waitcnt lgkmcnt(0)" ::: "memory");
  { const int row = lane >> 1, half = lane & 1; const LAS u32x4* src = (const LAS u32x4*)(stg + row * 128 + half * 64); float s = 0.f;
    bf16_t* orow = Ob + (long)(wid * QBLK + row) * 1024 + half * 64;
#pragma unroll
    for (int i = 0; i < 8; ++i) { const u32x4 v = src[i]; if (VAR == 0) *(u32x4*)(orow + i * 8) = v; else asm volatile("" :: "v"(v));
#pragma unroll
      for (int e = 0; e < 4; ++e) { const float a = __builtin_bit_cast(float, v[e] << 16), b = __builtin_bit_cast(float, v[e] & 0xffff0000u); s += a * a + b * b; } }
    s = add_xor1(s);
    if (half == 0 && VAR == 0) ssq[(long)(wid * QBLK + row) * 8] = s; if (VAR != 0) asm volatile("" :: "v"(s)); }
  }
  asm volatile("s_waitcnt lgkmcnt(0)\n\ts_barrier" ::: "memory");
#undef GLDS
#undef DMA_K
#undef DMA_V
#undef WAIT_BAR
#undef RESC
#undef BAR_ONLY
#undef KEEP16
#undef NEXT3
#undef PREV3
}
#undef SBAR
}

constexpr int NWAVES = 8, MK_THREADS = NWAVES * 64;
constexpr int MK_LDS = 147456, XCH_OFF = 131072, MISC_OFF = XCH_OFF + 4096, CW_BAR = 4096, CTL_ZERO_BYTES = 65536;

template <bool HAS_GAIN> __device__ __forceinline__ void tr_item(const float* W, int K, int N, int koff, const float* g1, const float* g2, int ksplit, bf16_t* WT, LAS float* scr, int item, int lane, int perm_from) {
    const int nblk = N / 32, kb = item / nblk, nb = item % nblk, k0 = 64 * kb, n0 = 32 * nb, c = lane & 7;
    f32x4 ga = (f32x4){1.f, 1.f, 1.f, 1.f}, gb = ga;
    if (HAS_GAIN) { const int ko = k0 < ksplit ? k0 : k0 - ksplit; const float* gp = (k0 < ksplit ? g1 : g2) + ko + 8 * c; ga = *(const f32x4*)gp; gb = *(const f32x4*)(gp + 4); }
    int nc = n0 + (lane & 31); if (nc >= perm_from) { const int cc = nc - perm_from; nc = perm_from + ((cc >> 2) & 1) * 32 + 16 * (cc >> 5) + 4 * ((cc >> 3) & 3) + (cc & 3); }
    const float* wp = W + nc;
#pragma unroll
    for (int i = 0; i < 32; ++i) {
        const int kk = 2 * i + (lane >> 5), ks = (k0 + kk + koff) & (K - 1);
        scr[kk * 33 + (lane & 31)] = wp[(size_t)ks * N];
    }
    asm volatile("s_waitcnt lgkmcnt(0)" ::: "memory");
#pragma unroll
    for (int j = 0; j < 4; ++j) {
        const int n = (lane >> 3) + 8 * j; const LAS float* s = scr + (8 * c) * 33 + n;
        u32x4 o; o.x = pk2(s[0 * 33] * ga[0], s[1 * 33] * ga[1]); o.y = pk2(s[2 * 33] * ga[2], s[3 * 33] * ga[3]); o.z = pk2(s[4 * 33] * gb[0], s[5 * 33] * gb[1]); o.w = pk2(s[6 * 33] * gb[2], s[7 * 33] * gb[3]);
        *(u32x4*)(WT + (size_t)(n0 + n) * K + k0 + 8 * c) = o;
    }
    asm volatile("s_waitcnt lgkmcnt(0)" ::: "memory");
}

__device__ __forceinline__ void phase_prologue(const Params& p, LAS unsigned char* lds, const int tid) {
    const int lane = tid & 63, wave = tid >> 6;
    const int G = gridDim.x, gw = blockIdx.x * NWAVES + wave, NGW = G * NWAVES;
    const int gt = blockIdx.x * MK_THREADS + tid, NGT = G * MK_THREADS;
    LAS float* tab = (LAS float*)lds;
    LAS float* scr = (LAS float*)(lds + 8192 + wave * 8704);
    for (int j = tid; j < 2048; j += MK_THREADS) tab[j] = cospif((float)j * (1.0f / 1024.0f));
    __syncthreads();
    unsigned char* ws = p.ws;
    if (p.sub & 1) {
        constexpr int I_IN = 16 * 26, I_QU = 4 * 36, I_KV = 4 * 48, I_OUT = 16 * 32, I_MI = 16 * 128, I_MO = 64 * 32, I_L = I_IN + I_QU + I_KV + I_OUT + I_MI + I_MO;
        for (int it = gw; it < DEPTH * I_L; it += NGW) {
            const int l = it / I_L; int r = it % I_L; unsigned char* wl = ws + WS_W + (size_t)l * LW;
            if (r < I_IN) { tr_item<true>(karg_in(I_WIN) + (size_t)l * DM * INW, DM, INW, 0, karg_in(I_ANG) + l * DM, nullptr, DM, (bf16_t*)(wl + OW_IN), scr, r, lane, 768); continue; } r -= I_IN;
            if (r < I_QU) { tr_item<true>(karg_in(I_WQUP) + (size_t)l * QL * QUPW, QL, QUPW, 0, karg_in(I_QAG) + l * QL, nullptr, QL, (bf16_t*)(wl + OW_QUP), scr, r, lane, 1 << 30); continue; } r -= I_QU;
            if (r < I_KV) { tr_item<true>(karg_in(I_WKVUP) + (size_t)l * KVL * KVUPW, KVL, KVUPW, 0, karg_in(I_KVAG) + l * KVL, nullptr, KVL, (bf16_t*)(wl + OW_KVUP), scr, r, lane, 1 << 30); continue; } r -= I_KV;
            if (r < I_OUT) { tr_item<true>(karg_in(I_WOUT) + (size_t)l * DM * DM, DM, DM, FW, karg_in(I_AOG) + l * AW, karg_in(I_FOG) + l * FW, AW, (bf16_t*)(wl + OW_OUT), scr, r, lane, 1 << 30); continue; } r -= I_OUT;
            if (r < I_MI) { tr_item<true>(karg_in(I_WMI) + (size_t)l * DM * FF, DM, FF, 0, karg_in(I_MNG) + l * DM, nullptr, DM, (bf16_t*)(wl + OW_MI), scr, r, lane, 1 << 30); continue; } r -= I_MI;
            tr_item<false>(karg_in(I_WMO) + (size_t)l * FF * DM, FF, DM, 0, nullptr, nullptr, FF, (bf16_t*)(wl + OW_MO), scr, r, lane, 1 << 30);
        }
    }
    if (p.sub & 1) {
        constexpr int C_IN = (INWP - INW) * DM / 8, C_QU = (QUPWP - QUPW) * QL / 8, C_L = C_IN + C_QU;
        for (int i = gt; i < DEPTH * C_L; i += NGT) {
            const int l = i / C_L, r = i % C_L; unsigned char* wl = ws + WS_W + (size_t)l * LW;
            u32x4* dst = (r < C_IN) ? (u32x4*)(wl + OW_IN + (size_t)INW * DM * 2) + r : (u32x4*)(wl + OW_QUP + (size_t)QUPW * QL * 2) + (r - C_IN);
            *dst = (u32x4){0u, 0u, 0u, 0u};
        }
    }
    if (p.sub & 2) {
        bf16_t* F = (bf16_t*)(ws + WS_F);
        for (int ci = gt; ci < 2048 * 256; ci += NGT) {
            const int r = ci >> 8, s0 = (ci & 255) * 8, sp = r > 1024 ? r - 1024 : r, sh = r > 1024 ? 1536 : 0;
            float v[8];
#pragma unroll
            for (int e = 0; e < 8; ++e) v[e] = tab[(sp * (s0 + e) + sh) & 2047];
            u32x4 o; o.x = pk2(v[0], v[1]); o.y = pk2(v[2], v[3]); o.z = pk2(v[4], v[5]); o.w = pk2(v[6], v[7]);
            *(u32x4*)(F + (size_t)r * 2048 + s0) = o;
        }
    }
    if (p.sub & 4) {
        if (blockIdx.x < DEPTH * 8) {
            const int w = blockIdx.x, l = w >> 3, g = (w >> 1) & 3, pq = w & 1, sh = pq ? 1536 : 0;
            LAS float* wfs = (LAS float*)(lds + 8192 + NWAVES * 8704);
            const float* wf = karg_in(I_WF) + (size_t)(l * 4 + g) * 4096;
            for (int i = tid; i < 4096; i += MK_THREADS) wfs[i] = wf[i];
            __syncthreads();
            const int d = tid & 63, cb = tid >> 6; float o[8];
#pragma unroll
            for (int k = 0; k < 8; ++k) o[k] = 0.f;
            for (int c2 = 0; c2 < 64; ++c2) { const float wv = wfs[c2 * 64 + d];
#pragma unroll
                for (int k = 0; k < 8; ++k) o[k] += tab[((((cb * 8 + k) * c2) & 63) * 32 + sh) & 2047] * wv; }
            const float sc = pq ? -DFT_NRM : DFT_NRM;
            u32x4 ov; ov.x = pk2(o[0] * sc, o[1] * sc); ov.y = pk2(o[2] * sc, o[3] * sc); ov.z = pk2(o[4] * sc, o[5] * sc); ov.w = pk2(o[6] * sc, o[7] * sc);
            *(u32x4*)((bf16_t*)(ws + WS_W + (size_t)l * LW + OW_Y) + (size_t)(g * 64 + d) * 512 + pq * 256 + g * 64 + cb * 8) = ov;
        }
        for (int i = gt; i < DEPTH * 256 * 64; i += NGT) {
            const int l = i / (256 * 64), r = i % (256 * 64), n = r >> 6, k8 = r & 63, g = n >> 6, g2 = (k8 >> 3) & 3;
            if (g2 != g) *(u32x4*)((bf16_t*)(ws + WS_W + (size_t)l * LW + OW_Y) + (size_t)n * 512 + k8 * 8) = (u32x4){0u, 0u, 0u, 0u};
        }
    }
    if (p.sub & 8) {
        bf16_t* XB = (bf16_t*)(ws + WS_XB); float* SSQ = (float*)(ws + WS_SSQX);
        for (int m = gw; m < T; m += NGW) {
            const f32x4* xr = (const f32x4*)(p.x + (size_t)m * DM) + lane; f32x4 v[4]; float s = 0.f;
#pragma unroll
            for (int j = 0; j < 4; ++j) { v[j] = xr[64 * j]; s += (v[j].x * v[j].x + v[j].y * v[j].y) + (v[j].z * v[j].z + v[j].w * v[j].w); }
            s = wave_sum(s);
            u32x2* o8 = (u32x2*)(XB + (size_t)m * DM) + lane;
#pragma unroll
            for (int j = 0; j < 4; ++j) o8[64 * j] = (u32x2){pk2(v[j].x, v[j].y), pk2(v[j].z, v[j].w)};
            if (lane < 4) SSQ[(size_t)m * 4 + lane] = lane == 0 ? s : 0.f;
        }
    }
    if (p.sub & 16) {
        float* R = (float*)(ws + WS_ROPE);
        LAS float* invf = (LAS float*)(lds + 8192 + NWAVES * 8704 + 16384);
        __syncthreads(); if (tid < 32) invf[tid] = powf(10000.0f, -(float)tid * (1.0f / 32.0f)); __syncthreads();
        for (int i = gt; i < T * 32; i += NGT) {
            const int row = i >> 5, j = i & 31;
            const float inv = invf[j];
            const float ang = (float)p.pos[row] * inv;
            R[(size_t)row * 64 + j] = cosf(ang); R[(size_t)row * 64 + 32 + j] = sinf(ang);
        }
    }
}

#define XB_TMO      128
#define XB_XCNT(j)  (256  + 64 * (j))
#define XB_XSUB(j)  (1280 + 64 * (j))
#define XB_XGEN(j)  (2304 + 64 * (j))
#define XB_TOP      3328
#define XB_TOPGEN   3392
#define XCD_BAR_WORDS 3456
#define XB_SPIN_CAP (1u << 18)

__device__ __forceinline__ unsigned xb_ld(unsigned* p)              { return __hip_atomic_load(p, __ATOMIC_RELAXED, __HIP_MEMORY_SCOPE_AGENT); }
__device__ __forceinline__ unsigned xb_add(unsigned* p, unsigned v) { return __hip_atomic_fetch_add(p, v, __ATOMIC_RELAXED, __HIP_MEMORY_SCOPE_AGENT); }
__device__ __forceinline__ unsigned xb_xcc_id() { return (unsigned)__builtin_amdgcn_s_getreg((3 << 11) | 20) & 0xFu; }
#define XB_SPIN(cond, bar) do { unsigned _sp = 0; while (cond) { __builtin_amdgcn_s_sleep(1); \
    if ((++_sp & 255u) == 0u) { if (xb_ld(&(bar)[XB_TMO])) break; if (_sp > XB_SPIN_CAP) { atomicAdd(&(bar)[XB_TMO], 1u); break; } } } } while (0)

struct XcdBarrier {
    unsigned* bar; unsigned x;
    volatile LAS unsigned* st;
};

__device__ __forceinline__ XcdBarrier xcd_barrier_post(unsigned* bar, volatile LAS unsigned* st) {
    XcdBarrier b; b.bar = bar; b.x = xb_xcc_id(); b.st = st;
    if (threadIdx.x == 0) (void)xb_add(&bar[XB_XCNT(b.x)], 1u);
    return b;
}
__device__ __forceinline__ void xcd_barrier_complete(unsigned* bar, unsigned x, unsigned& nloc, unsigned& nx) {
    const unsigned G = gridDim.x * gridDim.y * gridDim.z;
    unsigned sum, cnt, mine, sp = 0u;
    for (;;) {
        sum = 0u; cnt = 0u; mine = 0u;
#pragma unroll 1
        for (unsigned j = 0; j < 16; ++j) { const unsigned c = xb_ld(&bar[XB_XCNT(j)]); sum += c; cnt += (c > 0u) ? 1u : 0u; mine = (j == x) ? c : mine; }
        if (sum == G) break;
        __builtin_amdgcn_s_sleep(1);
        if ((++sp & 255u) == 0u) { if (xb_ld(&bar[XB_TMO])) break; if (sp > XB_SPIN_CAP) { atomicAdd(&bar[XB_TMO], 1u); break; } }
    }
    nloc = mine > 0u ? mine : 1u; nx = cnt > 0u ? cnt : 1u;
}

__device__ __forceinline__ void xcd_barrier(const XcdBarrier& b) {
    asm volatile("s_waitcnt vmcnt(0)" ::: "memory");
    __syncthreads();
    if (threadIdx.x == 0) {
        unsigned* bar = b.bar;
        __builtin_amdgcn_s_waitcnt(0);
        unsigned nloc = b.st[0], nx = b.st[1];
        if (nloc == 0u) { xcd_barrier_complete(bar, b.x, nloc, nx); b.st[0] = nloc; b.st[1] = nx; }
        const unsigned old = xb_add(&bar[XB_XSUB(b.x)], 1u);
        const unsigned gen = old / nloc;
        if (old + 1u == (gen + 1u) * nloc) {
            __builtin_amdgcn_fence(__ATOMIC_RELEASE, "agent");
            asm volatile("s_waitcnt vmcnt(0)" ::: "memory");
            const unsigned og = xb_add(&bar[XB_TOP], 1u);
            const unsigned tg = og / nx;
            if (og + 1u == (tg + 1u) * nx) xb_add(&bar[XB_TOPGEN], 1u);
            else XB_SPIN(xb_ld(&bar[XB_TOPGEN]) == tg, bar);
            __builtin_amdgcn_fence(__ATOMIC_ACQUIRE, "agent");
            xb_add(&bar[XB_XGEN(b.x)], 1u);
            asm volatile("s_waitcnt vmcnt(0)" ::: "memory");
        } else {
            XB_SPIN(xb_ld(&bar[XB_XGEN(b.x)]) == gen, bar);
            __builtin_amdgcn_fence(__ATOMIC_ACQUIRE, "agent");
            asm volatile("s_waitcnt vmcnt(0)" ::: "memory");
        }
    }
    __syncthreads();
}

constexpr int N_PHASES = 1 + 6 * DEPTH;
#ifndef DUP_PH
#define DUP_PH -1
#define DUP_SUB 7
#endif
#ifndef PHM
#define PHM 0xffff
#endif
__global__ void __launch_bounds__(MK_THREADS, 2) mk(Params p) {
    extern __shared__ __attribute__((aligned(16))) unsigned char lds_raw[];
    LAS unsigned char* lds = (LAS unsigned char*)lds_raw;
    const int G = gridDim.x, bid = blockIdx.x;
#define BP(off) ((bf16_t*)(ws + (off)))
#define FP(off) ((float*)(ws + (off)))
    volatile LAS unsigned* MISC = (volatile LAS unsigned*)(lds + MISC_OFF);
    if (threadIdx.x < 32) MISC[threadIdx.x] = 0u;
    __syncthreads();
    const XcdBarrier bar = xcd_barrier_post((unsigned*)(p.ws + WS_CTL) + CW_BAR, MISC + 8);
    if (p.ph_lo == 0) {
        phase_prologue(p, lds, threadIdx.x);
        if (p.ph_hi > 1) xcd_barrier(bar);
    }
    for (int ph = p.ph_lo < 1 ? 1 : p.ph_lo; ph < p.ph_hi; ++ph) {
        for (int rep = 0; rep < ((ph == DUP_PH) ? 2 : 1); ++rep) {
            const int sub = rep == 0 ? p.sub : DUP_SUB; if (rep) __syncthreads();
        int tid = threadIdx.x; asm volatile("" : "+v"(tid));
        unsigned char* ws; { unsigned long long w_ = (unsigned long long)p.ws; asm volatile("" : "+s"(w_)); ws = (unsigned char*)(__attribute__((address_space(1))) unsigned char*)w_; }
            const int l = (ph - 1) / 6, s = (ph - 1) % 6;
            unsigned char* wl = ws + WS_W + (size_t)l * LW;
            pg8::StaticOrder S;
            if (s == 0 && ((PHM & 1) != 0)) {
                pg8::Gemm g{BP(WS_XB), (const bf16_t*)(wl + OW_IN), T, INWP, DM}; S.init(T, INWP, G, bid);
                pg8::EpiIn E{ws, karg_in(I_KNG) + l * QKD};
                pg8::gemm_phase<pg8::EpiIn, pg8::StaticOrder, true, true>(lds, g, S, E, tid);
            } else if (s == 1 && ((PHM & 2) != 0)) {
                if ((sub & 1) && ((PHM & 64) != 0)) { pg8::Gemm g{BP(WS_F), BP(WS_UT), 2048, 4096, 2048}; S.init(2048, 4096, G, bid);     pg8::EpiDft E{ws};
                    pg8::gemm_phase<pg8::EpiDft, pg8::StaticOrder, true, true>(lds, g, S, E, tid); }
                if ((sub & 2) && ((PHM & 128) != 0)) { pg8::Gemm g{BP(WS_CQ), (const bf16_t*)(wl + OW_QUP), T, QUPWP, QL}; S.init(T, QUPWP, G, (bid + G / 2) % G);     pg8::EpiQ E{ws};
                    pg8::gemm_phase<pg8::EpiQ, pg8::StaticOrder, true, true>(lds, g, S, E, tid); }
                if ((sub & 4) && ((PHM & 512) != 0)) { pg8::Gemm g{BP(WS_CKV), (const bf16_t*)(wl + OW_KVUP), T, KVUPW, KVL}; S.init(T, KVUPW, G, bid);
                    pg8::EpiKV E{ws, karg_in(I_KNG) + l * QKD, (LAS float*)(lds + XCH_OFF)};
                    pg8::gemm_phase<pg8::EpiKV, pg8::StaticOrder, true, true>(lds, g, S, E, tid); }
            } else if (s == 2 && ((PHM & 4) != 0)) {
                if ((sub & 1) && ((PHM & 1024) != 0)) {
                    const int vcu = (G % 8 == 0) ? (bid % 8) * (G / 8) + bid / 8 : bid;
                    for (int ui = vcu; ui < BATCH * NH * 8; ui += G) { const int bh = ui >> 3, qb = ui & 7, b = bh / NH, h = bh - b * NH; const size_t row0 = (size_t)b * SEQ + qb * 256;
                        att::attn_unit<0>(BP(WS_Q) + row0 * QUPW + h * QKD, BP(WS_K) + (size_t)b * SEQ * QUPW + h * QKD, BP(WS_V) + (size_t)b * SEQ * AW + h * VD, BP(WS_MIX) + row0 * 1024 + h * VD,
                                       FP(WS_SSQA) + row0 * 8 + h, karg_in(I_QNG) + l * QKD, FP(WS_ROPE) + row0 * 64, (LAS char*)lds, tid); }
                }
                if ((sub & 2) && ((PHM & 2048) != 0)) { pg8::Gemm g{BP(WS_PQ), (const bf16_t*)(wl + OW_Y), T, 256, 512}; S.init(T, 256, G, bid);
                    pg8::EpiY E{ws, (LAS float*)(lds + XCH_OFF)};
                    pg8::gemm_phase<pg8::EpiY, pg8::StaticOrder, true, true>(lds, g, S, E, tid); }
            } else if (s == 3 && ((PHM & 8) != 0)) {
                pg8::Gemm g{BP(WS_MIX), (const bf16_t*)(wl + OW_OUT), T, DM, DM}; S.init(T, DM, G, bid);
                pg8::EpiRes<12> E{ws, l == 0 ? p.x : nullptr, nullptr, (LAS float*)(lds + XCH_OFF)};
                pg8::gemm_phase<pg8::EpiRes<12>, pg8::StaticOrder, true, true>(lds, g, S, E, tid);
            } else if (s == 4 && ((PHM & 16) != 0)) {
                pg8::Gemm g{BP(WS_XB), (const bf16_t*)(wl + OW_MI), T, FF, DM}; S.init(T, FF, G, bid);
                pg8::EpiMlpIn E{ws, p.pad};
                pg8::gemm_phase<pg8::EpiMlpIn, pg8::StaticOrder, true, true>(lds, g, S, E, tid);
            } else if ((PHM & 32) != 0) {
                pg8::Gemm g{BP(WS_H), (const bf16_t*)(wl + OW_MO), T, DM, FF}; S.init(T, DM, G, bid);
                pg8::EpiRes<0> E{ws, nullptr, l == DEPTH - 1 ? p.out : nullptr, (LAS float*)(lds + XCH_OFF)};
                pg8::gemm_phase<pg8::EpiRes<0>, pg8::StaticOrder, true, true>(lds, g, S, E, tid);
            }
        }
        if (ph + 1 < p.ph_hi) xcd_barrier(bar); else __syncthreads();
    }
}


#ifdef ATTN_PROBE
__global__ void __launch_bounds__(MK_THREADS, 2) attn_probe(Params p) {
    extern __shared__ __attribute__((aligned(16))) unsigned char lds_raw[];
    LAS unsigned char* lds = (LAS unsigned char*)lds_raw;
    unsigned char* ws = p.ws; const int G = gridDim.x, bid = blockIdx.x, tid = threadIdx.x, l = 1;
    const int vcu = (G % 8 == 0) ? (bid % 8) * (G / 8) + bid / 8 : bid;
    for (int ui = vcu; ui < BATCH * NH * 8; ui += G) { const int bh = ui >> 3, qb = ui & 7, b = bh / NH, h = bh - b * NH; const size_t row0 = (size_t)b * SEQ + qb * 256;
        att::attn_unit<ATTN_PROBE>(BP(WS_Q) + row0 * QUPW + h * QKD, BP(WS_K) + (size_t)b * SEQ * QUPW + h * QKD, BP(WS_V) + (size_t)b * SEQ * AW + h * VD, BP(WS_MIX) + row0 * 1024 + h * VD,
                       FP(WS_SSQA) + row0 * 8 + h, karg_in(I_QNG) + l * QKD, FP(WS_ROPE) + row0 * 64, (LAS char*)lds, tid); }
}
#endif

extern "C" void kernel_launch(void* const* d_in, const int* in_sizes, int n_in, void* d_out, int out_size, void* d_ws, size_t ws_size, hipStream_t stream) {
    static int grid = 0;
    if (grid == 0) {
        if (n_in != 17 || in_sizes[0] != T * DM || out_size != T * DM || ws_size < WS_END) {
            fprintf(stderr, "kernel_launch: shape/workspace mismatch: n_in %d in0 %d out %d ws %zu (need %zu)\n", n_in, n_in > 0 ? in_sizes[0] : -1, out_size, ws_size, (size_t)WS_END);
            grid = -1; return; }
#ifdef ATTN_PROBE
        (void)hipFuncSetAttribute((const void*)attn_probe, hipFuncAttributeMaxDynamicSharedMemorySize, MK_LDS);
#endif
        if (hipFuncSetAttribute((const void*)mk, hipFuncAttributeMaxDynamicSharedMemorySize, MK_LDS) != hipSuccess) { fprintf(stderr, "kernel_launch: hipFuncSetAttribute failed\n"); grid = -1; return; }
        int dev = 0, cus = 0, per_cu = 0;
        if (hipGetDevice(&dev) != hipSuccess || hipDeviceGetAttribute(&cus, hipDeviceAttributeMultiprocessorCount, dev) != hipSuccess) { fprintf(stderr, "kernel_launch: device query failed\n"); grid = -1; return; }
        if (hipOccupancyMaxActiveBlocksPerMultiprocessor(&per_cu, (const void*)mk, MK_THREADS, MK_LDS) != hipSuccess || per_cu < 1) { fprintf(stderr, "kernel_launch: occupancy query says %d blocks per CU\n", per_cu); grid = -1; return; }
        grid = cus;
    }
    if (grid < 0) return;
    Params p{};
    p.x = (const float*)d_in[0]; p.pos = (const int*)d_in[1];
    for (int i = 0; i < 15; ++i) p.in[i] = (const float*)d_in[2 + i];
    p.out = (float*)d_out; p.ws = (unsigned char*)d_ws; p.ph_lo = 0; p.ph_hi = N_PHASES; p.sub = 31; p.pad = 0;
    if (hipMemsetAsync((char*)d_ws + WS_CTL, 0, CTL_ZERO_BYTES, stream) != hipSuccess) { fprintf(stderr, "kernel_launch: hipMemsetAsync failed\n"); return; }
    hipLaunchKernelGGL(mk, dim3(grid), dim3(MK_THREADS), MK_LDS, stream, p);
#ifdef ATTN_PROBE
    hipLaunchKernelGGL(attn_probe, dim3(grid), dim3(MK_THREADS), MK_LDS, stream, p);
#endif
#ifndef PHASE_PROBE_DBG
#define PHASE_PROBE_DBG 0
#endif
#ifdef PHASE_PROBE
    { Params q = p; q.ph_lo = PHASE_PROBE; q.ph_hi = PHASE_PROBE + 1; q.sub = PHASE_PROBE_SUB; q.pad = PHASE_PROBE_DBG; hipLaunchKernelGGL(mk, dim3(grid), dim3(MK_THREADS), MK_LDS, stream, q); }
#endif
    const hipError_t le = hipPeekAtLastError();
    if (le != hipSuccess) fprintf(stderr, "kernel_launch: launch failed: %s (grid %d)\n", hipGetErrorName(le), grid);
}
```
